# Optimizing an MI355X kernel written in HIP

```python
import math
import jax, jax.numpy as jnp
from jax import lax
import numpy as np

D_MODEL = 2048
BATCH = 1
SEQ = 8192
DEPTH = 4

HEAD_DIM = 128
N_Q_HEADS = 12
N_KV_HEADS = 4
GQA_GROUP = N_Q_HEADS // N_KV_HEADS
WINDOW = 128
ATTN_BLOCK = 128
N_FOURIER_GROUPS = 4
FOURIER_GROUP_DIM = 128
Q_DIM = N_Q_HEADS * HEAD_DIM
KV_DIM = N_KV_HEADS * HEAD_DIM
FOURIER_DIM = N_FOURIER_GROUPS * FOURIER_GROUP_DIM
EVEN_IN_DIM = Q_DIM + 2 * KV_DIM + FOURIER_DIM
EVEN_MIX_DIM = Q_DIM + FOURIER_DIM

N_REL_BUCKETS = 32
REL_MAX_DISTANCE = 128

CONV_GROUPS = 8
CONV_GROUP_DIM = 128
CONV_DIM = CONV_GROUPS * CONV_GROUP_DIM
CONV_WIDTH = 3
POOL_WINDOWS = (2, 4, 8, 16)
POOL_GROUPS = len(POOL_WINDOWS)
POOL_GROUP_DIM = 256
POOL_DIM = POOL_GROUPS * POOL_GROUP_DIM
ODD_IN_DIM = 3 * CONV_DIM + POOL_DIM
ODD_MIX_DIM = CONV_DIM + POOL_DIM

N_EXPERTS = 16
EXPERT_HIDDEN = 1024
CAPACITY_FACTOR = 2

RMS_EPS = 1e-6
NEG_INF = -1e30

kernel_name = "hybrid_swa_fourier_conv_pool_ec_moe_encoder"


def rmsnorm(x, g):
    xf = x.astype(jnp.float32)
    y = xf * lax.rsqrt(jnp.mean(xf * xf, axis=-1, keepdims=True) + RMS_EPS)
    return (y * g.astype(jnp.float32)).astype(x.dtype)


def t5_bucket(rel):
    nb = N_REL_BUCKETS // 2
    max_exact = nb // 2
    ret = (rel > 0).astype(jnp.int32) * nb
    n = jnp.abs(rel)
    nf = jnp.maximum(n, 1).astype(jnp.float32)
    large = max_exact + (jnp.log(nf / max_exact) / math.log(REL_MAX_DISTANCE / max_exact)
                         * (nb - max_exact)).astype(jnp.int32)
    large = jnp.minimum(large, nb - 1)
    return ret + jnp.where(n < max_exact, n, large)


def window_rel_bias(table):
    i = jnp.arange(ATTN_BLOCK, dtype=jnp.int32)[:, None]
    j = jnp.arange(3 * ATTN_BLOCK, dtype=jnp.int32)[None, :]
    rel = (j - WINDOW) - i
    return jnp.transpose(table[t5_bucket(rel)], (2, 0, 1))


def windowed_gqa(q, k, v, sink, bias):
    bsz, seq = q.shape[0], q.shape[1]
    nb = seq // ATTN_BLOCK
    qb = q.reshape(bsz, nb, ATTN_BLOCK, N_KV_HEADS, GQA_GROUP, HEAD_DIM)
    pad = ((0, 0), (WINDOW, WINDOW), (0, 0), (0, 0))

    def band(t):
        tp = jnp.pad(t, pad).reshape(bsz, nb + 2, ATTN_BLOCK, N_KV_HEADS, HEAD_DIM)
        return jnp.concatenate([tp[:, 0:nb], tp[:, 1:nb + 1], tp[:, 2:nb + 2]], axis=2)

    kb, vb = band(k), band(v)
    s = jnp.einsum('bnqkgd,bnjkd->bnkgqj', qb, kb,
                   preferred_element_type=jnp.float32) * (HEAD_DIM ** -0.5)
    s = s + bias.astype(jnp.float32).reshape(N_KV_HEADS, GQA_GROUP, ATTN_BLOCK, 3 * ATTN_BLOCK)
    blk = jnp.arange(nb, dtype=jnp.int32)[:, None, None]
    qi = jnp.arange(ATTN_BLOCK, dtype=jnp.int32)[None, :, None]
    kj = jnp.arange(3 * ATTN_BLOCK, dtype=jnp.int32)[None, None, :]
    kpos = blk * ATTN_BLOCK - WINDOW + kj
    valid = (jnp.abs(kj - WINDOW - qi) <= WINDOW) & (kpos >= 0) & (kpos < seq)
    s = jnp.where(valid[None, :, None, None], s, NEG_INF)
    sk = sink.astype(jnp.float32).reshape(1, 1, N_KV_HEADS, GQA_GROUP, 1)
    m = jnp.maximum(jnp.max(s, axis=-1), sk)
    p = jnp.exp(s - m[..., None])
    denom = jnp.sum(p, axis=-1) + jnp.exp(sk - m)
    w = (p / denom[..., None]).astype(v.dtype)
    o = jnp.einsum('bnkgqj,bnjkd->bnqkgd', w, vb)
    return o.reshape(bsz, seq, Q_DIM)


def fourier_mix(f):
    spec = jnp.fft.fft2(f.astype(jnp.float32), axes=(1, 3), norm="ortho")
    return jnp.real(spec).astype(f.dtype)


def even_mixer(h, w_in, sink, w_out, bias):
    bsz, seq, _ = h.shape
    z = h @ w_in
    q = z[..., :Q_DIM].reshape(bsz, seq, N_Q_HEADS, HEAD_DIM)
    k = z[..., Q_DIM:Q_DIM + KV_DIM].reshape(bsz, seq, N_KV_HEADS, HEAD_DIM)
    v = z[..., Q_DIM + KV_DIM:Q_DIM + 2 * KV_DIM].reshape(bsz, seq, N_KV_HEADS, HEAD_DIM)
    f = z[..., Q_DIM + 2 * KV_DIM:].reshape(bsz, seq, N_FOURIER_GROUPS, FOURIER_GROUP_DIM)
    a_out = windowed_gqa(q, k, v, sink, bias)
    b_out = fourier_mix(f).reshape(bsz, seq, FOURIER_DIM)
    return jnp.concatenate([a_out, b_out], axis=-1) @ w_out


def multiscale_pool(xd):
    seq = xd.shape[1]
    xf = xd.astype(jnp.float32)
    cs = jnp.concatenate([jnp.zeros_like(xf[:, :1]), lax.cumsum(xf, axis=1)], axis=1)
    win = jnp.array(POOL_WINDOWS, dtype=jnp.int32)
    lo = win // 2
    hi = win - 1 - lo
    t = jnp.arange(seq, dtype=jnp.int32)[:, None]
    a = jnp.maximum(t - lo[None, :], 0)
    b = jnp.minimum(t + hi[None, :], seq - 1)
    gi = jnp.arange(POOL_GROUPS, dtype=jnp.int32)[None, :]
    total = cs[:, b + 1, gi] - cs[:, a, gi]
    count = (b - a + 1).astype(jnp.float32)[None, :, :, None]
    return (total / count - xf).astype(xd.dtype)


def odd_mixer(h, w_in, conv_w, pool_w, pool_scale, w_out):
    bsz, seq, _ = h.shape
    z = h @ w_in
    bg = z[..., :CONV_DIM]
    cg = z[..., CONV_DIM:2 * CONV_DIM]
    u = z[..., 2 * CONV_DIM:3 * CONV_DIM]
    xd = z[..., 3 * CONV_DIM:].reshape(bsz, seq, POOL_GROUPS, POOL_GROUP_DIM)
    conv = lax.conv_general_dilated(
        cg * u, conv_w[:, None, :], window_strides=(1,), padding=((1, 1),),
        dimension_numbers=('NWC', 'WIO', 'NWC'), feature_group_count=CONV_DIM)
    c_out = bg * conv
    pooled = multiscale_pool(xd)
    d_out = jnp.einsum('bsgc,gcd->bsgd', pooled, pool_w)
    d_out = (d_out * pool_scale.reshape(POOL_GROUPS, POOL_GROUP_DIM)).reshape(bsz, seq, POOL_DIM)
    return jnp.concatenate([c_out, d_out], axis=-1) @ w_out


def ec_moe(h, w_router, w_gate, w_up, w_down):
    bsz, seq, dm = h.shape
    cap = CAPACITY_FACTOR * seq // N_EXPERTS
    logits = jnp.einsum('bsd,de->bse', h, w_router, preferred_element_type=jnp.float32)
    aff = jax.nn.softmax(logits, axis=-1)
    gate, idx = lax.top_k(jnp.transpose(aff, (0, 2, 1)), cap)
    bidx = jnp.arange(bsz, dtype=jnp.int32)[:, None, None]
    xe = h[bidx, idx]
    hid = jax.nn.silu(jnp.einsum('becd,edh->bech', xe, w_gate)) * jnp.einsum('becd,edh->bech', xe, w_up)
    ye = jnp.einsum('bech,ehd->becd', hid, w_down) * gate.astype(h.dtype)[..., None]
    flat = (bidx * seq + idx).reshape(-1)
    out = jnp.zeros((bsz * seq, dm), ye.dtype).at[flat].add(ye.reshape(-1, dm))
    return out.reshape(bsz, seq, dm)


def setup_inputs(seed: int = 0) -> dict:
    key = jax.random.key(seed)
    ks = jax.random.split(key, 20)
    n_even = (DEPTH + 1) // 2
    n_odd = DEPTH // 2
    nrm = jax.random.normal
    f32 = jnp.float32
    return {
        "x": nrm(ks[0], (BATCH, SEQ, D_MODEL), f32),
        "rel_bias": 0.1 * nrm(ks[1], (N_REL_BUCKETS, N_Q_HEADS), f32),
        "norm_mix_g": 1.0 + 0.02 * nrm(ks[2], (DEPTH, D_MODEL), f32),
        "norm_ffn_g": 1.0 + 0.02 * nrm(ks[3], (DEPTH, D_MODEL), f32),
        "final_norm_g": 1.0 + 0.02 * nrm(ks[4], (D_MODEL,), f32),
        "ev_w_in": nrm(ks[5], (n_even, D_MODEL, EVEN_IN_DIM), f32) * D_MODEL ** -0.5,
        "ev_sink": 0.5 * nrm(ks[6], (n_even, N_Q_HEADS), f32),
        "ev_w_out": nrm(ks[7], (n_even, EVEN_MIX_DIM, D_MODEL), f32) * EVEN_MIX_DIM ** -0.5,
        "od_w_in": nrm(ks[8], (n_odd, D_MODEL, ODD_IN_DIM), f32) * D_MODEL ** -0.5,
        "od_conv_w": nrm(ks[9], (n_odd, CONV_WIDTH, CONV_DIM), f32) * CONV_WIDTH ** -0.5,
        "od_pool_w": nrm(ks[10], (n_odd, POOL_GROUPS, POOL_GROUP_DIM, POOL_GROUP_DIM), f32) * POOL_GROUP_DIM ** -0.5,
        "od_pool_scale": 1.0 + 0.1 * nrm(ks[11], (n_odd, POOL_DIM), f32),
        "od_w_out": nrm(ks[12], (n_odd, ODD_MIX_DIM, D_MODEL), f32) * ODD_MIX_DIM ** -0.5,
        "moe_w_router": nrm(ks[13], (DEPTH, D_MODEL, N_EXPERTS), f32) * D_MODEL ** -0.5,
        "moe_w_gate": nrm(ks[14], (DEPTH, N_EXPERTS, D_MODEL, EXPERT_HIDDEN), f32) * D_MODEL ** -0.5,
        "moe_w_up": nrm(ks[15], (DEPTH, N_EXPERTS, D_MODEL, EXPERT_HIDDEN), f32) * D_MODEL ** -0.5,
        "moe_w_down": nrm(ks[16], (DEPTH, N_EXPERTS, EXPERT_HIDDEN, D_MODEL), f32) * EXPERT_HIDDEN ** -0.5,
    }


def reference(x, rel_bias, norm_mix_g, norm_ffn_g, final_norm_g,
              ev_w_in, ev_sink, ev_w_out,
              od_w_in, od_conv_w, od_pool_w, od_pool_scale, od_w_out,
              moe_w_router, moe_w_gate, moe_w_up, moe_w_down):
    bias = window_rel_bias(rel_bias)
    for layer in range(DEPTH):
        h = rmsnorm(x, norm_mix_g[layer])
        if layer % 2 == 0:
            i = layer // 2
            x = x + even_mixer(h, ev_w_in[i], ev_sink[i], ev_w_out[i], bias)
        else:
            i = layer // 2
            x = x + odd_mixer(h, od_w_in[i], od_conv_w[i], od_pool_w[i], od_pool_scale[i], od_w_out[i])
        h = rmsnorm(x, norm_ffn_g[layer])
        x = x + ec_moe(h, moe_w_router[layer], moe_w_gate[layer], moe_w_up[layer], moe_w_down[layer])
    return rmsnorm(x, final_norm_g)
```

```cpp
#include <hip/hip_runtime.h>
#include <cstdio>
#include <cstdint>

#ifndef MK_DEBUG
#define MK_DEBUG 0
#endif
#ifndef MK_NLAUNCH
#define MK_NLAUNCH 1
#endif

namespace mk {
constexpr int S = 8192, D = 2048;
constexpr int NL = MK_DEBUG ? 2 : 4;
constexpr int HD = 128, NQ = 12, NKV = 4, WIN = 128;
constexpr int QDIM = 1536, KVDIM = 512, FDIM = 512, EV_IN = 3072, QKF_LD = 2560, MIX_LD_EV = 2560;
constexpr int CONVD = 1024, POOLD = 1024, OD_IN = 4096;
constexpr int NE = 16, EH = 1024, CAP = 1024;
constexpr float EPS = 1e-6f;
constexpr int NWAVES = 8, NTHREADS = 512;

typedef unsigned short bf16_t;
typedef short bf16x8 __attribute__((ext_vector_type(8)));
typedef short s16x4 __attribute__((ext_vector_type(4)));
typedef float f32x4 __attribute__((ext_vector_type(4)));
typedef float f32x2 __attribute__((ext_vector_type(2)));
typedef unsigned u32x4 __attribute__((ext_vector_type(4)));
typedef unsigned u32x2 __attribute__((ext_vector_type(2)));
#define LAS __attribute__((address_space(3)))
#define GAS __attribute__((address_space(1)))
#define LDS_WAIT() asm volatile("s_waitcnt lgkmcnt(0)" ::: "memory")
#define VM_WAIT() asm volatile("s_waitcnt vmcnt(0)" ::: "memory")

constexpr size_t MiB = 1u << 20;
constexpr size_t WS_CTL = 0, CTL_ZERO_BYTES = 1 * MiB;
constexpr size_t WS_AFF = 1 * MiB;
constexpr size_t WS_INV = WS_AFF + 512 * 1024;
constexpr size_t WS_IDX = 2 * MiB;
constexpr size_t WS_GATE = WS_IDX + 64 * 1024;
constexpr size_t WS_PAR = 3 * MiB;
constexpr int PAR_RELB = 0, PAR_SINK = 384, PAR_GMIX = 512, PAR_GFFN = PAR_GMIX + 4 * 2048, PAR_GFIN = PAR_GFFN + 4 * 2048, PAR_CONV = PAR_GFIN + 2048, PAR_ROUTER = 32768, PAR_PTRS = 32000;
constexpr size_t WS_FTC = WS_PAR + 768 * 1024;
constexpr size_t WS_FTA = WS_PAR + 896 * 1024;
constexpr size_t WS_H = 4 * MiB;
constexpr size_t WS_Z = 36 * MiB;
constexpr size_t WS_VT = 100 * MiB;
constexpr size_t WS_MIX = 108 * MiB;
constexpr size_t WS_TB = 148 * MiB;
constexpr size_t WS_POOLED = 164 * MiB;
constexpr size_t WS_HID = 180 * MiB;
constexpr size_t WS_Y = 212 * MiB;
constexpr size_t WS_W = 276 * MiB;
constexpr size_t SZ_EVIN = (size_t)EV_IN * D * 2, SZ_EVOUT = (size_t)D * MIX_LD_EV * 2, SZ_ODIN = (size_t)OD_IN * D * 2, SZ_ODOUT = (size_t)D * D * 2, SZ_POOL = (size_t)4 * 256 * 256 * 2;
constexpr size_t SZ_GU = (size_t)NE * 2048 * D * 2, SZ_DN = (size_t)NE * D * EH * 2;
constexpr size_t WS_EVIN = WS_W, WS_EVOUT = WS_EVIN + (NL / 2) * SZ_EVIN, WS_ODIN = WS_EVOUT + (NL / 2) * SZ_EVOUT, WS_ODOUT = WS_ODIN + (NL / 2) * SZ_ODIN,
                 WS_POOLW = WS_ODOUT + (NL / 2) * SZ_ODOUT, WS_GU = WS_POOLW + (NL / 2) * SZ_POOL, WS_DN = WS_GU + NL * SZ_GU, WS_END = WS_DN + NL * SZ_DN;
constexpr int CW_TMO = 0, CW_CODE = 1, CW_BAR = 4096;

constexpr int RING_BYTES = 131072;
constexpr int LDSCTL_OFF = RING_BYTES, MISC_OFF = LDSCTL_OFF + 320;
constexpr int LDS_BYTES = 163840;

__device__ __forceinline__ unsigned f2bf(float f) { unsigned u = __builtin_bit_cast(unsigned, f); return (u + 0x7fffu + ((u >> 16) & 1u)) >> 16; }
__device__ __forceinline__ unsigned pk2(float lo, float hi) { return f2bf(lo) | (f2bf(hi) << 16); }
typedef __bf16 bf16x2_t __attribute__((ext_vector_type(2)));
__device__ __forceinline__ unsigned cvt_pk_bf16(float lo, float hi) { const f32x2 v = {lo, hi}; return __builtin_bit_cast(unsigned, __builtin_convertvector(v, bf16x2_t)); }
__device__ __forceinline__ unsigned cvt_pk_bf16_v(float lo, float hi) { unsigned r; asm volatile("v_cvt_pk_bf16_f32 %0, %1, %2" : "=v"(r) : "v"(lo), "v"(hi)); return r; }
__device__ __forceinline__ float bf_lo(unsigned w) { return __builtin_bit_cast(float, w << 16); }
__device__ __forceinline__ float bf_hi(unsigned w) { return __builtin_bit_cast(float, w & 0xffff0000u); }
__device__ __forceinline__ int lane_id() { int l; asm volatile("v_mbcnt_lo_u32_b32 %0, -1, 0\n\tv_mbcnt_hi_u32_b32 %0, -1, %0" : "=v"(l)); return l; }
__device__ __forceinline__ float shx(float v, int o, int lane) { return __builtin_bit_cast(float, __builtin_amdgcn_ds_bpermute((lane ^ o) << 2, __builtin_bit_cast(int, v))); }
__device__ __forceinline__ int shxi(int v, int o, int lane) { return __builtin_amdgcn_ds_bpermute((lane ^ o) << 2, v); }
__device__ __forceinline__ float wave_sum(float v, int lane) {
#pragma unroll
    for (int o = 1; o < 64; o <<= 1) v += shx(v, o, lane);
    return v;
}
__device__ __forceinline__ int wave_sum_dpp(int v) {
    int t = v + __builtin_amdgcn_update_dpp(0, v, 0x111, 0xf, 0xf, true);
    t += __builtin_amdgcn_update_dpp(0, v, 0x112, 0xf, 0xf, true);
    t += __builtin_amdgcn_update_dpp(0, v, 0x113, 0xf, 0xf, true);
    t += __builtin_amdgcn_update_dpp(0, t, 0x114, 0xf, 0xe, true);
    t += __builtin_amdgcn_update_dpp(0, t, 0x118, 0xf, 0xc, true);
    t += __builtin_amdgcn_update_dpp(0, t, 0x142, 0xa, 0xf, true);
    t += __builtin_amdgcn_update_dpp(0, t, 0x143, 0xc, 0xf, true);
    return __builtin_amdgcn_readlane(t, 63);
}
__device__ __forceinline__ int wave_sum_i(int v, int lane) {
#pragma unroll
    for (int o = 1; o < 64; o <<= 1) v += shxi(v, o, lane);
    return v;
}

namespace pg8 {
constexpr int BM = 256, BK = 64, HALF = 128, HTB = HALF * BK * 2, STAGE_BYTES = 8 * HTB, NXCD = 8, WGM = 8;
__host__ __device__ __forceinline__ int lds_byte(int r, int c) { const int st = (r >> 4) * 2 + (c >> 5), rr = r & 15, cc = c & 31, ob = rr * 64 + cc * 2; return st * 1024 + (ob ^ (((ob >> 9) & 1) << 5)); }
__host__ __device__ __forceinline__ void stage_rc(int b, int& R, int& C) { const int st = b / 1024, sb = b % 1024, swz = sb ^ (((sb >> 9) & 1) << 5); R = (st >> 1) * 16 + swz / 64; C = (st & 1) * 32 + (swz % 64) / 2; }
__host__ __device__ __forceinline__ int perm32(int rho) { const int n = rho >> 4, i = rho & 15; return 8 * (i >> 2) + 4 * n + (i & 3); }

struct Unit { long offA, offB; int gio, pm, pn, grp, kind, half, hsel; };

struct Sched {
    long A, B, sA, sB;
    int tA, tB; int nM, nN, nG, G, c; const int* gidx;
    int nExtra;
    int nFull;
    __device__ __forceinline__ bool next(int i, Unit& u) const {
        const int nreg = nM * nN * nG, ntot = nreg + nExtra; const int L0 = i * G + c;
        if (L0 >= nFull + 2 * (ntot - nFull)) return false;
        const bool hf = L0 >= nFull; const int L = hf ? nFull + ((L0 - nFull) >> 1) : L0; const int hs = hf ? ((L0 - nFull) & 1) : 0;
        const bool ex = L >= nreg;
        int wgid = ex ? 0 : L; { const int q = nreg / NXCD, r = nreg % NXCD, xcd = wgid % NXCD, off = wgid / NXCD; wgid = (xcd < r ? xcd * (q + 1) : r * (q + 1) + (xcd - r) * q) + off; }
        int pm, pn, grp;
        if (nG == 1) {
            const int nig = WGM * nN, gid = wgid / nig, fm = gid * WGM, gsz = (nM - fm) < WGM ? (nM - fm) : WGM;
            pm = fm + ((wgid % nig) % gsz); pn = (wgid % nig) / gsz; grp = 0;
        } else { const int per = nM * nN; grp = wgid / per; const int r = wgid % per; pm = r % nM; pn = r / nM; }
        const int j = L - nreg;
        u.pm = ex ? (j & 1) : pm; u.pn = ex ? (j >> 1) : pn; u.grp = ex ? 0 : grp; u.kind = ex ? 1 : 0; u.half = hf ? 1 : 0; u.hsel = hs;
        u.gio = grp * (nM * BM) + pm * BM;
        const long ra = A + grp * sA + (gidx ? 0 : (long)pm * tA), rb = B + grp * sB + (long)pn * tB;
        u.offA = (ex ? B + (long)(nN + (j & 1)) * tB : ra) + (long)hs * ((ex ? tB : tA) >> 1); u.offB = ex ? A + (long)(j >> 1) * tA : rb;
        return true;
    }
};

struct EpiBf16 {
    static constexpr bool PERM = true, INIT_ACC = false, HALVES = true;
    bf16_t* O; int ldc; int gcol; bf16_t* O2; int ldc2;
    __device__ __forceinline__ void operator()(const f32x4 (&acc)[2][2][4][2], const Unit& u, int wr, int wc, int fr, int fq) const {
        bf16_t* base; int ld;
        if (u.kind) { base = O2 + (size_t)(u.pm * BM) * ldc2 + u.pn * BM; ld = ldc2; } else { base = O + (size_t)(u.pm * BM) * ldc + u.pn * BM + u.grp * gcol; ld = ldc; }
        bf16_t* rowp = base + (unsigned)((wr * 64 + fr + u.hsel * HALF) * ld + wc * 32 + 8 * fq);
#pragma unroll
        for (int ai = 0; ai < 2; ++ai) {
            if (ai == 1 && u.half) break;
#pragma unroll
            for (int m = 0; m < 4; ++m) {
#pragma unroll
                for (int bj = 0; bj < 2; ++bj) { const f32x4 v0 = acc[ai][bj][m][0], v1 = acc[ai][bj][m][1];
                    u32x4 w; w.x = cvt_pk_bf16(v0[0], v0[1]); w.y = cvt_pk_bf16(v0[2], v0[3]); w.z = cvt_pk_bf16(v1[0], v1[1]); w.w = cvt_pk_bf16(v1[2], v1[3]);
                    *(u32x4*)(rowp + bj * HALF) = w; }
                rowp += 16 * ld; asm volatile("" : "+v"(rowp)); }
            rowp += (HALF - 64) * ld; }
    }
};
struct EpiResF32 {
    static constexpr bool PERM = false, INIT_ACC = true, HALVES = false;
    const float* R; float* X; int ldc;
    __device__ __forceinline__ void init(f32x4 (&acc)[2][2][4][2], const Unit& u, int wr, int wc, int fr, int fq) const {
        const size_t off0 = (size_t)(u.pm * BM + wr * 64 + fr) * ldc + u.pn * BM + wc * 32 + 4 * fq;
#pragma unroll
        for (int ai = 0; ai < 2; ++ai)
#pragma unroll
            for (int m = 0; m < 4; ++m) { const size_t off = off0 + (size_t)(ai * HALF + m * 16) * ldc;
#pragma unroll
                for (int bj = 0; bj < 2; ++bj)
#pragma unroll
                    for (int n = 0; n < 2; ++n) acc[ai][bj][m][n] = *(const f32x4*)(R + off + bj * HALF + n * 16); }
    }
    __device__ __forceinline__ void operator()(const f32x4 (&acc)[2][2][4][2], const Unit& u, int wr, int wc, int fr, int fq) const {
        const size_t off0 = (size_t)(u.pm * BM + wr * 64 + fr) * ldc + u.pn * BM + wc * 32 + 4 * fq;
#pragma unroll
        for (int ai = 0; ai < 2; ++ai)
#pragma unroll
            for (int m = 0; m < 4; ++m) { const size_t off = off0 + (size_t)(ai * HALF + m * 16) * ldc;
#pragma unroll
                for (int bj = 0; bj < 2; ++bj)
#pragma unroll
                    for (int n = 0; n < 2; ++n) *(f32x4*)(X + off + bj * HALF + n * 16) = acc[ai][bj][m][n]; }
    }
};
__device__ __forceinline__ float silu_mul(float g, float u) { return g * u * __builtin_amdgcn_rcpf(1.0f + __expf(-g)); }
struct EpiGU {
    static constexpr bool PERM = true, INIT_ACC = false, HALVES = false;
    bf16_t* HID;
    __device__ __forceinline__ void operator()(const f32x4 (&acc)[2][2][4][2], const Unit& u, int wr, int wc, int fr, int fq) const {
        bf16_t* base = HID + ((size_t)u.grp * CAP + u.pm * BM + wr * 64 + fr) * EH + u.pn * HALF + wc * 32 + 8 * fq;
#pragma unroll
        for (int ai = 0; ai < 2; ++ai)
#pragma unroll
            for (int m = 0; m < 4; ++m) { const f32x4 g0 = acc[ai][0][m][0], g1 = acc[ai][0][m][1], u0 = acc[ai][1][m][0], u1 = acc[ai][1][m][1];
                u32x4 w; w.x = cvt_pk_bf16(silu_mul(g0[0], u0[0]), silu_mul(g0[1], u0[1])); w.y = cvt_pk_bf16(silu_mul(g0[2], u0[2]), silu_mul(g0[3], u0[3]));
                w.z = cvt_pk_bf16(silu_mul(g1[0], u1[0]), silu_mul(g1[1], u1[1])); w.w = cvt_pk_bf16(silu_mul(g1[2], u1[2]), silu_mul(g1[3], u1[3]));
                *(u32x4*)(base + (size_t)(ai * HALF + m * 16) * EH) = w; }
    }
};
struct EpiDown {
    static constexpr bool PERM = true, INIT_ACC = false, HALVES = false;
    bf16_t* Y; const float* gate;
    __device__ __forceinline__ void operator()(const f32x4 (&acc)[2][2][4][2], const Unit& u, int wr, int wc, int fr, int fq) const {
        const int row0 = u.grp * CAP + u.pm * BM + wr * 64 + fr;
        bf16_t* base = Y + (size_t)row0 * D + u.pn * BM + wc * 32 + 8 * fq;
#pragma unroll
        for (int ai = 0; ai < 2; ++ai)
#pragma unroll
            for (int m = 0; m < 4; ++m) { const float gt = gate[row0 + ai * HALF + m * 16]; bf16_t* rowp = base + (size_t)(ai * HALF + m * 16) * D;
#pragma unroll
                for (int bj = 0; bj < 2; ++bj) { const f32x4 v0 = acc[ai][bj][m][0] * gt, v1 = acc[ai][bj][m][1] * gt;
                    u32x4 w; w.x = cvt_pk_bf16(v0[0], v0[1]); w.y = cvt_pk_bf16(v0[2], v0[3]); w.z = cvt_pk_bf16(v1[0], v1[1]); w.w = cvt_pk_bf16(v1[2], v1[3]);
                    *(u32x4*)(rowp + bj * HALF) = w; } }
    }
};

template <class Epi, bool GATHER>
__device__ __forceinline__ void gemm_phase(LAS unsigned char* lds, const int wid_in, const char* wsb, const int K, const int lda, const int ldb, const Sched& S, const Epi& E) {
    int wid = wid_in; asm volatile("" : "+s"(wid));
    const int lane = lane_id();
    const int tid = wid * 64 + lane, wr = wid >> 2, wc = wid & 3, fr = lane & 15, fq = lane >> 4;
    const int nt = K / BK;
    unsigned voffA[2][2], voffB[2];
#pragma unroll
    for (int i = 0; i < 2; ++i) { int R, C; stage_rc(tid * 16 + i * 8192, R, C); const int Rb = Epi::PERM ? ((R & ~31) + perm32(R & 31)) : R;
        voffA[0][i] = (unsigned)(R * lda + C) * 2u; voffA[1][i] = voffA[0][i]; voffB[i] = (unsigned)(Rb * ldb + C) * 2u; }
    const size_t hstepA = GATHER ? (size_t)0 : (size_t)HALF * lda * 2;
    const size_t kstep = (size_t)(BK * 2);
    const size_t hstepB = (size_t)HALF * ldb * 2;
    const unsigned ldsw = (unsigned)wid * 1024u;
    const int aoff = lds_byte(wr * 64 + fr, fq * 8), boff = lds_byte(wc * 32 + fr, fq * 8);
#define PG8_SA(b, h) (((b) * 2 + (h)) * HTB)
#define PG8_SB(b, h) ((4 + (b) * 2 + (h)) * HTB)
#define PG8_STAGEA(bufoff, gbase, h) do { _Pragma("unroll") for (int _i = 0; _i < 2; ++_i) \
        __builtin_amdgcn_global_load_lds((const unsigned*)((const char*)(gbase) + (h) * hstepA + voffA[GATHER ? (h) : 0][_i]), (LAS unsigned*)(lds + (bufoff) + ldsw + _i * 8192), 16, 0, 0); } while (0)
#define PG8_STAGEB(bufoff, gbase) do { _Pragma("unroll") for (int _i = 0; _i < 2; ++_i) \
        __builtin_amdgcn_global_load_lds((const unsigned*)((const char*)(gbase) + voffB[_i]), (LAS unsigned*)(lds + (bufoff) + ldsw + _i * 8192), 16, 0, 0); } while (0)
#define PG8_LDA(dst, b, h) do { _Pragma("unroll") for (int m = 0; m < 4; ++m) _Pragma("unroll") for (int k = 0; k < 2; ++k) dst[m][k] = *(const LAS bf16x8*)(lds + PG8_SA(b, h) + aoff + m * 2048 + k * 1024); } while (0)
#define PG8_LDB(dst, b, h) do { _Pragma("unroll") for (int n = 0; n < 2; ++n) _Pragma("unroll") for (int k = 0; k < 2; ++k) dst[n][k] = *(const LAS bf16x8*)(lds + PG8_SB(b, h) + boff + n * 2048 + k * 1024); } while (0)
#define PG8_MMA(ai, bj, At, Bt) do { __builtin_amdgcn_s_setprio(1); _Pragma("unroll") for (int m = 0; m < 4; ++m) _Pragma("unroll") for (int n = 0; n < 2; ++n) _Pragma("unroll") for (int k = 0; k < 2; ++k) \
        acc[ai][bj][m][n] = __builtin_amdgcn_mfma_f32_16x16x32_bf16(Bt[n][k], At[m][k], acc[ai][bj][m][n], 0, 0, 0); __builtin_amdgcn_s_setprio(0); } while (0)
#define PG8_WAIT_V(n) asm volatile("s_waitcnt vmcnt(" #n ")" ::: "memory")
#define PG8_WAIT_L(n) asm volatile("s_waitcnt lgkmcnt(" #n ")" ::: "memory")
#define PG8_BAR __builtin_amdgcn_s_barrier()
#define PG8_SCHED __builtin_amdgcn_sched_barrier(0)
#define PG8_GIDX(dst, uu) do { _Pragma("unroll") for (int _i = 0; _i < 2; ++_i) { int _R, _C; stage_rc(tid * 16 + _i * 8192, _R, _C); _Pragma("unroll") for (int _h = 0; _h < 2; ++_h) \
        dst[_h][_i] = (unsigned)(S.gidx[(uu).gio + _R + _h * HALF] * lda + _C) * 2u; } } while (0)
    Unit cur, nxt; int ui = 0;
    if (!S.next(0, cur)) return;
    f32x4 acc[2][2][4][2];
    if constexpr (Epi::INIT_ACC) { E.init(acc, cur, wr, wc, fr, fq); } else {
#pragma unroll
    for (int a = 0; a < 2; ++a)
#pragma unroll
        for (int b = 0; b < 2; ++b)
#pragma unroll
            for (int m = 0; m < 4; ++m)
#pragma unroll
                for (int n = 0; n < 2; ++n) acc[a][b][m][n] = (f32x4){0.f, 0.f, 0.f, 0.f};
    }
    bf16x8 At[4][2], B0[2][2], B1[2][2];
    const char* cA = wsb + cur.offA; const char* cB = wsb + cur.offB;
    if constexpr (GATHER) { PG8_GIDX(voffA, cur); }
    PG8_STAGEB(PG8_SB(0, 0), cB); PG8_STAGEB(PG8_SB(0, 1), cB + hstepB); PG8_STAGEA(PG8_SA(0, 0), cA, 0); PG8_STAGEA(PG8_SA(0, 1), cA, 1);
    if (wr == 1) PG8_BAR;
    PG8_WAIT_V(2); PG8_BAR;
    PG8_STAGEB(PG8_SB(1, 0), cB + kstep); PG8_STAGEA(PG8_SA(1, 0), cA + kstep, 0); PG8_STAGEB(PG8_SB(1, 1), cB + hstepB + kstep);
    PG8_WAIT_V(6); PG8_BAR;
    for (;;) {
        const bool has_next = S.next(ui + 1, nxt);
        const char* nA = has_next ? wsb + nxt.offA : cA; const char* nB = has_next ? wsb + nxt.offB : cB;
        for (int t = 0; t < nt; t += 2) {
            const bool last = (t == nt - 2);
            const char* a1 = cA + (size_t)(t + 1) * kstep;
            const char* a2 = last ? nA : cA + (size_t)(t + 2) * kstep; const char* b2 = last ? nB : cB + (size_t)(t + 2) * kstep;
            const char* a3 = a2 + kstep; const char* b3 = b2 + kstep;
            unsigned nv[2][2];
            if constexpr (GATHER) { if (last && has_next) { PG8_GIDX(nv, nxt); } }
            PG8_LDB(B0, 0, 0); PG8_LDB(B1, 0, 1); PG8_SCHED; PG8_LDA(At, 0, 0); PG8_STAGEA(PG8_SA(1, 1), a1, 1);
            if constexpr (GATHER) { if (last && has_next) {
#pragma unroll
                for (int _h = 0; _h < 2; ++_h)
#pragma unroll
                    for (int _i = 0; _i < 2; ++_i) voffA[_h][_i] = nv[_h][_i]; } }
            PG8_WAIT_V(8); PG8_WAIT_L(0); PG8_BAR; PG8_MMA(0, 0, At, B0); PG8_MMA(0, 1, At, B1); PG8_BAR; PG8_SCHED;
            PG8_LDA(At, 0, 1); PG8_STAGEB(PG8_SB(0, 0), b2); PG8_STAGEB(PG8_SB(0, 1), b2 + hstepB); PG8_STAGEA(PG8_SA(0, 0), a2, 0);
            PG8_WAIT_V(8); PG8_WAIT_L(0); PG8_BAR; if (!(Epi::HALVES && cur.half)) { PG8_MMA(1, 0, At, B0); PG8_MMA(1, 1, At, B1); } PG8_BAR; PG8_SCHED;
            PG8_LDB(B0, 1, 0); PG8_LDB(B1, 1, 1); PG8_SCHED; PG8_LDA(At, 1, 0); PG8_STAGEA(PG8_SA(0, 1), a2, 1);
            PG8_WAIT_V(8); PG8_WAIT_L(0); PG8_BAR; PG8_MMA(0, 0, At, B0); PG8_MMA(0, 1, At, B1); PG8_BAR; PG8_SCHED;
            PG8_LDA(At, 1, 1); PG8_STAGEB(PG8_SB(1, 0), b3); PG8_STAGEB(PG8_SB(1, 1), b3 + hstepB); PG8_STAGEA(PG8_SA(1, 0), a3, 0);
            PG8_WAIT_V(8); PG8_WAIT_L(0); PG8_BAR; if (!(Epi::HALVES && cur.half)) { PG8_MMA(1, 0, At, B0); PG8_MMA(1, 1, At, B1); } PG8_BAR; PG8_SCHED;
        }
        if (wr == 0) PG8_BAR;
        { const int le = lane_id(); E(acc, cur, wr, wc, le & 15, le >> 4); }
        if (!has_next) break;
        if constexpr (Epi::INIT_ACC) { E.init(acc, nxt, wr, wc, fr, fq); } else {
#pragma unroll
        for (int a = 0; a < 2; ++a)
#pragma unroll
            for (int b = 0; b < 2; ++b)
#pragma unroll
                for (int m = 0; m < 4; ++m)
#pragma unroll
                    for (int n = 0; n < 2; ++n) acc[a][b][m][n] = (f32x4){0.f, 0.f, 0.f, 0.f};
        }
        cur = nxt; cA = nA; cB = nB; ++ui;
        if (wr == 1) PG8_BAR;
    }
    PG8_WAIT_V(0);
    PG8_BAR;
#undef PG8_SA
#undef PG8_SB
#undef PG8_STAGEA
#undef PG8_STAGEB
#undef PG8_LDA
#undef PG8_LDB
#undef PG8_MMA
#undef PG8_WAIT_V
#undef PG8_WAIT_L
#undef PG8_BAR
#undef PG8_SCHED
#undef PG8_GIDX
}
}
#define XB_TMO      128
#define XB_XCNT(j)  (256  + 64 * (j))
#define XB_XSUB(j)  (1280 + 64 * (j))
#define XB_XGEN(j)  (2304 + 64 * (j))
#define XB_TOP      3328
#define XB_TOPGEN   3392
#define XCD_BAR_WORDS 3456
#define XB_SPIN_CAP (1u << 18)
__device__ __forceinline__ unsigned xb_ld(unsigned* p)              { return __hip_atomic_load(p, __ATOMIC_RELAXED, __HIP_MEMORY_SCOPE_AGENT); }
__device__ __forceinline__ unsigned xb_add(unsigned* p, unsigned v) { return __hip_atomic_fetch_add(p, v, __ATOMIC_RELAXED, __HIP_MEMORY_SCOPE_AGENT); }
__device__ __forceinline__ unsigned xb_xcc_id() { return (unsigned)__builtin_amdgcn_s_getreg((3 << 11) | 20) & 0xFu; }
#define XB_SPIN(cond, bar) do { unsigned _sp = 0; while (cond) { __builtin_amdgcn_s_sleep(1); \
    if ((++_sp & 255u) == 0u) { if (xb_ld(&(bar)[XB_TMO])) break; if (_sp > XB_SPIN_CAP) { atomicAdd(&(bar)[XB_TMO], 1u); break; } } } } while (0)
struct XcdBarrier { unsigned* bar; unsigned x; volatile LAS unsigned* st; };
__device__ __forceinline__ XcdBarrier xcd_barrier_post(unsigned* bar, volatile LAS unsigned* st, bool leader) {
    XcdBarrier b; b.bar = bar; b.x = xb_xcc_id(); b.st = st;
    if (leader) (void)xb_add(&bar[XB_XCNT(b.x)], 1u);
    return b;
}
__device__ __forceinline__ void xcd_barrier_complete(unsigned* bar, unsigned x, unsigned& nloc, unsigned& nx) {
    const unsigned G = gridDim.x * gridDim.y * gridDim.z;
    unsigned sum, cnt, mine, sp = 0u;
    for (;;) {
        sum = 0u; cnt = 0u; mine = 0u;
#pragma unroll
        for (unsigned j = 0; j < 16; ++j) { const unsigned c = xb_ld(&bar[XB_XCNT(j)]); sum += c; cnt += (c > 0u) ? 1u : 0u; mine = (j == x) ? c : mine; }
        if (sum == G) break;
        __builtin_amdgcn_s_sleep(1);
        if ((++sp & 255u) == 0u) { if (xb_ld(&bar[XB_TMO])) break; if (sp > XB_SPIN_CAP) { atomicAdd(&bar[XB_TMO], 1u); break; } }
    }
    nloc = mine > 0u ? mine : 1u; nx = cnt > 0u ? cnt : 1u;
}
__device__ __forceinline__ void xcd_barrier(const XcdBarrier& b, bool leader) {
    asm volatile("s_waitcnt vmcnt(0)" ::: "memory");
    __syncthreads();
    if (leader) {
        unsigned* bar = b.bar;
        __builtin_amdgcn_s_waitcnt(0);
        unsigned nloc = b.st[0], nx = b.st[1];
        if (nloc == 0u) { xcd_barrier_complete(bar, b.x, nloc, nx); b.st[0] = nloc; b.st[1] = nx; }
        const unsigned old = xb_add(&bar[XB_XSUB(b.x)], 1u);
        const unsigned gen = old / nloc;
        if (old + 1u == (gen + 1u) * nloc) {
            __builtin_amdgcn_fence(__ATOMIC_RELEASE, "agent");
            asm volatile("s_waitcnt vmcnt(0)" ::: "memory");
            const unsigned og = xb_add(&bar[XB_TOP], 1u);
            const unsigned tg = og / nx;
            if (og + 1u == (tg + 1u) * nx) xb_add(&bar[XB_TOPGEN], 1u);
            else XB_SPIN(xb_ld(&bar[XB_TOPGEN]) == tg, bar);
            __builtin_amdgcn_fence(__ATOMIC_ACQUIRE, "agent");
            xb_add(&bar[XB_XGEN(b.x)], 1u);
            asm volatile("s_waitcnt vmcnt(0)" ::: "memory");
        } else {
            XB_SPIN(xb_ld(&bar[XB_XGEN(b.x)]) == gen, bar);
            __builtin_amdgcn_fence(__ATOMIC_ACQUIRE, "agent");
            asm volatile("s_waitcnt vmcnt(0)" ::: "memory");
        }
    }
    __syncthreads();
}

struct Args {
    const float* x_in; const float* rel_bias; const float* norm_mix_g; const float* norm_ffn_g; const float* final_g;
    const float* ev_w_in; const float* ev_sink; const float* ev_w_out;
    const float* od_w_in; const float* od_conv_w; const float* od_pool_w; const float* od_pool_scale; const float* od_w_out;
    const float* moe_w_router; const float* moe_w_gate; const float* moe_w_up; const float* moe_w_down;
    float* X; unsigned char* ws; int ph_lo, ph_hi;
};
struct Ctx { LAS unsigned char* lds; int tid, lane, wave, vcu, G; };

__device__ __forceinline__ int t5_bucket(int rel) {
    const int n = rel < 0 ? -rel : rel; int b;
    if (n < 8) b = n; else if (n < 12) b = 8; else if (n < 16) b = 9; else if (n < 23) b = 10; else if (n < 32) b = 11;
    else if (n < 46) b = 12; else if (n < 64) b = 13; else if (n < 91) b = 14; else b = 15;
    return b + (rel > 0 ? 16 : 0);
}

__device__ __forceinline__ void cvt_item(const float* W, int ldw, int k0, int n0, bf16_t* WT, int ldd, int drow, const float* nscale, LAS float* scr, int lane) {
    const int lr = lane >> 4, lc = (lane & 15) * 4;
    f32x4 v[16];
    const float* src = W + (size_t)(k0 + lr) * ldw + n0 + lc;
#pragma unroll
    for (int i = 0; i < 16; ++i) v[i] = __builtin_nontemporal_load((const GAS f32x4*)(src + (size_t)(4 * i) * ldw));
#pragma unroll
    for (int i = 0; i < 16; ++i) { const int row = 4 * i + lr; *(LAS f32x4*)(scr + row * 64 + (lc ^ (4 * ((row >> 3) & 7)))) = v[i]; }
    LDS_WAIT(); asm volatile("" ::: "memory");
    const int c = lane & 7;
#pragma unroll
    for (int j = 0; j < 8; ++j) { const int n = (lane >> 3) + 8 * j; const LAS float* sp = scr + (8 * c) * 64 + (n ^ (4 * c)); const float sc = nscale ? nscale[n0 + n] : 1.0f;
        u32x4 o; o.x = pk2(sp[0 * 64] * sc, sp[1 * 64] * sc); o.y = pk2(sp[2 * 64] * sc, sp[3 * 64] * sc); o.z = pk2(sp[4 * 64] * sc, sp[5 * 64] * sc); o.w = pk2(sp[6 * 64] * sc, sp[7 * 64] * sc);
        __builtin_nontemporal_store(o, (GAS u32x4*)(WT + (size_t)(drow + n) * ldd + k0 + 8 * c)); }
    LDS_WAIT(); asm volatile("" ::: "memory");
}
__device__ __forceinline__ void norm_store_bf16(const f32x4 (&v)[8], const float* g, bf16_t* orow, int lane) {
    float ss = 0.f;
#pragma unroll
    for (int j = 0; j < 8; ++j) ss += (v[j].x * v[j].x + v[j].y * v[j].y) + (v[j].z * v[j].z + v[j].w * v[j].w);
    const float r = rsqrtf(wave_sum(ss, lane) * (1.0f / D) + EPS);
    GAS u32x2* o8 = (GAS u32x2*)orow + lane; const GAS f32x4* g4 = (const GAS f32x4*)g + lane;
#pragma unroll
    for (int j = 0; j < 8; ++j) { const f32x4 w = g4[64 * j]; u32x2 o; o.x = pk2(v[j].x * r * w.x, v[j].y * r * w.y); o.y = pk2(v[j].z * r * w.z, v[j].w * r * w.w); o8[64 * j] = o; }
}

#ifndef MK_ODDMIX2
#define MK_ODDMIX2 1
#endif
#ifndef MK_PV3
#define MK_PV3 1
#endif
#ifndef MK_UPHOST
#define MK_UPHOST 1
#endif
#ifndef MK_JITCVT
#define MK_JITCVT 1
#endif
__device__ __forceinline__ void moe_cvt(const Args& a, const Ctx& c, int l, int part, int rank0 = -1, int nrank = 0, int it_lo = 0, int it_hi = NE * 16 * 32) {
    LAS float* scr = (LAS float*)(c.lds + c.wave * 16384);
    int gw = (rank0 >= 0 ? rank0 : c.vcu) * NWAVES + c.wave; asm volatile("" : "+s"(gw));
    const int NGW = (rank0 >= 0 ? nrank : c.G) * NWAVES;
    unsigned char* ws = a.ws;
    const float* wsrc = (const float*)(((const unsigned long long*)((const float*)(ws + WS_PAR) + PAR_PTRS))[part]);
    if (part < 2) {
        for (int it = it_lo + gw; it < it_hi; it += NGW) { const int le = l * NE + it / 512, r2 = it % 512, kb = r2 / 16, nb = r2 % 16;
            const float* src = wsrc + (size_t)le * D * EH; const int n0 = nb * 64;
            cvt_item(src, EH, kb * 64, n0, (bf16_t*)(ws + WS_GU) + (size_t)le * 2048 * D, D, (n0 >> 7) * 256 + part * 128 + (n0 & 127), nullptr, scr, c.lane); }
    } else {
        for (int it = it_lo + gw; it < it_hi; it += NGW) { const int le = l * NE + it / 512, r = it % 512, kb = r / 32, nb = r % 32;
            cvt_item(wsrc + (size_t)le * EH * D, D, kb * 64, nb * 64, (bf16_t*)(ws + WS_DN) + (size_t)le * D * EH, EH, nb * 64, nullptr, scr, c.lane); }
    }
}

__device__ __forceinline__ u32x4 fftc_bfrag(const LAS float* c128, int w, int ks, int t, int fr, int fq) {
    const int pq = w >> 2, k2 = 32 * (w & 3) + 16 * t + fr; unsigned wv[4];
#pragma unroll
    for (int jj = 0; jj < 4; ++jj) { float v[2];
#pragma unroll
        for (int e = 0; e < 2; ++e) { const int j = 2 * jj + e; const int ss = 32 * ks + 16 * (j >> 2) + 4 * fq + (j & 3); const int ri = ss >> 7, s2 = ss & 127; const int m = (s2 * k2) & 127;
            const float cs = c128[m], sn = c128[(m - 32) & 127];
            v[e] = (pq == 0) ? (ri == 0 ? cs : sn) : (ri == 0 ? -sn : cs); }
        wv[jj] = pk2(v[0], v[1]); }
    u32x4 ww; ww.x = wv[0]; ww.y = wv[1]; ww.z = wv[2]; ww.w = wv[3]; return ww;
}
__device__ __forceinline__ void ffta_bfrag(const LAS float* c128, int jp, int ks, int fr, int fq, u32x4& wr_, u32x4& wi_) {
    unsigned re[4], im[4];
#pragma unroll
    for (int jj = 0; jj < 4; ++jj) { float cr[2], ci[2];
#pragma unroll
        for (int e = 0; e < 2; ++e) { const int j = 2 * jj + e; const int s1 = 32 * ks + 16 * (j >> 2) + 4 * fq + (j & 3); const int m = (s1 * (16 * jp + fr)) & 63; cr[e] = c128[2 * m]; ci[e] = -c128[2 * ((m - 16) & 63)]; }
        re[jj] = pk2(cr[0], cr[1]); im[jj] = pk2(ci[0], ci[1]); }
    wr_.x = re[0]; wr_.y = re[1]; wr_.z = re[2]; wr_.w = re[3]; wi_.x = im[0]; wi_.y = im[1]; wi_.z = im[2]; wi_.w = im[3];
}

__device__ __forceinline__ void p0_prologue(const Args& a, const Ctx& c) {
    LAS float* scr = (LAS float*)(c.lds + c.wave * 16384);
    const int gw = c.vcu * NWAVES + c.wave, NGW = c.G * NWAVES;
    unsigned char* ws = a.ws;
    LAS float* ctab = (LAS float*)(c.lds + RING_BYTES + 1024);
    __syncthreads();
    if (c.tid < 128) { float sn, cs; sincospif((float)c.tid * (1.0f / 64.0f), &sn, &cs); ctab[c.tid] = cs; }
    __syncthreads();
    if (c.vcu < 8) { const int ks = c.vcu;
#pragma unroll
        for (int t = 0; t < 2; ++t) ((GAS u32x4*)(ws + WS_FTC))[((c.wave * 8 + ks) * 2 + t) * 64 + c.lane] = fftc_bfrag(ctab, c.wave, ks, t, c.lane & 15, c.lane >> 4);
    } else if (c.vcu == 8) { u32x4 wr_, wi_; ffta_bfrag(ctab, c.wave >> 1, c.wave & 1, c.lane & 15, c.lane >> 4, wr_, wi_);
        ((GAS u32x4*)(ws + WS_FTA))[(c.wave * 2 + 0) * 64 + c.lane] = wr_; ((GAS u32x4*)(ws + WS_FTA))[(c.wave * 2 + 1) * 64 + c.lane] = wi_; }
#pragma unroll 1
    for (int pass = 0; pass < 2; ++pass) {
    if ((pass == 0) == (c.wave < 4)) {
        LAS float* sw = (LAS float*)(c.lds + c.wave * 16384);
        for (int it = gw; it < (NL / 2) * 4 * 64 * 4; it += NGW) {
            const int i = it / 1024, r = it % 1024, g = r / 256, nb = (r % 256) / 4, jq = r % 4;
            const float* wsrc = a.ev_w_out + (size_t)i * D * D + (size_t)(QDIM + 128 * g) * D + nb * 32;
            const int n = c.lane & 31, jb = jq * 64 + (c.lane >> 5) * 32;
            float accv[32];
#pragma unroll
            for (int q = 0; q < 32; ++q) accv[q] = 0.f;
            for (int lp = 0; lp < 2; ++lp) {
#pragma unroll 8
                for (int q = 0; q < 32; ++q) { const int ll = 2 * q + (c.lane >> 5); sw[ll * 32 + n] = wsrc[(size_t)(lp * 64 + ll) * D + n]; }
                LDS_WAIT(); asm volatile("" ::: "memory");
                for (int ll = 0; ll < 64; ++ll) { const float wv = sw[ll * 32 + n]; const int l = lp * 64 + ll;
#pragma unroll
                    for (int q = 0; q < 32; ++q) { const int j = jb + q; const int m = ((j & 127) * l) & 127; const float cf = (j < 128) ? ctab[m] : ctab[(m - 32) & 127]; accv[q] = fmaf(cf, wv, accv[q]); } }
                LDS_WAIT(); asm volatile("" ::: "memory");
            }
            bf16_t* dst = (bf16_t*)(ws + WS_EVOUT + i * SZ_EVOUT) + (size_t)(nb * 32 + n) * MIX_LD_EV + QDIM + g * 256 + jb;
#pragma unroll
            for (int q = 0; q < 4; ++q) { u32x4 o; o.x = pk2(accv[8 * q] * (1.f / 1024.f), accv[8 * q + 1] * (1.f / 1024.f)); o.y = pk2(accv[8 * q + 2] * (1.f / 1024.f), accv[8 * q + 3] * (1.f / 1024.f));
                o.z = pk2(accv[8 * q + 4] * (1.f / 1024.f), accv[8 * q + 5] * (1.f / 1024.f)); o.w = pk2(accv[8 * q + 6] * (1.f / 1024.f), accv[8 * q + 7] * (1.f / 1024.f)); *(GAS u32x4*)(dst + 8 * q) = o; }
        }
    }
    if (pass == 0) {
    for (int it = gw; it < (NL / 2) * 32 * 48; it += NGW) { const int i = it / (32 * 48), r = it % (32 * 48), kb = r / 48, nb = r % 48;
        const int n0 = nb * 64; const int drow = n0 < 2048 ? n0 : (n0 < 2560 ? n0 + 512 : n0 - 512);
        cvt_item(a.ev_w_in + (size_t)i * D * EV_IN, EV_IN, kb * 64, n0, (bf16_t*)(ws + WS_EVIN + i * SZ_EVIN), D, drow, nullptr, scr, c.lane); }
    for (int it = gw; it < (NL / 2) * 24 * 32; it += NGW) { const int i = it / (24 * 32), r = it % (24 * 32), kb = r / 32, nb = r % 32;
        cvt_item(a.ev_w_out + (size_t)i * D * D, D, kb * 64, nb * 64, (bf16_t*)(ws + WS_EVOUT + i * SZ_EVOUT), MIX_LD_EV, nb * 64, nullptr, scr, c.lane); }
    for (int it = gw; it < (NL / 2) * 32 * 64; it += NGW) { const int i = it / (32 * 64), r = it % (32 * 64), kb = r / 64, nb = r % 64;
        cvt_item(a.od_w_in + (size_t)i * D * OD_IN, OD_IN, kb * 64, nb * 64, (bf16_t*)(ws + WS_ODIN + i * SZ_ODIN), D, nb * 64, nullptr, scr, c.lane); }
    for (int it = gw; it < (NL / 2) * 32 * 32; it += NGW) { const int i = it / (32 * 32), r = it % (32 * 32), kb = r / 32, nb = r % 32;
        cvt_item(a.od_w_out + (size_t)i * D * D, D, kb * 64, nb * 64, (bf16_t*)(ws + WS_ODOUT + i * SZ_ODOUT), D, nb * 64, nullptr, scr, c.lane); }
    for (int it = gw; it < (NL / 2) * 4 * 4 * 4; it += NGW) { const int ig = it / 16, i = ig / 4, g = ig % 4, r = it % 16, kb = r / 4, nb = r % 4;
        cvt_item(a.od_pool_w + ((size_t)i * 4 + g) * 65536, 256, kb * 64, nb * 64, (bf16_t*)(ws + WS_POOLW + i * SZ_POOL) + g * 65536, 256, nb * 64, a.od_pool_scale + i * POOLD + g * 256, scr, c.lane); }
    }
    }
    __syncthreads();
    {
        float* par = (float*)(ws + WS_PAR); const int gt = c.vcu * NTHREADS + c.tid, NGT = c.G * NTHREADS;
        if (gt == 0) { unsigned long long* pp = (unsigned long long*)(par + PAR_PTRS); pp[0] = (unsigned long long)a.moe_w_gate; pp[1] = (unsigned long long)a.moe_w_up; pp[2] = (unsigned long long)a.moe_w_down; }
        for (int i = gt; i < 384; i += NGT) par[PAR_RELB + i] = a.rel_bias[i];
        for (int i = gt; i < (NL / 2) * NQ; i += NGT) par[PAR_SINK + i] = a.ev_sink[i];
        for (int i = gt; i < NL * D; i += NGT) { par[PAR_GMIX + i] = a.norm_mix_g[i]; par[PAR_GFFN + i] = a.norm_ffn_g[i]; }
        for (int i = gt; i < D; i += NGT) par[PAR_GFIN + i] = a.final_g[i];
        for (int i = gt; i < (NL / 2) * 3 * CONVD; i += NGT) par[PAR_CONV + i] = a.od_conv_w[i];
        for (int i = gt; i < NL * D * NE; i += NGT) { const int l = i / (D * NE), r = i % (D * NE), e = r / D, d = r % D; par[PAR_ROUTER + i] = a.moe_w_router[(size_t)l * D * NE + d * NE + e]; }
    }
    for (int m = gw; m < S; m += 2 * NGW) { const int m1 = (m + NGW) < S ? m + NGW : m;
        const GAS f32x4* xa = (const GAS f32x4*)(a.x_in + (size_t)m * D) + c.lane; const GAS f32x4* xb = (const GAS f32x4*)(a.x_in + (size_t)m1 * D) + c.lane; f32x4 va[8], vb[8];
#pragma unroll
        for (int j = 0; j < 8; ++j) { va[j] = xa[64 * j]; vb[j] = xb[64 * j]; }
        norm_store_bf16(va, a.norm_mix_g, (bf16_t*)(ws + WS_H) + (size_t)m * D, c.lane);
        if (m1 != m) norm_store_bf16(vb, a.norm_mix_g, (bf16_t*)(ws + WS_H) + (size_t)m1 * D, c.lane); }
}

__device__ __forceinline__ void attn_unit(const Args& a, const Ctx& c, int layer_i, int blk, int kvh) {
    const bf16_t* QKF = (const bf16_t*)(a.ws + WS_Z); const bf16_t* VT = (const bf16_t*)(a.ws + WS_VT); bf16_t* MIX = (bf16_t*)(a.ws + WS_MIX);
    LAS unsigned char* band = c.lds;
    LAS float* bt = (LAS float*)(c.lds + 98304);
    const float* par = (const float*)(a.ws + WS_PAR);
    const int kb0 = 128 * (blk - 1);
    bf16x8 qfa[3][4];
    { const int fr_ = c.lane & 15, fq_ = c.lane >> 4; unsigned qoff = (unsigned)(((blk * 8 + c.wave) * 16 + fr_) * QKF_LD + kvh * 3 * HD + 8 * fq_) * 2u; asm volatile("" : "+v"(qoff));
#pragma unroll
      for (int hh = 0; hh < 3; ++hh)
#pragma unroll
          for (int ks = 0; ks < 4; ++ks) qfa[hh][ks] = *(const GAS bf16x8*)((const GAS char*)QKF + (size_t)qoff + hh * HD * 2 + 64 * ks); }
    __syncthreads();
    u32x4 kreg[12];
#pragma unroll
    for (int p = 0; p < 12; ++p) { const int id = c.tid + NTHREADS * p, row = id >> 4, ch = id & 15, key = kb0 + row; const int kc = key < 0 ? 0 : (key > S - 1 ? S - 1 : key);
        kreg[p] = *(const GAS u32x4*)(QKF + (size_t)kc * QKF_LD + QDIM + kvh * HD + ch * 8); }
    for (int i = c.tid; i < 3 * 257; i += NTHREADS) { const int hh = i / 257, r = i % 257; bt[hh * 260 + r] = par[PAR_RELB + t5_bucket(r - 128) * NQ + kvh * 3 + hh] * 1.4426950408889634f; }
#pragma unroll
    for (int p = 0; p < 12; ++p) { const int id = c.tid + NTHREADS * p, row = id >> 4, ch = id & 15, key = kb0 + row;
        if (key >= 0 && key < S) *(LAS u32x4*)(band + row * 256 + ((ch ^ (row & 15)) << 4)) = kreg[p]; }
    __syncthreads();
    const int fr = c.lane & 15, fq = c.lane >> 4, w = c.wave;
    const int q0 = (blk * 8 + w) * 16;
    unsigned pw[3][9][4]; float inv[3];
#pragma unroll
    for (int hh = 0; hh < 3; ++hh) {
        const int h = kvh * 3 + hh; const float snk = par[PAR_SINK + layer_i * NQ + h] * 1.4426950408889634f;
        bf16x8 qf[4];
#pragma unroll
        for (int ks = 0; ks < 4; ++ks) qf[ks] = qfa[hh][ks];
        f32x4 s[17];
#pragma unroll
        for (int kt = 0; kt < 17; ++kt) {
            const int key0 = q0 - WIN + 16 * kt;
            f32x4 acc = (f32x4){0.f, 0.f, 0.f, 0.f};
            if (key0 >= 0 && key0 < S) {
                const LAS unsigned char* kp = band + (16 * (w + kt) + fr) * 256;
#pragma unroll
                for (int ks = 0; ks < 4; ++ks) { const bf16x8 kf = *(const LAS bf16x8*)(kp + (((4 * ks + fq) ^ fr) << 4)); acc = __builtin_amdgcn_mfma_f32_16x16x32_bf16(kf, qf[ks], acc, 0, 0, 0); }
#pragma unroll
                for (int r = 0; r < 4; ++r) { const int rel = 16 * kt - WIN + 4 * fq + r - fr;
                    if (kt == 0 || kt == 16) { const bool ok = (rel >= -WIN) && (rel <= WIN); acc[r] = ok ? acc[r] * 0.12751743082459664f + bt[hh * 260 + (ok ? rel + WIN : 0)] : -1e30f; }
                    else acc[r] = acc[r] * 0.12751743082459664f + bt[hh * 260 + rel + WIN]; }
            } else { acc = (f32x4){-1e30f, -1e30f, -1e30f, -1e30f}; }
            s[kt] = acc;
        }
        float mx = -3.0e38f;
#pragma unroll
        for (int kt = 0; kt < 17; ++kt) mx = fmaxf(mx, fmaxf(fmaxf(s[kt][0], s[kt][1]), fmaxf(s[kt][2], s[kt][3])));
        mx = fmaxf(mx, shx(mx, 16, c.lane)); mx = fmaxf(mx, shx(mx, 32, c.lane)); mx = fmaxf(mx, snk);
        float sum = 0.f;
#pragma unroll
        for (int kt = 0; kt < 17; ++kt)
#pragma unroll
            for (int r = 0; r < 4; ++r) { const float pv = __builtin_amdgcn_exp2f(s[kt][r] - mx); s[kt][r] = pv; sum += pv; }
        sum += shx(sum, 16, c.lane); sum += shx(sum, 32, c.lane);
        inv[hh] = 1.0f / (sum + __builtin_amdgcn_exp2f(snk - mx));
        if (w & 1) {
#pragma unroll
            for (int kp = 0; kp < 9; ++kp) { pw[hh][kp][0] = (kp > 0) ? cvt_pk_bf16_v(s[kp > 0 ? 2 * kp - 1 : 0][0], s[kp > 0 ? 2 * kp - 1 : 0][1]) : 0u; pw[hh][kp][1] = (kp > 0) ? cvt_pk_bf16_v(s[kp > 0 ? 2 * kp - 1 : 0][2], s[kp > 0 ? 2 * kp - 1 : 0][3]) : 0u;
                pw[hh][kp][2] = cvt_pk_bf16_v(s[2 * kp][0], s[2 * kp][1]); pw[hh][kp][3] = cvt_pk_bf16_v(s[2 * kp][2], s[2 * kp][3]); }
        } else {
#pragma unroll
            for (int kp = 0; kp < 9; ++kp) { pw[hh][kp][0] = cvt_pk_bf16_v(s[2 * kp][0], s[2 * kp][1]); pw[hh][kp][1] = cvt_pk_bf16_v(s[2 * kp][2], s[2 * kp][3]);
                pw[hh][kp][2] = (kp < 8) ? cvt_pk_bf16_v(s[kp < 8 ? 2 * kp + 1 : 16][0], s[kp < 8 ? 2 * kp + 1 : 16][1]) : 0u; pw[hh][kp][3] = (kp < 8) ? cvt_pk_bf16_v(s[kp < 8 ? 2 * kp + 1 : 16][2], s[kp < 8 ? 2 * kp + 1 : 16][3]) : 0u; }
        }
        __builtin_amdgcn_sched_barrier(0);
    }
    __syncthreads();
#pragma unroll
    for (int p = 0; p < 12; ++p) { const int id = c.tid + NTHREADS * p, d = id / 48, pc = id % 48, b = pc >> 2, m = pc & 3, key = kb0 + 32 * b + 8 * m;
        u32x4 v = (u32x4){0u, 0u, 0u, 0u};
        if (key >= 0 && key < S) v = *(const GAS u32x4*)(VT + (size_t)(kvh * HD + d) * S + key);
        const int c0 = 4 * b + 2 * (m & 1), t = m >> 1; LAS unsigned char* rowp = band + d * 768;
        u32x2 lo; lo.x = v.x; lo.y = v.y; u32x2 hi; hi.x = v.z; hi.y = v.w;
        *(LAS u32x2*)(rowp + ((((c0 >> 4) << 4) + ((c0 & 15) ^ (d & 15))) << 4) + 8 * t) = lo;
        *(LAS u32x2*)(rowp + (((((c0 + 1) >> 4) << 4) + (((c0 + 1) & 15) ^ (d & 15))) << 4) + 8 * t) = hi; }
    __syncthreads();
#if MK_PV3
    {
        f32x4 o[3][8];
#pragma unroll
        for (int hh = 0; hh < 3; ++hh)
#pragma unroll
            for (int dt = 0; dt < 8; ++dt) o[hh][dt] = (f32x4){0.f, 0.f, 0.f, 0.f};
#pragma unroll
        for (int kp = 0; kp < 9; ++kp) {
            bf16x8 pf[3];
#pragma unroll
            for (int hh = 0; hh < 3; ++hh) { u32x4 pq; pq.x = pw[hh][kp][0]; pq.y = pw[hh][kp][1]; pq.z = pw[hh][kp][2]; pq.w = pw[hh][kp][3]; pf[hh] = __builtin_bit_cast(bf16x8, pq); }
            const int cc = 4 * ((w >> 1) + kp) + fq;
            const int poff = (((cc >> 4) << 4) + ((cc & 15) ^ fr)) << 4;
#pragma unroll
            for (int dt = 0; dt < 8; ++dt) { const bf16x8 vf = *(const LAS bf16x8*)(band + (16 * dt + fr) * 768 + poff);
#pragma unroll
                for (int hh = 0; hh < 3; ++hh) o[hh][dt] = __builtin_amdgcn_mfma_f32_16x16x32_bf16(vf, pf[hh], o[hh][dt], 0, 0, 0); }
        }
#pragma unroll
        for (int hh = 0; hh < 3; ++hh) { const int h = kvh * 3 + hh;
            unsigned ooff = (unsigned)((q0 + fr) * MIX_LD_EV + h * HD + 4 * fq) * 2u; asm volatile("" : "+v"(ooff));
            const float iv = inv[hh];
#pragma unroll
            for (int dt = 0; dt < 8; ++dt) { u32x2 wv; wv.x = cvt_pk_bf16(o[hh][dt][0] * iv, o[hh][dt][1] * iv); wv.y = cvt_pk_bf16(o[hh][dt][2] * iv, o[hh][dt][3] * iv); *(GAS u32x2*)((GAS char*)MIX + (size_t)ooff + 32 * dt) = wv; } }
    }
#else
#pragma unroll
    for (int hh = 0; hh < 3; ++hh) {
        const int h = kvh * 3 + hh;
        f32x4 o[8];
#pragma unroll
        for (int dt = 0; dt < 8; ++dt) o[dt] = (f32x4){0.f, 0.f, 0.f, 0.f};
#pragma unroll
        for (int kp = 0; kp < 9; ++kp) {
            u32x4 pq; pq.x = pw[hh][kp][0]; pq.y = pw[hh][kp][1]; pq.z = pw[hh][kp][2]; pq.w = pw[hh][kp][3];
            const bf16x8 pf = __builtin_bit_cast(bf16x8, pq);
            const int cc = 4 * ((w >> 1) + kp) + fq;
            const int poff = (((cc >> 4) << 4) + ((cc & 15) ^ fr)) << 4;
#pragma unroll
            for (int dt = 0; dt < 8; ++dt) { const bf16x8 vf = *(const LAS bf16x8*)(band + (16 * dt + fr) * 768 + poff);
                o[dt] = __builtin_amdgcn_mfma_f32_16x16x32_bf16(vf, pf, o[dt], 0, 0, 0); }
        }
        unsigned ooff = (unsigned)((q0 + fr) * MIX_LD_EV + h * HD + 4 * fq) * 2u; asm volatile("" : "+v"(ooff));
        const float iv = inv[hh];
#pragma unroll
        for (int dt = 0; dt < 8; ++dt) { u32x2 wv; wv.x = cvt_pk_bf16(o[dt][0] * iv, o[dt][1] * iv); wv.y = cvt_pk_bf16(o[dt][2] * iv, o[dt][3] * iv); *(GAS u32x2*)((GAS char*)MIX + (size_t)ooff + 32 * dt) = wv; }
    }
#endif
}

typedef short v4i16_t __attribute__((ext_vector_type(4)));
__device__ __forceinline__ s16x4 tr_read(const LAS unsigned char* p) { return __builtin_bit_cast(s16x4, __builtin_amdgcn_ds_read_tr16_b64_v4i16((LAS v4i16_t*)p)); }

constexpr int XS = 544;
__device__ __forceinline__ void ffta_unit(const Args& a, const Ctx& c, int g, int sb) {
    const bf16_t* F = (const bf16_t*)(a.ws + WS_Z) + QDIM + KVDIM + g * 128;
    bf16_t* TB = (bf16_t*)(a.ws + WS_TB);
    LAS unsigned char* X = c.lds;
    __syncthreads();
#pragma unroll
    for (int p = 0; p < 4; ++p) { const int id = c.tid + NTHREADS * p, s1 = id >> 5, ch = id & 31, ds2 = ch >> 4, c8 = (ch & 15) * 8;
        const u32x4 v = *(const GAS u32x4*)(F + (size_t)(128 * s1 + 2 * sb + ds2) * QKF_LD + c8);
        *(LAS u32x4*)(X + s1 * XS + (ds2 * 128 + c8) * 2) = v; }
    __syncthreads();
    const int fr = c.lane & 15, fq = c.lane >> 4, w = c.wave;
    bf16x8 af[2][2];
#pragma unroll
    for (int mt = 0; mt < 2; ++mt)
#pragma unroll
        for (int ks = 0; ks < 2; ++ks) {
            const LAS unsigned char* ap = X + (32 * ks + 4 * fq + (fr >> 2)) * XS + (32 * w + 16 * mt + 4 * (fr & 3)) * 2;
            const s16x4 t0 = tr_read(ap), t1 = tr_read(ap + 16 * XS);
            bf16x8 f; f[0] = t0[0]; f[1] = t0[1]; f[2] = t0[2]; f[3] = t0[3]; f[4] = t1[0]; f[5] = t1[1]; f[6] = t1[2]; f[7] = t1[3]; af[mt][ks] = f; }
    f32x4 acc[2][4][2];
#pragma unroll
    for (int jp = 0; jp < 4; ++jp) {
        bf16x8 bfr[2][2];
#pragma unroll
        for (int ks = 0; ks < 2; ++ks) { const GAS u32x4* ft = (const GAS u32x4*)(a.ws + WS_FTA) + ((jp * 2 + ks) * 2) * 64 + c.lane;
            bfr[0][ks] = __builtin_bit_cast(bf16x8, ft[0]); bfr[1][ks] = __builtin_bit_cast(bf16x8, ft[64]); }
#pragma unroll
        for (int mt = 0; mt < 2; ++mt) { f32x4 ar = (f32x4){0.f, 0.f, 0.f, 0.f}, ai = (f32x4){0.f, 0.f, 0.f, 0.f};
#pragma unroll
            for (int ks = 0; ks < 2; ++ks) { ar = __builtin_amdgcn_mfma_f32_16x16x32_bf16(af[mt][ks], bfr[0][ks], ar, 0, 0, 0); ai = __builtin_amdgcn_mfma_f32_16x16x32_bf16(af[mt][ks], bfr[1][ks], ai, 0, 0, 0); }
            acc[mt][jp][0] = ar; acc[mt][jp][1] = ai; }
        __builtin_amdgcn_sched_barrier(0);
    }
    const int s2 = 2 * sb + (w >> 2);
#pragma unroll
    for (int jp = 0; jp < 4; ++jp) { const int k1 = 16 * jp + fr; float sn, cs; sincospif((float)(s2 * k1) * (1.0f / 4096.0f), &sn, &cs);
#pragma unroll
        for (int mt = 0; mt < 2; ++mt) { const f32x4 re = acc[mt][jp][0], im = acc[mt][jp][1]; const int cc = 32 * (w & 3) + 16 * mt + 4 * fq;
            u32x2 tr, ti; tr.x = cvt_pk_bf16(re[0] * cs + im[0] * sn, re[1] * cs + im[1] * sn); tr.y = cvt_pk_bf16(re[2] * cs + im[2] * sn, re[3] * cs + im[3] * sn);
            ti.x = cvt_pk_bf16(im[0] * cs - re[0] * sn, im[1] * cs - re[1] * sn); ti.y = cvt_pk_bf16(im[2] * cs - re[2] * sn, im[3] * cs - re[3] * sn);
            bf16_t* tp = TB + ((size_t)((k1 * 4 + g) * 2) * 128 + s2) * 128 + cc;
            *(GAS u32x2*)tp = tr; *(GAS u32x2*)(tp + 128 * 128) = ti; } }
}

constexpr int TS = 288;
__device__ __forceinline__ void fftc_unit(const Args& a, const Ctx& c, int k1, int g) {
    const bf16_t* T = (const bf16_t*)(a.ws + WS_TB) + (size_t)((k1 * 4 + g) * 2) * 128 * 128; bf16_t* MIX = (bf16_t*)(a.ws + WS_MIX);
    LAS unsigned char* X = c.lds;
    __syncthreads();
    u32x4 bft[8][2];
    { const GAS u32x4* ft = (const GAS u32x4*)(a.ws + WS_FTC) + (size_t)(c.wave * 16) * 64 + c.lane;
#pragma unroll
      for (int q = 0; q < 16; ++q) bft[q >> 1][q & 1] = ft[q * 64]; }
#pragma unroll
    for (int p = 0; p < 8; ++p) { const int id = c.tid + NTHREADS * p, row = id >> 4, ch = id & 15; *(LAS u32x4*)(X + row * TS + ch * 16) = *(const GAS u32x4*)(T + (size_t)row * 128 + ch * 8); }
    __syncthreads();
    const int fr = c.lane & 15, fq = c.lane >> 4, w = c.wave, pq = w >> 2;
    f32x4 acc[8][2];
#pragma unroll
    for (int mt = 0; mt < 8; ++mt) { acc[mt][0] = (f32x4){0.f, 0.f, 0.f, 0.f}; acc[mt][1] = (f32x4){0.f, 0.f, 0.f, 0.f}; }
#pragma unroll
    for (int ks = 0; ks < 8; ++ks) {
        bf16x8 bf[2]; bf[0] = __builtin_bit_cast(bf16x8, bft[ks][0]); bf[1] = __builtin_bit_cast(bf16x8, bft[ks][1]);
#pragma unroll
        for (int mt = 0; mt < 8; ++mt) {
            const LAS unsigned char* ap = X + (32 * ks + 4 * fq + (fr >> 2)) * TS + (16 * mt + 4 * (fr & 3)) * 2;
            const s16x4 t0 = tr_read(ap), t1 = tr_read(ap + 16 * TS);
            bf16x8 af; af[0] = t0[0]; af[1] = t0[1]; af[2] = t0[2]; af[3] = t0[3]; af[4] = t1[0]; af[5] = t1[1]; af[6] = t1[2]; af[7] = t1[3];
            acc[mt][0] = __builtin_amdgcn_mfma_f32_16x16x32_bf16(af, bf[0], acc[mt][0], 0, 0, 0);
            acc[mt][1] = __builtin_amdgcn_mfma_f32_16x16x32_bf16(af, bf[1], acc[mt][1], 0, 0, 0);
        }
        __builtin_amdgcn_sched_barrier(0);
    }
#pragma unroll
    for (int t = 0; t < 2; ++t) { const int k2 = 32 * (w & 3) + 16 * t + fr; bf16_t* op = MIX + (size_t)(k1 + 64 * k2) * MIX_LD_EV + QDIM + g * 256 + pq * 128 + 4 * fq;
#pragma unroll
        for (int mt = 0; mt < 8; ++mt) { u32x2 o; o.x = cvt_pk_bf16(acc[mt][t][0], acc[mt][t][1]); o.y = cvt_pk_bf16(acc[mt][t][2], acc[mt][t][3]); *(GAS u32x2*)(op + 16 * mt) = o; } }
}

__device__ __forceinline__ void bf8_to_f32(const u32x4 w, float (&f)[8]) { f[0] = bf_lo(w.x); f[1] = bf_hi(w.x); f[2] = bf_lo(w.y); f[3] = bf_hi(w.y); f[4] = bf_lo(w.z); f[5] = bf_hi(w.z); f[6] = bf_lo(w.w); f[7] = bf_hi(w.w); }
__device__ __forceinline__ void oddmix_unit(const Args& a, const Ctx& c, int layer_i, int unit) {
    const bf16_t* Z = (const bf16_t*)(a.ws + WS_Z); bf16_t* MIX = (bf16_t*)(a.ws + WS_MIX); bf16_t* PO = (bf16_t*)(a.ws + WS_POOLED);
    if (c.wave < 4) {
        const int t0 = unit * 32 + (c.wave >> 1) * 16, ch = ((c.wave & 1) * 64 + c.lane) * 8;
        const float* cw = (const float*)(a.ws + WS_PAR) + PAR_CONV + layer_i * 3 * CONVD + ch;
        float w0[8], w1[8], w2[8];
#pragma unroll
        for (int q = 0; q < 8; ++q) { w0[q] = cw[q]; w1[q] = cw[CONVD + q]; w2[q] = cw[2 * CONVD + q]; }
        float pm[8], pc[8], pn[8], fa[8], fb[8];
#pragma unroll
        for (int q = 0; q < 8; ++q) pm[q] = 0.f;
        if (t0 > 0) { bf8_to_f32(*(const GAS u32x4*)(Z + (size_t)(t0 - 1) * OD_IN + CONVD + ch), fa); bf8_to_f32(*(const GAS u32x4*)(Z + (size_t)(t0 - 1) * OD_IN + 2 * CONVD + ch), fb);
#pragma unroll
            for (int q = 0; q < 8; ++q) pm[q] = fa[q] * fb[q]; }
        bf8_to_f32(*(const GAS u32x4*)(Z + (size_t)t0 * OD_IN + CONVD + ch), fa); bf8_to_f32(*(const GAS u32x4*)(Z + (size_t)t0 * OD_IN + 2 * CONVD + ch), fb);
#pragma unroll
        for (int q = 0; q < 8; ++q) pc[q] = fa[q] * fb[q];
#pragma unroll 4
        for (int t = t0; t < t0 + 16; ++t) {
#pragma unroll
            for (int q = 0; q < 8; ++q) pn[q] = 0.f;
            if (t + 1 < S) { bf8_to_f32(*(const GAS u32x4*)(Z + (size_t)(t + 1) * OD_IN + CONVD + ch), fa); bf8_to_f32(*(const GAS u32x4*)(Z + (size_t)(t + 1) * OD_IN + 2 * CONVD + ch), fb);
#pragma unroll
                for (int q = 0; q < 8; ++q) pn[q] = fa[q] * fb[q]; }
            bf8_to_f32(*(const GAS u32x4*)(Z + (size_t)t * OD_IN + ch), fa);
            float o[8];
#pragma unroll
            for (int q = 0; q < 8; ++q) { o[q] = fa[q] * (w0[q] * pm[q] + w1[q] * pc[q] + w2[q] * pn[q]); pm[q] = pc[q]; pc[q] = pn[q]; }
            u32x4 ov; ov.x = pk2(o[0], o[1]); ov.y = pk2(o[2], o[3]); ov.z = pk2(o[4], o[5]); ov.w = pk2(o[6], o[7]);
            *(GAS u32x4*)(MIX + (size_t)t * D + ch) = ov;
        }
    } else {
        const int g = c.wave - 4, lo = 1 << g, hi = lo - 1;
        const int t0 = unit * 32 + (c.lane >> 5) * 16, ch = g * 256 + (c.lane & 31) * 8;
        const bf16_t* zp = Z + 3 * CONVD + ch;
        float sm[8], fa[8];
#pragma unroll
        for (int q = 0; q < 8; ++q) sm[q] = 0.f;
        for (int tt = t0 - lo; tt <= t0 + hi; ++tt) if (tt >= 0 && tt < S) { bf8_to_f32(*(const GAS u32x4*)(zp + (size_t)tt * OD_IN), fa);
#pragma unroll
            for (int q = 0; q < 8; ++q) sm[q] += fa[q]; }
#pragma unroll 2
        for (int t = t0; t < t0 + 16; ++t) {
            const int aa = t - lo < 0 ? 0 : t - lo, bb = t + hi > S - 1 ? S - 1 : t + hi; const float rc = 1.0f / (float)(bb - aa + 1);
            bf8_to_f32(*(const GAS u32x4*)(zp + (size_t)t * OD_IN), fa);
            u32x4 ov; ov.x = pk2(sm[0] * rc - fa[0], sm[1] * rc - fa[1]); ov.y = pk2(sm[2] * rc - fa[2], sm[3] * rc - fa[3]); ov.z = pk2(sm[4] * rc - fa[4], sm[5] * rc - fa[5]); ov.w = pk2(sm[6] * rc - fa[6], sm[7] * rc - fa[7]);
            { const int tok = t - unit * 32; *(LAS u32x4*)(c.lds + tok * 2048 + ((((ch >> 3) & ~15) | (((ch >> 3) & 15) ^ (tok & 15))) << 4)) = ov; }
            if (t + 1 + hi < S) { bf8_to_f32(*(const GAS u32x4*)(zp + (size_t)(t + 1 + hi) * OD_IN), fa);
#pragma unroll
                for (int q = 0; q < 8; ++q) sm[q] += fa[q]; }
            if (t - lo >= 0) { bf8_to_f32(*(const GAS u32x4*)(zp + (size_t)(t - lo) * OD_IN), fa);
#pragma unroll
                for (int q = 0; q < 8; ++q) sm[q] -= fa[q]; }
        }
    }
    __syncthreads();
    {
        const int fr = c.lane & 15, fq = c.lane >> 4, g = c.wave >> 1, mt0 = 8 * (c.wave & 1);
        const bf16_t* Wp = (const bf16_t*)(a.ws + WS_POOLW + layer_i * SZ_POOL) + (size_t)g * 65536;
        bf16x8 bfr[2][8];
#pragma unroll
        for (int nt = 0; nt < 2; ++nt)
#pragma unroll
            for (int ks = 0; ks < 8; ++ks) { const int tok = 16 * nt + fr, c16 = g * 32 + 4 * ks + fq; bfr[nt][ks] = *(const LAS bf16x8*)(c.lds + tok * 2048 + (((c16 & ~15) | ((c16 & 15) ^ fr)) << 4)); }
        unsigned woff = (unsigned)((16 * mt0 + fr) * 256 + 8 * fq) * 2u; asm volatile("" : "+v"(woff));
        bf16x8 af[8], an[8];
#pragma unroll
        for (int ks = 0; ks < 8; ++ks) af[ks] = *(const GAS bf16x8*)((const GAS char*)Wp + (size_t)woff + 64 * ks);
#pragma unroll 1
        for (int mi = 0; mi < 8; ++mi) {
            if (mi + 1 < 8) {
#pragma unroll
                for (int ks = 0; ks < 8; ++ks) an[ks] = *(const GAS bf16x8*)((const GAS char*)Wp + (size_t)woff + (size_t)(mi + 1) * (16 * 256 * 2) + 64 * ks); }
            f32x4 acc0 = (f32x4){0.f, 0.f, 0.f, 0.f}, acc1 = (f32x4){0.f, 0.f, 0.f, 0.f};
#pragma unroll
            for (int ks = 0; ks < 8; ++ks) { acc0 = __builtin_amdgcn_mfma_f32_16x16x32_bf16(af[ks], bfr[0][ks], acc0, 0, 0, 0); acc1 = __builtin_amdgcn_mfma_f32_16x16x32_bf16(af[ks], bfr[1][ks], acc1, 0, 0, 0); }
            const int dcol = CONVD + g * 256 + 16 * (mt0 + mi) + 4 * fq;
            u32x2 o0; o0.x = cvt_pk_bf16(acc0[0], acc0[1]); o0.y = cvt_pk_bf16(acc0[2], acc0[3]); *(GAS u32x2*)(MIX + (size_t)(unit * 32 + fr) * D + dcol) = o0;
            u32x2 o1; o1.x = cvt_pk_bf16(acc1[0], acc1[1]); o1.y = cvt_pk_bf16(acc1[2], acc1[3]); *(GAS u32x2*)(MIX + (size_t)(unit * 32 + 16 + fr) * D + dcol) = o1;
#pragma unroll
            for (int ks = 0; ks < 8; ++ks) af[ks] = an[ks];
        }
    }
    __syncthreads();
}

template <int G>
__device__ __forceinline__ void oddmix_pool(const bf16_t* zp, int t0, int ltok, int cl, LAS unsigned char* lds) {
    constexpr int LO = 1 << G, HI = LO - 1, W = 2 * LO, NR = 8 + W - 1;
    u32x4 rw[NR];
    const bf16_t* zb = zp + (size_t)t0 * OD_IN;
#pragma unroll
    for (int r = 0; r < NR; ++r) { const int tt = t0 - LO + r; const int d = (tt >= 0 && tt < S) ? (r - LO) * OD_IN : 0; rw[r] = *(const GAS u32x4*)(zb + d); }
    float sm[8], fa[8];
#pragma unroll
    for (int q = 0; q < 8; ++q) sm[q] = 0.f;
#pragma unroll
    for (int r = 0; r < W; ++r) { const int tt = t0 - LO + r; if (tt >= 0 && tt < S) { bf8_to_f32(rw[r], fa);
#pragma unroll
        for (int q = 0; q < 8; ++q) sm[q] += fa[q]; } }
#pragma unroll
    for (int i = 0; i < 8; ++i) { const int t = t0 + i;
        const int aa = t - LO < 0 ? 0 : t - LO, bb = t + HI > S - 1 ? S - 1 : t + HI; const float rc = 1.0f / (float)(bb - aa + 1);
        bf8_to_f32(rw[i + LO], fa);
        u32x4 ov; ov.x = pk2(sm[0] * rc - fa[0], sm[1] * rc - fa[1]); ov.y = pk2(sm[2] * rc - fa[2], sm[3] * rc - fa[3]); ov.z = pk2(sm[4] * rc - fa[4], sm[5] * rc - fa[5]); ov.w = pk2(sm[6] * rc - fa[6], sm[7] * rc - fa[7]);
        { const int tok = ltok + i; *(LAS u32x4*)(lds + tok * 512 + (((cl & ~15) | ((cl & 15) ^ (tok & 15))) << 4)) = ov; }
        if (i < 7) {
            if (t + 1 + HI < S) { bf8_to_f32(rw[i + W], fa);
#pragma unroll
                for (int q = 0; q < 8; ++q) sm[q] += fa[q]; }
            if (t - LO >= 0) { bf8_to_f32(rw[i], fa);
#pragma unroll
                for (int q = 0; q < 8; ++q) sm[q] -= fa[q]; } }
    }
}
__device__ __forceinline__ void oddmix_unit2(const Args& a, const Ctx& c, int layer_i, int unit) {
    const bf16_t* Z = (const bf16_t*)(a.ws + WS_Z); bf16_t* MIX = (bf16_t*)(a.ws + WS_MIX);
    const int tb = unit >> 2, g = unit & 3;
    const int tg = c.tid >> 5, cl = c.tid & 31;
    const int t0 = tb * 128 + tg * 8, ch = g * 256 + cl * 8;
    {
        u32x4 ra[10], rb[10], rg[8];
        const bf16_t* zb = Z + (size_t)t0 * OD_IN + ch;
#pragma unroll
        for (int r = 0; r < 10; ++r) { const int tt = t0 - 1 + r; const int d = (tt >= 0 && tt < S) ? (r - 1) * OD_IN : 0;
            ra[r] = *(const GAS u32x4*)(zb + d + CONVD); rb[r] = *(const GAS u32x4*)(zb + d + 2 * CONVD); }
#pragma unroll
        for (int r = 0; r < 8; ++r) rg[r] = *(const GAS u32x4*)(zb + r * OD_IN);
        const float* cw = (const float*)(a.ws + WS_PAR) + PAR_CONV + layer_i * 3 * CONVD + ch;
        float w0[8], w1[8], w2[8];
#pragma unroll
        for (int q = 0; q < 8; ++q) { w0[q] = cw[q]; w1[q] = cw[CONVD + q]; w2[q] = cw[2 * CONVD + q]; }
        float pm[8], pc[8], pn[8], fa[8], fb[8];
        { bf8_to_f32(ra[0], fa); bf8_to_f32(rb[0], fb); const float v = (t0 - 1 >= 0) ? 1.f : 0.f;
#pragma unroll
          for (int q = 0; q < 8; ++q) pm[q] = fa[q] * fb[q] * v; }
        { bf8_to_f32(ra[1], fa); bf8_to_f32(rb[1], fb);
#pragma unroll
          for (int q = 0; q < 8; ++q) pc[q] = fa[q] * fb[q]; }
#pragma unroll
        for (int i = 0; i < 8; ++i) { const int t = t0 + i;
            bf8_to_f32(ra[i + 2], fa); bf8_to_f32(rb[i + 2], fb); const float v = (t + 1 < S) ? 1.f : 0.f;
#pragma unroll
            for (int q = 0; q < 8; ++q) pn[q] = fa[q] * fb[q] * v;
            bf8_to_f32(rg[i], fa);
            float o[8];
#pragma unroll
            for (int q = 0; q < 8; ++q) { o[q] = fa[q] * (w0[q] * pm[q] + w1[q] * pc[q] + w2[q] * pn[q]); pm[q] = pc[q]; pc[q] = pn[q]; }
            u32x4 ov; ov.x = pk2(o[0], o[1]); ov.y = pk2(o[2], o[3]); ov.z = pk2(o[4], o[5]); ov.w = pk2(o[6], o[7]);
            *(GAS u32x4*)(MIX + (size_t)t * D + ch) = ov; }
    }
    const int fr = c.lane & 15, fq = c.lane >> 4;
    const bf16_t* Wp = (const bf16_t*)(a.ws + WS_POOLW + layer_i * SZ_POOL) + (size_t)g * 65536 + (size_t)(32 * c.wave + fr) * 256 + 8 * fq;
    bf16x8 wf[2][8];
#pragma unroll
    for (int mt = 0; mt < 2; ++mt)
#pragma unroll
        for (int ks = 0; ks < 8; ++ks) wf[mt][ks] = *(const GAS bf16x8*)(Wp + mt * 16 * 256 + 32 * ks);
    { int t0p = t0; asm volatile("" : "+v"(t0p)); const bf16_t* zp = Z + 3 * CONVD + ch;
      if (g == 0) oddmix_pool<0>(zp, t0p, tg * 8, cl, c.lds); else if (g == 1) oddmix_pool<1>(zp, t0p, tg * 8, cl, c.lds); else if (g == 2) oddmix_pool<2>(zp, t0p, tg * 8, cl, c.lds); else oddmix_pool<3>(zp, t0p, tg * 8, cl, c.lds); }
    __syncthreads();
#pragma unroll
    for (int nt = 0; nt < 8; ++nt) {
        bf16x8 bfr[8];
#pragma unroll
        for (int ks = 0; ks < 8; ++ks) { const int tok = 16 * nt + fr, c16 = 4 * ks + fq; bfr[ks] = *(const LAS bf16x8*)(c.lds + tok * 512 + (((c16 & ~15) | ((c16 & 15) ^ fr)) << 4)); }
        f32x4 acc0 = (f32x4){0.f, 0.f, 0.f, 0.f}, acc1 = (f32x4){0.f, 0.f, 0.f, 0.f};
#pragma unroll
        for (int ks = 0; ks < 8; ++ks) { acc0 = __builtin_amdgcn_mfma_f32_16x16x32_bf16(wf[0][ks], bfr[ks], acc0, 0, 0, 0); acc1 = __builtin_amdgcn_mfma_f32_16x16x32_bf16(wf[1][ks], bfr[ks], acc1, 0, 0, 0); }
        bf16_t* op = MIX + (size_t)(tb * 128 + 16 * nt + fr) * D + CONVD + g * 256 + 32 * c.wave + 4 * fq;
        u32x2 o0; o0.x = cvt_pk_bf16(acc0[0], acc0[1]); o0.y = cvt_pk_bf16(acc0[2], acc0[3]); *(GAS u32x2*)op = o0;
        u32x2 o1; o1.x = cvt_pk_bf16(acc1[0], acc1[1]); o1.y = cvt_pk_bf16(acc1[2], acc1[3]); *(GAS u32x2*)(op + 16) = o1;
    }
    __syncthreads();
}

__device__ __forceinline__ void norm_router_stage(const Args& a, const Ctx& c, int layer) {
    LAS float* wT = (LAS float*)c.lds; const float* par = (const float*)(a.ws + WS_PAR); const float* wr = par + PAR_ROUTER + (size_t)layer * D * NE;
    __syncthreads();
    for (int i = c.tid; i < D * NE / 4; i += NTHREADS) ((LAS f32x4*)wT)[i] = ((const GAS f32x4*)wr)[i];
    LAS f32x4* gl = (LAS f32x4*)(c.lds + RING_BYTES + 1024);
    c.tid < D / 4 ? (void)(gl[c.tid] = ((const GAS f32x4*)(par + PAR_GFFN + (size_t)layer * D))[c.tid]) : (void)0;
    __syncthreads();
}
__device__ __forceinline__ void norm_router_phase(const Args& a, const Ctx& c, int layer, bool staged = false) {
    LAS float* wT = (LAS float*)c.lds;
    const float* par = (const float*)(a.ws + WS_PAR); const float* wr = par + PAR_ROUTER + (size_t)layer * D * NE;
    int gw = c.vcu * NWAVES + c.wave; asm volatile("" : "+s"(gw));
    const int NGW = c.G * NWAVES, lane = c.lane;
    float* AFF = (float*)(a.ws + WS_AFF); bf16_t* H = (bf16_t*)(a.ws + WS_H);
    f32x4 n0[8], n1[8];
    { const int mb = (gw + NGW) < S ? gw + NGW : gw;
#pragma unroll
        for (int j = 0; j < 8; ++j) { n0[j] = ((const GAS f32x4*)(a.X + (size_t)gw * D))[lane + 64 * j]; n1[j] = ((const GAS f32x4*)(a.X + (size_t)mb * D))[lane + 64 * j]; } }
    LAS f32x4* gl = (LAS f32x4*)(c.lds + RING_BYTES + 1024);
    if (!staged) {
    __syncthreads();
    for (int i = c.tid; i < D * NE / 4; i += NTHREADS) ((LAS f32x4*)wT)[i] = ((const GAS f32x4*)wr)[i];
    c.tid < D / 4 ? (void)(gl[c.tid] = ((const GAS f32x4*)(par + PAR_GFFN + (size_t)layer * D))[c.tid]) : (void)0;
    }
    __syncthreads();
    for (int m = gw; m < S; m += 2 * NGW) {
        const bool two = (m + NGW) < S; const int m1 = two ? m + NGW : m;
        f32x4 v0[8], v1[8]; float ss0 = 0.f, ss1 = 0.f;
#pragma unroll
        for (int j = 0; j < 8; ++j) { v0[j] = n0[j]; v1[j] = n1[j]; }
        if (m + 2 * NGW < S) { const int ma = m + 2 * NGW, mb = (ma + NGW) < S ? ma + NGW : ma;
#pragma unroll
            for (int j = 0; j < 8; ++j) { n0[j] = ((const GAS f32x4*)(a.X + (size_t)ma * D))[lane + 64 * j]; n1[j] = ((const GAS f32x4*)(a.X + (size_t)mb * D))[lane + 64 * j]; } }
#pragma unroll
        for (int j = 0; j < 8; ++j) { ss0 += (v0[j].x * v0[j].x + v0[j].y * v0[j].y) + (v0[j].z * v0[j].z + v0[j].w * v0[j].w); ss1 += (v1[j].x * v1[j].x + v1[j].y * v1[j].y) + (v1[j].z * v1[j].z + v1[j].w * v1[j].w); }
#pragma unroll
        for (int o = 1; o < 64; o <<= 1) { ss0 += shx(ss0, o, lane); ss1 += shx(ss1, o, lane); }
        const float r0 = rsqrtf(ss0 * (1.0f / D) + EPS), r1 = rsqrtf(ss1 * (1.0f / D) + EPS);
        GAS u32x2* o0 = (GAS u32x2*)(H + (size_t)m * D) + lane; GAS u32x2* o1 = (GAS u32x2*)(H + (size_t)m1 * D) + lane;
#pragma unroll
        for (int j = 0; j < 8; ++j) { const f32x4 w = gl[lane + 64 * j]; v0[j] = v0[j] * r0 * w; v1[j] = v1[j] * r1 * w;
            u32x2 p0; p0.x = cvt_pk_bf16(v0[j].x, v0[j].y); p0.y = cvt_pk_bf16(v0[j].z, v0[j].w); o0[64 * j] = p0;
            u32x2 p1; p1.x = cvt_pk_bf16(v1[j].x, v1[j].y); p1.y = cvt_pk_bf16(v1[j].z, v1[j].w); if (two) o1[64 * j] = p1; }
        float lg0[NE], lg1[NE];
#pragma unroll
        for (int e = 0; e < NE; ++e) { f32x2 a0 = (f32x2){0.f, 0.f}, a1 = (f32x2){0.f, 0.f};
#pragma unroll
            for (int j = 0; j < 8; ++j) { const f32x4 w = *(const LAS f32x4*)(wT + e * D + 4 * lane + 256 * j); const f32x2 wl = (f32x2){w.x, w.y}, wh = (f32x2){w.z, w.w};
                a0 = __builtin_elementwise_fma((f32x2){v0[j].x, v0[j].y}, wl, a0); a0 = __builtin_elementwise_fma((f32x2){v0[j].z, v0[j].w}, wh, a0);
                a1 = __builtin_elementwise_fma((f32x2){v1[j].x, v1[j].y}, wl, a1); a1 = __builtin_elementwise_fma((f32x2){v1[j].z, v1[j].w}, wh, a1); }
            lg0[e] = a0.x + a0.y; lg1[e] = a1.x + a1.y; if (e & 1) __builtin_amdgcn_sched_barrier(0); }
#pragma unroll
        for (int st = 0; st < 4; ++st) { const int o = 32 >> st, n = 8 >> st; const bool up = (lane & o) != 0;
#pragma unroll
            for (int i = 0; i < 8; ++i) if (i < n) { const float s0 = up ? lg0[i] : lg0[i + n], k0 = up ? lg0[i + n] : lg0[i]; const float s1 = up ? lg1[i] : lg1[i + n], k1 = up ? lg1[i + n] : lg1[i];
                lg0[i] = k0 + shx(s0, o, lane); lg1[i] = k1 + shx(s1, o, lane); } }
        float l0 = lg0[0], l1 = lg1[0]; l0 += shx(l0, 2, lane); l1 += shx(l1, 2, lane); l0 += shx(l0, 1, lane); l1 += shx(l1, 1, lane);
        float mx0 = l0, mx1 = l1;
#pragma unroll
        for (int o = 4; o < 64; o <<= 1) { mx0 = fmaxf(mx0, shx(mx0, o, lane)); mx1 = fmaxf(mx1, shx(mx1, o, lane)); }
        const float e0 = expf(l0 - mx0), e1 = expf(l1 - mx1); float sm0 = e0, sm1 = e1;
#pragma unroll
        for (int o = 4; o < 64; o <<= 1) { sm0 += shx(sm0, o, lane); sm1 += shx(sm1, o, lane); }
        const int e = ((lane >> 5) & 1) * 8 + ((lane >> 4) & 1) * 4 + ((lane >> 3) & 1) * 2 + ((lane >> 2) & 1);
        if ((lane & 3) == 0) { AFF[(size_t)e * S + m] = e0 / sm0; if (two) AFF[(size_t)e * S + m1] = e1 / sm1; }
    }
    __syncthreads();
}

__device__ __forceinline__ void select_phase(const Args& a, const Ctx& c, int e) {
    const float* AFF = (const float*)(a.ws + WS_AFF) + (size_t)e * S; int* INV = (int*)(a.ws + WS_INV) + (size_t)e * S; int* IDX = (int*)(a.ws + WS_IDX); float* GATE = (float*)(a.ws + WS_GATE);
    LAS int* red = (LAS int*)c.lds;
    unsigned v[16];
#pragma unroll
    for (int q = 0; q < 4; ++q) { const u32x4 t4 = *(const GAS u32x4*)(AFF + c.tid * 16 + 4 * q); v[4 * q] = t4.x; v[4 * q + 1] = t4.y; v[4 * q + 2] = t4.z; v[4 * q + 3] = t4.w; }
    __syncthreads();
    unsigned prefix = 0; int it = 0;
    for (int sh = 30; sh >= 0; sh -= 2, ++it) {
        const int nb = (sh == 30) ? 1 : 2; const int shift = (sh == 30) ? 30 : sh - 1;
        int cnt[3];
#pragma unroll
        for (int j = 1; j <= 3; ++j) { const unsigned cand = prefix | ((unsigned)j << shift); int cj = 0;
#pragma unroll
            for (int i = 0; i < 16; ++i) cj += (v[i] >= cand) ? 1 : 0;
            cnt[j - 1] = wave_sum_dpp(cj); }
        LAS int* rb = red + (it & 1) * 32;
        if (c.lane == 0) { rb[c.wave * 4 + 0] = cnt[0]; rb[c.wave * 4 + 1] = cnt[1]; rb[c.wave * 4 + 2] = cnt[2]; }
        __syncthreads();
        int t1 = 0, t2 = 0, t3 = 0;
#pragma unroll
        for (int w = 0; w < NWAVES; ++w) { t1 += rb[w * 4 + 0]; t2 += rb[w * 4 + 1]; t3 += rb[w * 4 + 2]; }
        int jsel = 0;
        if (nb == 1) { jsel = (t1 >= CAP) ? 1 : 0; } else { jsel = (t3 >= CAP) ? 3 : ((t2 >= CAP) ? 2 : ((t1 >= CAP) ? 1 : 0)); }
        prefix |= (unsigned)jsel << shift;
        if (sh == 30) sh = 31;
    }
    const unsigned T = prefix;
    int cg = 0, ce = 0;
#pragma unroll
    for (int i = 0; i < 16; ++i) { cg += (v[i] > T) ? 1 : 0; ce += (v[i] == T) ? 1 : 0; }
    int pg = cg, pe = ce;
#pragma unroll
    for (int o = 1; o < 64; o <<= 1) { const int src = (c.lane >= o ? c.lane - o : c.lane) << 2; const int tg = __builtin_amdgcn_ds_bpermute(src, pg), te = __builtin_amdgcn_ds_bpermute(src, pe); if (c.lane >= o) { pg += tg; pe += te; } }
    __syncthreads();
    if (c.lane == 63) { red[64 + c.wave] = pg; red[80 + c.wave] = pe; }
    __syncthreads();
    int bg = 0, be = 0, ng = 0;
#pragma unroll
    for (int w = 0; w < NWAVES; ++w) { const int xg = red[64 + w], xe = red[80 + w]; if (w < c.wave) { bg += xg; be += xe; } ng += xg; }
    pg = pg - cg + bg; pe = pe - ce + be;
    const int need = CAP - ng;
    int slots[16];
#pragma unroll
    for (int i = 0; i < 16; ++i) {
        const int t = c.tid * 16 + i; int slot = -1;
        if (v[i] > T) { slot = pg++; } else if (v[i] == T) { if (pe < need) slot = ng + pe; pe++; }
        slots[i] = slot;
        if (slot >= 0) { IDX[e * CAP + slot] = t; GATE[e * CAP + slot] = __builtin_bit_cast(float, v[i]); }
    }
#pragma unroll
    for (int q = 0; q < 4; ++q) { u32x4 o; o.x = (unsigned)slots[4 * q]; o.y = (unsigned)slots[4 * q + 1]; o.z = (unsigned)slots[4 * q + 2]; o.w = (unsigned)slots[4 * q + 3]; *(GAS u32x4*)(INV + c.tid * 16 + 4 * q) = o; }
}

__device__ __forceinline__ void combine_stage(const Args& a, const Ctx& c, int layer) {
    LAS f32x4* gl = (LAS f32x4*)c.lds; const bool lastl = (layer == NL - 1);
    __syncthreads();
    if (c.tid < D / 4) gl[c.tid] = ((const GAS f32x4*)((const float*)(a.ws + WS_PAR) + (lastl ? PAR_GFIN : PAR_GMIX + (layer + 1) * D)))[c.tid];
    __syncthreads();
}
__device__ __forceinline__ void combine_phase(const Args& a, const Ctx& c, int layer, bool staged = false) {
    int gw = c.vcu * NWAVES + c.wave; asm volatile("" : "+s"(gw));
    const int NGW = c.G * NWAVES, lane = c.lane;
    const bf16_t* Y = (const bf16_t*)(a.ws + WS_Y); const int* INV = (const int*)(a.ws + WS_INV); bf16_t* H = (bf16_t*)(a.ws + WS_H);
    const bool lastl = (layer == NL - 1);
    LAS f32x4* gl = (LAS f32x4*)c.lds;
    f32x4 nv[8]; int ninv = -1;
    { ninv = INV[(size_t)(lane & 15) * S + gw];
#pragma unroll
        for (int j = 0; j < 8; ++j) nv[j] = ((const GAS f32x4*)(a.X + (size_t)gw * D))[lane + 64 * j]; }
    if (!staged) {
    __syncthreads();
    if (c.tid < D / 4) gl[c.tid] = ((const GAS f32x4*)((const float*)(a.ws + WS_PAR) + (lastl ? PAR_GFIN : PAR_GMIX + (layer + 1) * D)))[c.tid];
    __syncthreads();
    }
    for (int m = gw; m < S; m += NGW) {
        GAS f32x4* xr = (GAS f32x4*)(a.X + (size_t)m * D) + lane; f32x4 v[8];
#pragma unroll
        for (int j = 0; j < 8; ++j) v[j] = nv[j];
        const int myinv = ninv;
        if (m + NGW < S) { ninv = INV[(size_t)(lane & 15) * S + m + NGW];
#pragma unroll
            for (int j = 0; j < 8; ++j) nv[j] = ((const GAS f32x4*)(a.X + (size_t)(m + NGW) * D))[lane + 64 * j]; }
        unsigned mask = (unsigned)(__builtin_amdgcn_ballot_w64(myinv >= 0) & 0xFFFFull);
        while (mask) {
            const int e1 = __builtin_ctz(mask); mask &= mask - 1u; const bool two = mask != 0u; const int e2 = two ? __builtin_ctz(mask) : e1; if (two) mask &= mask - 1u;
            const int s1 = __builtin_amdgcn_readlane(myinv, e1), s2 = __builtin_amdgcn_readlane(myinv, e2);
            const GAS u32x2* y1 = (const GAS u32x2*)(Y + ((size_t)e1 * CAP + s1) * D) + lane; const GAS u32x2* y2 = (const GAS u32x2*)(Y + ((size_t)e2 * CAP + s2) * D) + lane;
            u32x2 a1[8], a2[8];
#pragma unroll
            for (int j = 0; j < 8; ++j) { a1[j] = y1[64 * j]; a2[j] = y2[64 * j]; }
#pragma unroll
            for (int j = 0; j < 8; ++j) { v[j].x += bf_lo(a1[j].x); v[j].y += bf_hi(a1[j].x); v[j].z += bf_lo(a1[j].y); v[j].w += bf_hi(a1[j].y); }
            if (two) {
#pragma unroll
                for (int j = 0; j < 8; ++j) { v[j].x += bf_lo(a2[j].x); v[j].y += bf_hi(a2[j].x); v[j].z += bf_lo(a2[j].y); v[j].w += bf_hi(a2[j].y); } }
        }
        float ss = 0.f;
#pragma unroll
        for (int j = 0; j < 8; ++j) ss += (v[j].x * v[j].x + v[j].y * v[j].y) + (v[j].z * v[j].z + v[j].w * v[j].w);
        const float r = rsqrtf(wave_sum(ss, lane) * (1.0f / D) + EPS);
        if (!lastl) {
            GAS u32x2* o8 = (GAS u32x2*)(H + (size_t)m * D) + lane;
#pragma unroll
            for (int j = 0; j < 8; ++j) { xr[64 * j] = v[j]; const f32x4 w = gl[lane + 64 * j]; u32x2 o; o.x = cvt_pk_bf16(v[j].x * r * w.x, v[j].y * r * w.y); o.y = cvt_pk_bf16(v[j].z * r * w.z, v[j].w * r * w.w); o8[64 * j] = o; }
        } else {
#pragma unroll
            for (int j = 0; j < 8; ++j) { const f32x4 w = gl[lane + 64 * j]; f32x4 o; o.x = v[j].x * r * w.x; o.y = v[j].y * r * w.y; o.z = v[j].z * r * w.z; o.w = v[j].w * r * w.w; xr[64 * j] = o; }
        }
    }
    __syncthreads();
}
constexpr int NPH = 1 + 9 * NL;
__global__ void __launch_bounds__(NTHREADS, 2) mk_fwd(Args a) {
    extern __shared__ __attribute__((aligned(16))) unsigned char lds_raw[];
    Ctx c; c.lds = (LAS unsigned char*)lds_raw;
    c.wave = __builtin_amdgcn_readfirstlane((int)threadIdx.x >> 6);
    c.lane = lane_id(); c.tid = c.wave * 64 + c.lane;
    c.G = gridDim.x; { const int bx = blockIdx.x; c.vcu = (c.G % 8 == 0) ? (bx % 8) * (c.G / 8) + bx / 8 : bx; }
    volatile LAS unsigned* MISC = (volatile LAS unsigned*)(c.lds + MISC_OFF);
    for (int u = c.tid; u < (LDS_BYTES - LDSCTL_OFF) / 4; u += NTHREADS) ((LAS unsigned*)(c.lds + LDSCTL_OFF))[u] = 0u;
    const bool leader0 = false; (void)leader0;
    __syncthreads();
    const int lo = a.ph_lo, hi = a.ph_hi;
    unsigned* ctl = (unsigned*)(a.ws + WS_CTL);
    XcdBarrier bar; bar.bar = ctl + CW_BAR; bar.x = 0; bar.st = nullptr;
    if (hi - lo > 1) bar = xcd_barrier_post(ctl + CW_BAR, MISC + 8, c.tid == 0);
    unsigned char* ws = a.ws;
#define IN(k) (lo <= (k) && (k) < hi)
#ifndef MK_PHMASK
#define MK_PHMASK 0x3ff
#endif
#define EN(b) ((MK_PHMASK >> (b)) & 1)
#ifndef MK_REPMASK
#define MK_REPMASK 0
#endif
#ifndef MK_NRSTAGE
#define MK_NRSTAGE 1
#endif
#define REPS_ON(b) (((MK_REPMASK >> (b)) & 1) != 0)
#ifndef MK_REPN
#define MK_REPN 3
#endif
#define REPS(b) (((MK_REPMASK >> (b)) & 1) ? MK_REPN : 1)
#define SEAM(k) do { if (IN((k) + 1)) { const int _ln = lane_id(); xcd_barrier(bar, c.wave == 0 && _ln == 0); } } while (0)
#ifndef MK_SELCVT
#define MK_SELCVT 2400
#endif
#define par0b_() ({ int _b = (int)blockIdx.x; asm volatile("" : "+s"(_b)); _b; })
#define FRESH(cc) Ctx cc = c; cc.lane = lane_id(); cc.tid = cc.wave * 64 + cc.lane

    if (EN(0) && IN(0)) {
        { FRESH(cc); p0_prologue(a, cc); }
        SEAM(0); }

    for (int l = 0; l < NL; ++l) {
        const int pb = 1 + 9 * l, li = l >> 1; const bool odd = (l & 1) != 0;
        if (EN(1) && IN(pb + 0)) {
            pg8::Sched Sc{}; Sc.G = c.G; Sc.c = (int)blockIdx.x; Sc.A = (long)WS_H; Sc.tA = 256 * D * 2; Sc.sA = 0; Sc.sB = 0; Sc.tB = 256 * D * 2; Sc.nM = S / 256; Sc.nG = 1; Sc.gidx = nullptr;
            pg8::EpiBf16 E{}; E.O = (bf16_t*)(ws + WS_Z); E.gcol = 0; E.O2 = (bf16_t*)(ws + WS_VT); E.ldc2 = S;
            if (!odd) { Sc.B = (long)(WS_EVIN + li * SZ_EVIN); Sc.nN = QKF_LD / 256; E.ldc = QKF_LD;
                Sc.nExtra = 64; Sc.nFull = 384; }
            else { Sc.B = (long)(WS_ODIN + li * SZ_ODIN); Sc.nN = OD_IN / 256; E.ldc = OD_IN; Sc.nExtra = 0; Sc.nFull = (S / 256) * (OD_IN / 256); }
#if MK_JITCVT
            int par0 = (int)blockIdx.x; asm volatile("" : "+s"(par0)); par0 &= 1;
            const bool solo = !odd && c.G == 256;
            if (solo) { if (par0b_() >= 128) { FRESH(cc); moe_cvt(a, cc, l, 0, par0b_() - 128, 128); __syncthreads(); } }
            else if (par0 == 0) { FRESH(cc); moe_cvt(a, cc, l, 0); __syncthreads(); }
#endif
            pg8::gemm_phase<pg8::EpiBf16, false>(c.lds, c.wave, (const char*)ws, D, D, D, Sc, E);
#if MK_JITCVT
            int par0b = (int)blockIdx.x; asm volatile("" : "+s"(par0b));
            if (!(!odd && c.G == 256) && (par0b & 1) != 0) { FRESH(cc); moe_cvt(a, cc, l, 0); __syncthreads(); }
#endif
            SEAM(pb + 0);
        }
        if (EN(2) && IN(pb + 1)) {
#if MK_JITCVT && MK_UPHOST
            { int parm = (int)blockIdx.x; asm volatile("" : "+s"(parm)); if ((parm & 1) == 0) { FRESH(cc); moe_cvt(a, cc, l, 1); __syncthreads(); } }
#endif
            if (!odd) {
#ifndef MK_SUB
#define MK_SUB 7
#endif
                _Pragma("unroll 1") for (int rep = 0; rep < REPS(10); ++rep) if (MK_SUB & 1) for (int u = c.vcu; u < 256; u += c.G) { FRESH(cc); attn_unit(a, cc, li, u >> 2, u & 3); }
                _Pragma("unroll 1") for (int rep = 0; rep < REPS(11); ++rep) if (MK_SUB & 2) for (int u = c.vcu; u < 256; u += c.G) { FRESH(cc); ffta_unit(a, cc, u >> 6, u & 63); }
            } else {
                _Pragma("unroll 1") for (int rep = 0; rep < REPS(13); ++rep) if (MK_SUB & 4) for (int u = c.vcu; u < 256; u += c.G) { FRESH(cc); if (MK_ODDMIX2) oddmix_unit2(a, cc, li, u); else oddmix_unit(a, cc, li, u); }
            }
#if MK_JITCVT && MK_UPHOST
            { int parm = (int)blockIdx.x; asm volatile("" : "+s"(parm)); if ((parm & 1) != 0) { __syncthreads(); FRESH(cc); moe_cvt(a, cc, l, 1); __syncthreads(); } }
#endif
            SEAM(pb + 1);
        }
        if (EN(3) && IN(pb + 2)) {
            if (!odd) {
                _Pragma("unroll 1") for (int rep = 0; rep < REPS(12); ++rep) if (MK_SUB & 1) for (int u = c.vcu; u < 256; u += c.G) { FRESH(cc); fftc_unit(a, cc, u >> 2, u & 3); }
                __syncthreads();
            }
            if (!odd)             SEAM(pb + 2);
        }
        if (EN(4) && IN(pb + 3)) {
            const int Kk = odd ? D : MIX_LD_EV;
            pg8::Sched Sc{}; Sc.G = c.G; Sc.c = (int)blockIdx.x; Sc.A = (long)WS_MIX; Sc.sA = 0; Sc.tA = 256 * Kk * 2;
            Sc.B = (long)(odd ? WS_ODOUT + li * SZ_ODOUT : WS_EVOUT + li * SZ_EVOUT); Sc.sB = 0; Sc.tB = 256 * Kk * 2;
            Sc.nM = S / 256; Sc.nN = D / 256; Sc.nG = 1; Sc.gidx = nullptr; Sc.nExtra = 0; Sc.nFull = 256;
            pg8::EpiResF32 E{}; E.R = (l == 0) ? a.x_in : a.X; E.X = a.X; E.ldc = D;
#if MK_JITCVT && !MK_UPHOST
            int par1 = (int)blockIdx.x; asm volatile("" : "+s"(par1)); par1 &= 1;
            if (par1 == 0) { FRESH(cc); moe_cvt(a, cc, l, 1); __syncthreads(); }
#endif
            pg8::gemm_phase<pg8::EpiResF32, false>(c.lds, c.wave, (const char*)ws, Kk, Kk, Kk, Sc, E);
#if MK_JITCVT && !MK_UPHOST
            int par1b = (int)blockIdx.x; asm volatile("" : "+s"(par1b));
            if ((par1b & 1) != 0) { FRESH(cc); moe_cvt(a, cc, l, 1); __syncthreads(); }
#endif
#if MK_NRSTAGE
            if (IN(pb + 4) && EN(5) && !REPS_ON(14)) { FRESH(cc); norm_router_stage(a, cc, l); }
#endif
            SEAM(pb + 3);
        }
        if (EN(5) && IN(pb + 4)) { _Pragma("unroll 1") for (int rep = 0; rep < REPS(14); ++rep) { FRESH(cc); norm_router_phase(a, cc, l, MK_NRSTAGE && EN(4) && IN(pb + 3) && !REPS_ON(14)); } SEAM(pb + 4); }
        if (EN(6) && IN(pb + 5)) { _Pragma("unroll 1") for (int rep = 0; rep < REPS(6); ++rep) { FRESH(cc); int bx = (int)blockIdx.x; asm volatile("" : "+s"(bx));
              if (bx < NE) select_phase(a, cc, bx);
#if MK_JITCVT
              else if (c.G == 256) moe_cvt(a, cc, l, 2, bx - NE, 256 - NE, 0, MK_SELCVT);
#endif
#ifdef MK_SELSLEEP
              else { for (int q = 0; q < MK_SELSLEEP; ++q) __builtin_amdgcn_s_sleep(127); }
#endif
            } SEAM(pb + 5); }
        if (EN(7) && IN(pb + 6)) {
            pg8::Sched Sc{}; Sc.G = c.G; Sc.c = (int)blockIdx.x; Sc.A = (long)WS_H; Sc.sA = 0; Sc.tA = 0; Sc.B = (long)(WS_GU + l * SZ_GU); Sc.sB = (long)2048 * D * 2; Sc.tB = 256 * D * 2;
            Sc.nM = CAP / 256; Sc.nN = 2048 / 256; Sc.nG = NE; Sc.gidx = (const int*)(ws + WS_IDX); Sc.nExtra = 0; Sc.nFull = 512;
            pg8::EpiGU E{}; E.HID = (bf16_t*)(ws + WS_HID);
#if MK_JITCVT
            int par2 = (int)blockIdx.x; asm volatile("" : "+s"(par2)); par2 &= 1;
            if (par2 == 0) { FRESH(cc); moe_cvt(a, cc, l, 2, -1, 0, (c.G == 256) ? MK_SELCVT : 0); __syncthreads(); }
#endif
            pg8::gemm_phase<pg8::EpiGU, true>(c.lds, c.wave, (const char*)ws, D, D, D, Sc, E);
#if MK_JITCVT
            int par2b = (int)blockIdx.x; asm volatile("" : "+s"(par2b));
            if ((par2b & 1) != 0) { FRESH(cc); moe_cvt(a, cc, l, 2, -1, 0, (c.G == 256) ? MK_SELCVT : 0); __syncthreads(); }
#endif
            SEAM(pb + 6);
        }
        if (EN(8) && IN(pb + 7)) {
            pg8::Sched Sc{}; Sc.G = c.G; Sc.c = (int)blockIdx.x; Sc.A = (long)WS_HID; Sc.sA = (long)CAP * EH * 2; Sc.tA = 256 * EH * 2; Sc.B = (long)(WS_DN + l * SZ_DN); Sc.sB = (long)D * EH * 2; Sc.tB = 256 * EH * 2;
            Sc.nM = CAP / 256; Sc.nN = D / 256; Sc.nG = NE; Sc.gidx = nullptr; Sc.nExtra = 0; Sc.nFull = 512;
            pg8::EpiDown E{}; E.Y = (bf16_t*)(ws + WS_Y); E.gate = (const float*)(ws + WS_GATE);
            pg8::gemm_phase<pg8::EpiDown, false>(c.lds, c.wave, (const char*)ws, EH, EH, EH, Sc, E);
#if MK_NRSTAGE
            if (IN(pb + 8) && EN(9)) { FRESH(cc); combine_stage(a, cc, l); }
#endif
            SEAM(pb + 7);
        }
        if (EN(9) && IN(pb + 8)) { FRESH(cc); combine_phase(a, cc, l, MK_NRSTAGE && EN(8) && IN(pb + 7)); SEAM(pb + 8); }
    }
#undef IN
#undef SEAM
}
}


extern "C" void kernel_launch(void* const* d_in, const int* in_sizes, int n_in, void* d_out, int out_size, void* d_ws, size_t ws_size, hipStream_t stream) {
    using namespace mk;
    static int grid = 0;
    if (grid == 0) {
        int dev = 0, cus = 0, per_cu = 0;
        if (hipGetDevice(&dev) != hipSuccess || hipDeviceGetAttribute(&cus, hipDeviceAttributeMultiprocessorCount, dev) != hipSuccess) { fprintf(stderr, "kernel_launch: device query failed\n"); grid = -1; return; }
        if (hipFuncSetAttribute((const void*)mk_fwd, hipFuncAttributeMaxDynamicSharedMemorySize, LDS_BYTES) != hipSuccess) { fprintf(stderr, "kernel_launch: hipFuncSetAttribute failed\n"); grid = -1; return; }
        if (hipOccupancyMaxActiveBlocksPerMultiprocessor(&per_cu, (const void*)mk_fwd, NTHREADS, LDS_BYTES) != hipSuccess || per_cu < 1) fprintf(stderr, "kernel_launch: occupancy query reports %d blocks per CU\n", per_cu);
        (void)hipGetLastError();
        grid = cus;
        if (ws_size < WS_END) { fprintf(stderr, "kernel_launch: workspace too small: %zu < %zu\n", ws_size, (size_t)WS_END); grid = -1; return; }
    }
    if (grid < 0) return;
    (void)hipMemsetAsync((char*)d_ws + WS_CTL, 0, CTL_ZERO_BYTES, stream);
    Args a{};
    a.x_in = (const float*)d_in[0]; a.rel_bias = (const float*)d_in[1]; a.norm_mix_g = (const float*)d_in[2]; a.norm_ffn_g = (const float*)d_in[3]; a.final_g = (const float*)d_in[4];
    a.ev_w_in = (const float*)d_in[5]; a.ev_sink = (const float*)d_in[6]; a.ev_w_out = (const float*)d_in[7];
    a.od_w_in = (const float*)d_in[8]; a.od_conv_w = (const float*)d_in[9]; a.od_pool_w = (const float*)d_in[10]; a.od_pool_scale = (const float*)d_in[11]; a.od_w_out = (const float*)d_in[12];
    a.moe_w_router = (const float*)d_in[13]; a.moe_w_gate = (const float*)d_in[14]; a.moe_w_up = (const float*)d_in[15]; a.moe_w_down = (const float*)d_in[16];
    a.X = (float*)d_out; a.ws = (unsigned char*)d_ws;
#if MK_DEBUG
    mkref::debug_run(a, grid, d_in, d_out, d_ws, ws_size, stream);
#else
#if MK_NLAUNCH == 1
    a.ph_lo = 0; a.ph_hi = NPH;
    hipLaunchKernelGGL(mk_fwd, dim3(grid), dim3(NTHREADS), LDS_BYTES, stream, a);
#else
    for (int p = 0; p < NPH; ++p) { const int type = p == 0 ? 0 : ((p - 1) % 9) + 1; const int layer = p == 0 ? 0 : (p - 1) / 9; (void)layer;
        int reps = 1;
#if defined(MK_HREPMASK)
        if (((MK_HREPMASK >> type) & 1) && ((MK_HREPLAYERS >> layer) & 1)) reps = MK_HREPN;
#endif
        for (int r = 0; r < reps; ++r) { a.ph_lo = p; a.ph_hi = p + 1; hipLaunchKernelGGL(mk_fwd, dim3(grid), dim3(NTHREADS), LDS_BYTES, stream, a); } }
#if defined(MK_HREP_EMPTY)
    for (int r = 0; r < MK_HREP_EMPTY; ++r) { a.ph_lo = NPH; a.ph_hi = NPH; hipLaunchKernelGGL(mk_fwd, dim3(grid), dim3(NTHREADS), LDS_BYTES, stream, a); }
#endif
#endif
    if (hipPeekAtLastError() != hipSuccess) fprintf(stderr, "kernel_launch: launch failed\n");
#endif
}
```

```cpp
#include <hip/hip_runtime.h>
#include <cstdio>
#include <cstdint>

#ifndef MK_DEBUG
#define MK_DEBUG 0
#endif
#ifndef MK_NLAUNCH
#define MK_NLAUNCH 1
#endif

namespace mk {
constexpr int S = 8192, D = 2048;
constexpr int NL = MK_DEBUG ? 2 : 4;
constexpr int HD = 128, NQ = 12, NKV = 4, WIN = 128;
#ifndef MK_FFTFUSE
#define MK_FFTFUSE 1
#endif
constexpr int QDIM = 1536, KVDIM = 512, FDIM = 512, EV_IN = 3072, QKF_LD = 2560, MIX_LD_EV = MK_FFTFUSE ? 2048 : 2560;
constexpr int CONVD = 1024, POOLD = 1024, OD_IN = 4096;
constexpr int NE = 16, EH = 1024, CAP = 1024;
constexpr float EPS = 1e-6f;
constexpr int NWAVES = 8, NTHREADS = 512;

typedef unsigned short bf16_t;
typedef short bf16x8 __attribute__((ext_vector_type(8)));
typedef short s16x4 __attribute__((ext_vector_type(4)));
typedef float f32x4 __attribute__((ext_vector_type(4)));
typedef float f32x2 __attribute__((ext_vector_type(2)));
typedef unsigned u32x4 __attribute__((ext_vector_type(4)));
typedef unsigned u32x2 __attribute__((ext_vector_type(2)));
#define LAS __attribute__((address_space(3)))
#define GAS __attribute__((address_space(1)))
#define LDS_WAIT() asm volatile("s_waitcnt lgkmcnt(0)" ::: "memory")
#define VM_WAIT() asm volatile("s_waitcnt vmcnt(0)" ::: "memory")

constexpr size_t MiB = 1u << 20;
constexpr size_t WS_CTL = 0, CTL_ZERO_BYTES = 1 * MiB;
constexpr size_t WS_AFF = 1 * MiB;
constexpr size_t WS_INV = WS_AFF + 512 * 1024;
constexpr size_t WS_IDX = 2 * MiB;
constexpr size_t WS_GATE = WS_IDX + 64 * 1024;
constexpr size_t WS_PAR = 3 * MiB;
constexpr int PAR_RELB = 0, PAR_SINK = 384, PAR_GMIX = 512, PAR_GFFN = PAR_GMIX + 4 * 2048, PAR_GFIN = PAR_GFFN + 4 * 2048, PAR_CONV = PAR_GFIN + 2048, PAR_ROUTER = 32768, PAR_PTRS = 32000;
constexpr size_t WS_FTC = WS_PAR + 768 * 1024;
constexpr size_t WS_FTA = WS_PAR + 896 * 1024;
constexpr size_t WS_FCO = WS_PAR + 912 * 1024;
constexpr size_t WS_H = 4 * MiB;
constexpr size_t WS_Z = 36 * MiB;
constexpr size_t WS_VT = 100 * MiB;
constexpr size_t WS_MIX = 108 * MiB;
constexpr size_t WS_TB = 148 * MiB;
constexpr size_t WS_POOLED = 164 * MiB;
constexpr size_t WS_HID = 180 * MiB;
constexpr size_t WS_Y = 212 * MiB;
constexpr size_t WS_W = 276 * MiB;
constexpr size_t SZ_EVIN = (size_t)EV_IN * D * 2, SZ_EVOUT = (size_t)D * MIX_LD_EV * 2, SZ_ODIN = (size_t)OD_IN * D * 2, SZ_ODOUT = (size_t)D * D * 2, SZ_POOL = (size_t)4 * 256 * 256 * 2;
constexpr size_t SZ_GU = (size_t)NE * 2048 * D * 2, SZ_DN = (size_t)NE * D * EH * 2;
constexpr size_t WS_EVIN = WS_W, WS_EVOUT = WS_EVIN + (NL / 2) * SZ_EVIN, WS_ODIN = WS_EVOUT + (NL / 2) * SZ_EVOUT, WS_ODOUT = WS_ODIN + (NL / 2) * SZ_ODIN,
                 WS_POOLW = WS_ODOUT + (NL / 2) * SZ_ODOUT, WS_GU = WS_POOLW + (NL / 2) * SZ_POOL, WS_DN = WS_GU + NL * SZ_GU, WS_END = WS_DN + NL * SZ_DN;
constexpr int CW_TMO = 0, CW_CODE = 1, CW_BAR = 4096;

constexpr int RING_BYTES = 131072;
constexpr int LDSCTL_OFF = RING_BYTES, MISC_OFF = LDSCTL_OFF + 320;
constexpr int LDS_BYTES = 163840;

__device__ __forceinline__ unsigned f2bf(float f) { unsigned u = __builtin_bit_cast(unsigned, f); return (u + 0x7fffu + ((u >> 16) & 1u)) >> 16; }
__device__ __forceinline__ unsigned pk2(float lo, float hi) { return f2bf(lo) | (f2bf(hi) << 16); }
typedef __bf16 bf16x2_t __attribute__((ext_vector_type(2)));
__device__ __forceinline__ unsigned cvt_pk_bf16(float lo, float hi) { const f32x2 v = {lo, hi}; return __builtin_bit_cast(unsigned, __builtin_convertvector(v, bf16x2_t)); }
__device__ __forceinline__ unsigned cvt_pk_bf16_v(float lo, float hi) { unsigned r; asm volatile("v_cvt_pk_bf16_f32 %0, %1, %2" : "=v"(r) : "v"(lo), "v"(hi)); return r; }
__device__ __forceinline__ float bf_lo(unsigned w) { return __builtin_bit_cast(float, w << 16); }
__device__ __forceinline__ float bf_hi(unsigned w) { return __builtin_bit_cast(float, w & 0xffff0000u); }
__device__ __forceinline__ int lane_id() { int l; asm volatile("v_mbcnt_lo_u32_b32 %0, -1, 0\n\tv_mbcnt_hi_u32_b32 %0, -1, %0" : "=v"(l)); return l; }
__device__ __forceinline__ float shx(float v, int o, int lane) { return __builtin_bit_cast(float, __builtin_amdgcn_ds_bpermute((lane ^ o) << 2, __builtin_bit_cast(int, v))); }
__device__ __forceinline__ int shxi(int v, int o, int lane) { return __builtin_amdgcn_ds_bpermute((lane ^ o) << 2, v); }
__device__ __forceinline__ float wave_sum(float v, int lane) {
#pragma unroll
    for (int o = 1; o < 64; o <<= 1) v += shx(v, o, lane);
    return v;
}
__device__ __forceinline__ int wave_sum_dpp(int v) {
    int t = v + __builtin_amdgcn_update_dpp(0, v, 0x111, 0xf, 0xf, true);
    t += __builtin_amdgcn_update_dpp(0, v, 0x112, 0xf, 0xf, true);
    t += __builtin_amdgcn_update_dpp(0, v, 0x113, 0xf, 0xf, true);
    t += __builtin_amdgcn_update_dpp(0, t, 0x114, 0xf, 0xe, true);
    t += __builtin_amdgcn_update_dpp(0, t, 0x118, 0xf, 0xc, true);
    t += __builtin_amdgcn_update_dpp(0, t, 0x142, 0xa, 0xf, true);
    t += __builtin_amdgcn_update_dpp(0, t, 0x143, 0xc, 0xf, true);
    return __builtin_amdgcn_readlane(t, 63);
}
__device__ __forceinline__ int wave_sum_i(int v, int lane) {
#pragma unroll
    for (int o = 1; o < 64; o <<= 1) v += shxi(v, o, lane);
    return v;
}

namespace pg8 {
constexpr int BM = 256, BK = 64, HALF = 128, HTB = HALF * BK * 2, STAGE_BYTES = 8 * HTB, NXCD = 8, WGM = 8;
__host__ __device__ __forceinline__ int lds_byte(int r, int c) { const int st = (r >> 4) * 2 + (c >> 5), rr = r & 15, cc = c & 31, ob = rr * 64 + cc * 2; return st * 1024 + (ob ^ (((ob >> 9) & 1) << 5)); }
__host__ __device__ __forceinline__ void stage_rc(int b, int& R, int& C) { const int st = b / 1024, sb = b % 1024, swz = sb ^ (((sb >> 9) & 1) << 5); R = (st >> 1) * 16 + swz / 64; C = (st & 1) * 32 + (swz % 64) / 2; }
__host__ __device__ __forceinline__ int perm32(int rho) { const int n = rho >> 4, i = rho & 15; return 8 * (i >> 2) + 4 * n + (i & 3); }

struct Unit { long offA, offB; int gio, pm, pn, grp, kind, half, hsel; };

struct Sched {
    long A, B, sA, sB;
    int tA, tB; int nM, nN, nG, G, c; const int* gidx;
    int nExtra;
    int nFull;
    __device__ __forceinline__ bool next(int i, Unit& u) const {
        const int nreg = nM * nN * nG, ntot = nreg + nExtra; const int L0 = i * G + c;
        if (L0 >= nFull + 2 * (ntot - nFull)) return false;
        const bool hf = L0 >= nFull; const int L = hf ? nFull + ((L0 - nFull) >> 1) : L0; const int hs = hf ? ((L0 - nFull) & 1) : 0;
        const bool ex = L >= nreg;
        int wgid = ex ? 0 : L; { const int q = nreg / NXCD, r = nreg % NXCD, xcd = wgid % NXCD, off = wgid / NXCD; wgid = (xcd < r ? xcd * (q + 1) : r * (q + 1) + (xcd - r) * q) + off; }
        int pm, pn, grp;
        if (nG == 1) {
            const int nig = WGM * nN, gid = wgid / nig, fm = gid * WGM, gsz = (nM - fm) < WGM ? (nM - fm) : WGM;
            pm = fm + ((wgid % nig) % gsz); pn = (wgid % nig) / gsz; grp = 0;
        } else { const int per = nM * nN; grp = wgid / per; const int r = wgid % per; pm = r % nM; pn = r / nM; }
        const int j = L - nreg;
        u.pm = ex ? (j & 1) : pm; u.pn = ex ? (j >> 1) : pn; u.grp = ex ? 0 : grp; u.kind = ex ? 1 : 0; u.half = hf ? 1 : 0; u.hsel = hs;
        u.gio = grp * (nM * BM) + pm * BM;
        const long ra = A + grp * sA + (gidx ? 0 : (long)pm * tA), rb = B + grp * sB + (long)pn * tB;
        u.offA = (ex ? B + (long)(nN + (j & 1)) * tB : ra) + (long)hs * ((ex ? tB : tA) >> 1); u.offB = ex ? A + (long)(j >> 1) * tA : rb;
        return true;
    }
};

struct EpiBf16 {
    static constexpr bool PERM = true, INIT_ACC = false, HALVES = true;
    bf16_t* O; int ldc; int gcol; bf16_t* O2; int ldc2;
    __device__ __forceinline__ void operator()(const f32x4 (&acc)[2][2][4][2], const Unit& u, int wr, int wc, int fr, int fq) const {
        bf16_t* base; int ld;
        if (u.kind) { base = O2 + (size_t)(u.pm * BM) * ldc2 + u.pn * BM; ld = ldc2; } else { base = O + (size_t)(u.pm * BM) * ldc + u.pn * BM + u.grp * gcol; ld = ldc; }
        bf16_t* rowp = base + (unsigned)((wr * 64 + fr + u.hsel * HALF) * ld + wc * 32 + 8 * fq);
#pragma unroll
        for (int ai = 0; ai < 2; ++ai) {
            if (ai == 1 && u.half) break;
#pragma unroll
            for (int m = 0; m < 4; ++m) {
#pragma unroll
                for (int bj = 0; bj < 2; ++bj) { const f32x4 v0 = acc[ai][bj][m][0], v1 = acc[ai][bj][m][1];
                    u32x4 w; w.x = cvt_pk_bf16(v0[0], v0[1]); w.y = cvt_pk_bf16(v0[2], v0[3]); w.z = cvt_pk_bf16(v1[0], v1[1]); w.w = cvt_pk_bf16(v1[2], v1[3]);
                    *(u32x4*)(rowp + bj * HALF) = w; }
                rowp += 16 * ld; asm volatile("" : "+v"(rowp)); }
            rowp += (HALF - 64) * ld; }
    }
};
struct EpiResF32 {
    static constexpr bool PERM = false, INIT_ACC = true, HALVES = false;
    const float* R; float* X; int ldc;
    __device__ __forceinline__ void init(f32x4 (&acc)[2][2][4][2], const Unit& u, int wr, int wc, int fr, int fq) const {
        const size_t off0 = (size_t)(u.pm * BM + wr * 64 + fr) * ldc + u.pn * BM + wc * 32 + 4 * fq;
#pragma unroll
        for (int ai = 0; ai < 2; ++ai)
#pragma unroll
            for (int m = 0; m < 4; ++m) { const size_t off = off0 + (size_t)(ai * HALF + m * 16) * ldc;
#pragma unroll
                for (int bj = 0; bj < 2; ++bj)
#pragma unroll
                    for (int n = 0; n < 2; ++n) acc[ai][bj][m][n] = *(const f32x4*)(R + off + bj * HALF + n * 16); }
    }
    __device__ __forceinline__ void operator()(const f32x4 (&acc)[2][2][4][2], const Unit& u, int wr, int wc, int fr, int fq) const {
        const size_t off0 = (size_t)(u.pm * BM + wr * 64 + fr) * ldc + u.pn * BM + wc * 32 + 4 * fq;
#pragma unroll
        for (int ai = 0; ai < 2; ++ai)
#pragma unroll
            for (int m = 0; m < 4; ++m) { const size_t off = off0 + (size_t)(ai * HALF + m * 16) * ldc;
#pragma unroll
                for (int bj = 0; bj < 2; ++bj)
#pragma unroll
                    for (int n = 0; n < 2; ++n) *(f32x4*)(X + off + bj * HALF + n * 16) = acc[ai][bj][m][n]; }
    }
};
__device__ __forceinline__ float silu_mul(float g, float u) { return g * u * __builtin_amdgcn_rcpf(1.0f + __expf(-g)); }
struct EpiGU {
    static constexpr bool PERM = true, INIT_ACC = false, HALVES = false;
    bf16_t* HID;
    __device__ __forceinline__ void operator()(const f32x4 (&acc)[2][2][4][2], const Unit& u, int wr, int wc, int fr, int fq) const {
        bf16_t* base = HID + ((size_t)u.grp * CAP + u.pm * BM + wr * 64 + fr) * EH + u.pn * HALF + wc * 32 + 8 * fq;
#pragma unroll
        for (int ai = 0; ai < 2; ++ai)
#pragma unroll
            for (int m = 0; m < 4; ++m) { const f32x4 g0 = acc[ai][0][m][0], g1 = acc[ai][0][m][1], u0 = acc[ai][1][m][0], u1 = acc[ai][1][m][1];
                u32x4 w; w.x = cvt_pk_bf16(silu_mul(g0[0], u0[0]), silu_mul(g0[1], u0[1])); w.y = cvt_pk_bf16(silu_mul(g0[2], u0[2]), silu_mul(g0[3], u0[3]));
                w.z = cvt_pk_bf16(silu_mul(g1[0], u1[0]), silu_mul(g1[1], u1[1])); w.w = cvt_pk_bf16(silu_mul(g1[2], u1[2]), silu_mul(g1[3], u1[3]));
                *(u32x4*)(base + (size_t)(ai * HALF + m * 16) * EH) = w; }
    }
};
struct EpiDown {
    static constexpr bool PERM = true, INIT_ACC = false, HALVES = false;
    bf16_t* Y; const float* gate;
    __device__ __forceinline__ void operator()(const f32x4 (&acc)[2][2][4][2], const Unit& u, int wr, int wc, int fr, int fq) const {
        const int row0 = u.grp * CAP + u.pm * BM + wr * 64 + fr;
        bf16_t* base = Y + (size_t)row0 * D + u.pn * BM + wc * 32 + 8 * fq;
#pragma unroll
        for (int ai = 0; ai < 2; ++ai)
#pragma unroll
            for (int m = 0; m < 4; ++m) { const float gt = gate[row0 + ai * HALF + m * 16]; bf16_t* rowp = base + (size_t)(ai * HALF + m * 16) * D;
#pragma unroll
                for (int bj = 0; bj < 2; ++bj) { const f32x4 v0 = acc[ai][bj][m][0] * gt, v1 = acc[ai][bj][m][1] * gt;
                    u32x4 w; w.x = cvt_pk_bf16(v0[0], v0[1]); w.y = cvt_pk_bf16(v0[2], v0[3]); w.z = cvt_pk_bf16(v1[0], v1[1]); w.w = cvt_pk_bf16(v1[2], v1[3]);
                    *(u32x4*)(rowp + bj * HALF) = w; } }
    }
};

template <class Epi, bool GATHER>
__device__ __forceinline__ void gemm_phase(LAS unsigned char* lds, const int wid_in, const char* wsb, const int K, const int lda, const int ldb, const Sched& S, const Epi& E) {
    int wid = wid_in; asm volatile("" : "+s"(wid));
    const int lane = lane_id();
    const int tid = wid * 64 + lane, wr = wid >> 2, wc = wid & 3, fr = lane & 15, fq = lane >> 4;
    const int nt = K / BK;
    unsigned voffA[2][2], voffB[2];
#pragma unroll
    for (int i = 0; i < 2; ++i) { int R, C; stage_rc(tid * 16 + i * 8192, R, C); const int Rb = Epi::PERM ? ((R & ~31) + perm32(R & 31)) : R;
        voffA[0][i] = (unsigned)(R * lda + C) * 2u; voffA[1][i] = voffA[0][i]; voffB[i] = (unsigned)(Rb * ldb + C) * 2u; }
    const size_t hstepA = GATHER ? (size_t)0 : (size_t)HALF * lda * 2;
    const size_t kstep = (size_t)(BK * 2);
    const size_t hstepB = (size_t)HALF * ldb * 2;
    const unsigned ldsw = (unsigned)wid * 1024u;
    const int aoff = lds_byte(wr * 64 + fr, fq * 8), boff = lds_byte(wc * 32 + fr, fq * 8);
#define PG8_SA(b, h) (((b) * 2 + (h)) * HTB)
#define PG8_SB(b, h) ((4 + (b) * 2 + (h)) * HTB)
#define PG8_STAGEA(bufoff, gbase, h) do { _Pragma("unroll") for (int _i = 0; _i < 2; ++_i) \
        __builtin_amdgcn_global_load_lds((const unsigned*)((const char*)(gbase) + (h) * hstepA + voffA[GATHER ? (h) : 0][_i]), (LAS unsigned*)(lds + (bufoff) + ldsw + _i * 8192), 16, 0, 0); } while (0)
#define PG8_STAGEB(bufoff, gbase) do { _Pragma("unroll") for (int _i = 0; _i < 2; ++_i) \
        __builtin_amdgcn_global_load_lds((const unsigned*)((const char*)(gbase) + voffB[_i]), (LAS unsigned*)(lds + (bufoff) + ldsw + _i * 8192), 16, 0, 0); } while (0)
#define PG8_LDA(dst, b, h) do { _Pragma("unroll") for (int m = 0; m < 4; ++m) _Pragma("unroll") for (int k = 0; k < 2; ++k) dst[m][k] = *(const LAS bf16x8*)(lds + PG8_SA(b, h) + aoff + m * 2048 + k * 1024); } while (0)
#define PG8_LDB(dst, b, h) do { _Pragma("unroll") for (int n = 0; n < 2; ++n) _Pragma("unroll") for (int k = 0; k < 2; ++k) dst[n][k] = *(const LAS bf16x8*)(lds + PG8_SB(b, h) + boff + n * 2048 + k * 1024); } while (0)
#define PG8_MMA(ai, bj, At, Bt) do { __builtin_amdgcn_s_setprio(1); _Pragma("unroll") for (int m = 0; m < 4; ++m) _Pragma("unroll") for (int n = 0; n < 2; ++n) _Pragma("unroll") for (int k = 0; k < 2; ++k) \
        acc[ai][bj][m][n] = __builtin_amdgcn_mfma_f32_16x16x32_bf16(Bt[n][k], At[m][k], acc[ai][bj][m][n], 0, 0, 0); __builtin_amdgcn_s_setprio(0); } while (0)
#define PG8_WAIT_V(n) asm volatile("s_waitcnt vmcnt(" #n ")" ::: "memory")
#define PG8_WAIT_L(n) asm volatile("s_waitcnt lgkmcnt(" #n ")" ::: "memory")
#define PG8_BAR __builtin_amdgcn_s_barrier()
#define PG8_SCHED __builtin_amdgcn_sched_barrier(0)
#define PG8_GIDX(dst, uu) do { _Pragma("unroll") for (int _i = 0; _i < 2; ++_i) { int _R, _C; stage_rc(tid * 16 + _i * 8192, _R, _C); _Pragma("unroll") for (int _h = 0; _h < 2; ++_h) \
        dst[_h][_i] = (unsigned)(S.gidx[(uu).gio + _R + _h * HALF] * lda + _C) * 2u; } } while (0)
    Unit cur, nxt; int ui = 0;
    if (!S.next(0, cur)) return;
    f32x4 acc[2][2][4][2];
    if constexpr (Epi::INIT_ACC) { E.init(acc, cur, wr, wc, fr, fq); } else {
#pragma unroll
    for (int a = 0; a < 2; ++a)
#pragma unroll
        for (int b = 0; b < 2; ++b)
#pragma unroll
            for (int m = 0; m < 4; ++m)
#pragma unroll
                for (int n = 0; n < 2; ++n) acc[a][b][m][n] = (f32x4){0.f, 0.f, 0.f, 0.f};
    }
    bf16x8 At[4][2], B0[2][2], B1[2][2];
    const char* cA = wsb + cur.offA; const char* cB = wsb + cur.offB;
    if constexpr (GATHER) { PG8_GIDX(voffA, cur); }
    PG8_STAGEB(PG8_SB(0, 0), cB); PG8_STAGEB(PG8_SB(0, 1), cB + hstepB); PG8_STAGEA(PG8_SA(0, 0), cA, 0); PG8_STAGEA(PG8_SA(0, 1), cA, 1);
    if (wr == 1) PG8_BAR;
    PG8_WAIT_V(2); PG8_BAR;
    PG8_STAGEB(PG8_SB(1, 0), cB + kstep); PG8_STAGEA(PG8_SA(1, 0), cA + kstep, 0); PG8_STAGEB(PG8_SB(1, 1), cB + hstepB + kstep);
    PG8_WAIT_V(6); PG8_BAR;
    for (;;) {
        const bool has_next = S.next(ui + 1, nxt);
        const char* nA = has_next ? wsb + nxt.offA : cA; const char* nB = has_next ? wsb + nxt.offB : cB;
        for (int t = 0; t < nt; t += 2) {
            const bool last = (t == nt - 2);
            const char* a1 = cA + (size_t)(t + 1) * kstep;
            const char* a2 = last ? nA : cA + (size_t)(t + 2) * kstep; const char* b2 = last ? nB : cB + (size_t)(t + 2) * kstep;
            const char* a3 = a2 + kstep; const char* b3 = b2 + kstep;
            unsigned nv[2][2];
            if constexpr (GATHER) { if (last && has_next) { PG8_GIDX(nv, nxt); } }
            PG8_LDB(B0, 0, 0); PG8_LDB(B1, 0, 1); PG8_SCHED; PG8_LDA(At, 0, 0); PG8_STAGEA(PG8_SA(1, 1), a1, 1);
            if constexpr (GATHER) { if (last && has_next) {
#pragma unroll
                for (int _h = 0; _h < 2; ++_h)
#pragma unroll
                    for (int _i = 0; _i < 2; ++_i) voffA[_h][_i] = nv[_h][_i]; } }
            PG8_WAIT_V(8); PG8_WAIT_L(0); PG8_BAR; PG8_MMA(0, 0, At, B0); PG8_MMA(0, 1, At, B1); PG8_BAR; PG8_SCHED;
            PG8_LDA(At, 0, 1); PG8_STAGEB(PG8_SB(0, 0), b2); PG8_STAGEB(PG8_SB(0, 1), b2 + hstepB); PG8_STAGEA(PG8_SA(0, 0), a2, 0);
            PG8_WAIT_V(8); PG8_WAIT_L(0); PG8_BAR; if (!(Epi::HALVES && cur.half)) { PG8_MMA(1, 0, At, B0); PG8_MMA(1, 1, At, B1); } PG8_BAR; PG8_SCHED;
            PG8_LDB(B0, 1, 0); PG8_LDB(B1, 1, 1); PG8_SCHED; PG8_LDA(At, 1, 0); PG8_STAGEA(PG8_SA(0, 1), a2, 1);
            PG8_WAIT_V(8); PG8_WAIT_L(0); PG8_BAR; PG8_MMA(0, 0, At, B0); PG8_MMA(0, 1, At, B1); PG8_BAR; PG8_SCHED;
            PG8_LDA(At, 1, 1); PG8_STAGEB(PG8_SB(1, 0), b3); PG8_STAGEB(PG8_SB(1, 1), b3 + hstepB); PG8_STAGEA(PG8_SA(1, 0), a3, 0);
            PG8_WAIT_V(8); PG8_WAIT_L(0); PG8_BAR; if (!(Epi::HALVES && cur.half)) { PG8_MMA(1, 0, At, B0); PG8_MMA(1, 1, At, B1); } PG8_BAR; PG8_SCHED;
        }
        if (wr == 0) PG8_BAR;
        { const int le = lane_id(); E(acc, cur, wr, wc, le & 15, le >> 4); }
        if (!has_next) break;
        if constexpr (Epi::INIT_ACC) { E.init(acc, nxt, wr, wc, fr, fq); } else {
#pragma unroll
        for (int a = 0; a < 2; ++a)
#pragma unroll
            for (int b = 0; b < 2; ++b)
#pragma unroll
                for (int m = 0; m < 4; ++m)
#pragma unroll
                    for (int n = 0; n < 2; ++n) acc[a][b][m][n] = (f32x4){0.f, 0.f, 0.f, 0.f};
        }
        cur = nxt; cA = nA; cB = nB; ++ui;
        if (wr == 1) PG8_BAR;
    }
    PG8_WAIT_V(0);
    PG8_BAR;
#undef PG8_SA
#undef PG8_SB
#undef PG8_STAGEA
#undef PG8_STAGEB
#undef PG8_LDA
#undef PG8_LDB
#undef PG8_MMA
#undef PG8_WAIT_V
#undef PG8_WAIT_L
#undef PG8_BAR
#undef PG8_SCHED
#undef PG8_GIDX
}
}
#define XB_TMO      128
#define XB_XCNT(j)  (256  + 64 * (j))
#define XB_XSUB(j)  (1280 + 64 * (j))
#define XB_XGEN(j)  (2304 + 64 * (j))
#define XB_TOP      3328
#define XB_TOPGEN   3392
#define XCD_BAR_WORDS 3456
#define XB_SPIN_CAP (1u << 18)
__device__ __forceinline__ unsigned xb_ld(unsigned* p)              { return __hip_atomic_load(p, __ATOMIC_RELAXED, __HIP_MEMORY_SCOPE_AGENT); }
__device__ __forceinline__ unsigned xb_add(unsigned* p, unsigned v) { return __hip_atomic_fetch_add(p, v, __ATOMIC_RELAXED, __HIP_MEMORY_SCOPE_AGENT); }
__device__ __forceinline__ unsigned xb_xcc_id() { return (unsigned)__builtin_amdgcn_s_getreg((3 << 11) | 20) & 0xFu; }
#define XB_SPIN(cond, bar) do { unsigned _sp = 0; while (cond) { __builtin_amdgcn_s_sleep(1); \
    if ((++_sp & 255u) == 0u) { if (xb_ld(&(bar)[XB_TMO])) break; if (_sp > XB_SPIN_CAP) { atomicAdd(&(bar)[XB_TMO], 1u); break; } } } } while (0)
struct XcdBarrier { unsigned* bar; unsigned x; volatile LAS unsigned* st; };
__device__ __forceinline__ XcdBarrier xcd_barrier_post(unsigned* bar, volatile LAS unsigned* st, bool leader) {
    XcdBarrier b; b.bar = bar; b.x = xb_xcc_id(); b.st = st;
    if (leader) (void)xb_add(&bar[XB_XCNT(b.x)], 1u);
    return b;
}
__device__ __forceinline__ void xcd_barrier_complete(unsigned* bar, unsigned x, unsigned& nloc, unsigned& nx) {
    const unsigned G = gridDim.x * gridDim.y * gridDim.z;
    unsigned sum, cnt, mine, sp = 0u;
    for (;;) {
        sum = 0u; cnt = 0u; mine = 0u;
#pragma unroll
        for (unsigned j = 0; j < 16; ++j) { const unsigned c = xb_ld(&bar[XB_XCNT(j)]); sum += c; cnt += (c > 0u) ? 1u : 0u; mine = (j == x) ? c : mine; }
        if (sum == G) break;
        __builtin_amdgcn_s_sleep(1);
        if ((++sp & 255u) == 0u) { if (xb_ld(&bar[XB_TMO])) break; if (sp > XB_SPIN_CAP) { atomicAdd(&bar[XB_TMO], 1u); break; } }
    }
    nloc = mine > 0u ? mine : 1u; nx = cnt > 0u ? cnt : 1u;
}
__device__ __forceinline__ void xcd_barrier(const XcdBarrier& b, bool leader) {
    asm volatile("s_waitcnt vmcnt(0)" ::: "memory");
    __syncthreads();
    if (leader) {
        unsigned* bar = b.bar;
        __builtin_amdgcn_s_waitcnt(0);
        unsigned nloc = b.st[0], nx = b.st[1];
        if (nloc == 0u) { xcd_barrier_complete(bar, b.x, nloc, nx); b.st[0] = nloc; b.st[1] = nx; }
        const unsigned old = xb_add(&bar[XB_XSUB(b.x)], 1u);
        const unsigned gen = old / nloc;
        if (old + 1u == (gen + 1u) * nloc) {
            __builtin_amdgcn_fence(__ATOMIC_RELEASE, "agent");
            asm volatile("s_waitcnt vmcnt(0)" ::: "memory");
            const unsigned og = xb_add(&bar[XB_TOP], 1u);
            const unsigned tg = og / nx;
            if (og + 1u == (tg + 1u) * nx) xb_add(&bar[XB_TOPGEN], 1u);
            else XB_SPIN(xb_ld(&bar[XB_TOPGEN]) == tg, bar);
            __builtin_amdgcn_fence(__ATOMIC_ACQUIRE, "agent");
            xb_add(&bar[XB_XGEN(b.x)], 1u);
            asm volatile("s_waitcnt vmcnt(0)" ::: "memory");
        } else {
            XB_SPIN(xb_ld(&bar[XB_XGEN(b.x)]) == gen, bar);
            __builtin_amdgcn_fence(__ATOMIC_ACQUIRE, "agent");
            asm volatile("s_waitcnt vmcnt(0)" ::: "memory");
        }
    }
    __syncthreads();
}

struct Args {
    const float* x_in; const float* rel_bias; const float* norm_mix_g; const float* norm_ffn_g; const float* final_g;
    const float* ev_w_in; const float* ev_sink; const float* ev_w_out;
    const float* od_w_in; const float* od_conv_w; const float* od_pool_w; const float* od_pool_scale; const float* od_w_out;
    const float* moe_w_router; const float* moe_w_gate; const float* moe_w_up; const float* moe_w_down;
    float* X; unsigned char* ws; int ph_lo, ph_hi;
};
struct Ctx { LAS unsigned char* lds; int tid, lane, wave, vcu, G; };

__device__ __forceinline__ int t5_bucket(int rel) {
    const int n = rel < 0 ? -rel : rel; int b;
    if (n < 8) b = n; else if (n < 12) b = 8; else if (n < 16) b = 9; else if (n < 23) b = 10; else if (n < 32) b = 11;
    else if (n < 46) b = 12; else if (n < 64) b = 13; else if (n < 91) b = 14; else b = 15;
    return b + (rel > 0 ? 16 : 0);
}

__device__ __forceinline__ void cvt_item(const float* W, int ldw, int k0, int n0, bf16_t* WT, int ldd, int drow, const float* nscale, LAS float* scr, int lane) {
    const int lr = lane >> 4, lc = (lane & 15) * 4;
    f32x4 v[16];
    const float* src = W + (size_t)(k0 + lr) * ldw + n0 + lc;
#pragma unroll
    for (int i = 0; i < 16; ++i) v[i] = __builtin_nontemporal_load((const GAS f32x4*)(src + (size_t)(4 * i) * ldw));
#pragma unroll
    for (int i = 0; i < 16; ++i) { const int row = 4 * i + lr; *(LAS f32x4*)(scr + row * 64 + (lc ^ (4 * ((row >> 3) & 7)))) = v[i]; }
    LDS_WAIT(); asm volatile("" ::: "memory");
    const int c = lane & 7;
#pragma unroll
    for (int j = 0; j < 8; ++j) { const int n = (lane >> 3) + 8 * j; const LAS float* sp = scr + (8 * c) * 64 + (n ^ (4 * c)); const float sc = nscale ? nscale[n0 + n] : 1.0f;
        u32x4 o; o.x = pk2(sp[0 * 64] * sc, sp[1 * 64] * sc); o.y = pk2(sp[2 * 64] * sc, sp[3 * 64] * sc); o.z = pk2(sp[4 * 64] * sc, sp[5 * 64] * sc); o.w = pk2(sp[6 * 64] * sc, sp[7 * 64] * sc);
        __builtin_nontemporal_store(o, (GAS u32x4*)(WT + (size_t)(drow + n) * ldd + k0 + 8 * c)); }
    LDS_WAIT(); asm volatile("" ::: "memory");
}
__device__ __forceinline__ void norm_store_bf16(const f32x4 (&v)[8], const float* g, bf16_t* orow, int lane) {
    float ss = 0.f;
#pragma unroll
    for (int j = 0; j < 8; ++j) ss += (v[j].x * v[j].x + v[j].y * v[j].y) + (v[j].z * v[j].z + v[j].w * v[j].w);
    const float r = rsqrtf(wave_sum(ss, lane) * (1.0f / D) + EPS);
    GAS u32x2* o8 = (GAS u32x2*)orow + lane; const GAS f32x4* g4 = (const GAS f32x4*)g + lane;
#pragma unroll
    for (int j = 0; j < 8; ++j) { const f32x4 w = g4[64 * j]; u32x2 o; o.x = pk2(v[j].x * r * w.x, v[j].y * r * w.y); o.y = pk2(v[j].z * r * w.z, v[j].w * r * w.w); o8[64 * j] = o; }
}

#ifndef MK_ODDMIX2
#define MK_ODDMIX2 1
#endif
#ifndef MK_PV3
#define MK_PV3 1
#endif
#ifndef MK_UPHOST
#define MK_UPHOST 1
#endif
#ifndef MK_JITCVT
#define MK_JITCVT 1
#endif
__device__ __forceinline__ void moe_cvt(const Args& a, const Ctx& c, int l, int part, int rank0 = -1, int nrank = 0, int it_lo = 0, int it_hi = NE * 16 * 32) {
    LAS float* scr = (LAS float*)(c.lds + c.wave * 16384);
    int gw = (rank0 >= 0 ? rank0 : c.vcu) * NWAVES + c.wave; asm volatile("" : "+s"(gw));
    const int NGW = (rank0 >= 0 ? nrank : c.G) * NWAVES;
    unsigned char* ws = a.ws;
    const float* wsrc = (const float*)(((const unsigned long long*)((const float*)(ws + WS_PAR) + PAR_PTRS))[part]);
    if (part < 2) {
        for (int it = it_lo + gw; it < it_hi; it += NGW) { const int le = l * NE + it / 512, r2 = it % 512, kb = r2 / 16, nb = r2 % 16;
            const float* src = wsrc + (size_t)le * D * EH; const int n0 = nb * 64;
            cvt_item(src, EH, kb * 64, n0, (bf16_t*)(ws + WS_GU) + (size_t)le * 2048 * D, D, (n0 >> 7) * 256 + part * 128 + (n0 & 127), nullptr, scr, c.lane); }
    } else {
        for (int it = it_lo + gw; it < it_hi; it += NGW) { const int le = l * NE + it / 512, r = it % 512, kb = r / 32, nb = r % 32;
            cvt_item(wsrc + (size_t)le * EH * D, D, kb * 64, nb * 64, (bf16_t*)(ws + WS_DN) + (size_t)le * D * EH, EH, nb * 64, nullptr, scr, c.lane); }
    }
}

__device__ __forceinline__ u32x4 fftc_bfrag(const LAS float* c128, int w, int ks, int t, int fr, int fq) {
#if MK_FFTFUSE
    const int pq = t, k2 = 16 * w + fr; unsigned wv[4];
#else
    const int pq = w >> 2, k2 = 32 * (w & 3) + 16 * t + fr; unsigned wv[4];
#endif
#pragma unroll
    for (int jj = 0; jj < 4; ++jj) { float v[2];
#pragma unroll
        for (int e = 0; e < 2; ++e) { const int j = 2 * jj + e; const int ss = 32 * ks + 16 * (j >> 2) + 4 * fq + (j & 3); const int ri = ss >> 7, s2 = ss & 127; const int m = (s2 * k2) & 127;
            const float cs = c128[m], sn = c128[(m - 32) & 127];
            v[e] = (pq == 0) ? (ri == 0 ? cs : sn) : (ri == 0 ? -sn : cs); }
        wv[jj] = pk2(v[0], v[1]); }
    u32x4 ww; ww.x = wv[0]; ww.y = wv[1]; ww.z = wv[2]; ww.w = wv[3]; return ww;
}
__device__ __forceinline__ u32x4 fftc_cfrag(const LAS float* c128, int lt, int kap, int plane, int fr, int fq) {
    const int l = 16 * lt + fr; unsigned wv[4];
#pragma unroll
    for (int jj = 0; jj < 4; ++jj) { float v[2];
#pragma unroll
        for (int e = 0; e < 2; ++e) { const int j = 2 * jj + e; const int cch = 32 * kap + 16 * (j >> 2) + 4 * fq + (j & 3); const int m = (l * cch) & 127;
            v[e] = (plane == 0 ? c128[m] : c128[(m - 32) & 127]) * (1.0f / 1024.0f); }
        wv[jj] = pk2(v[0], v[1]); }
    u32x4 ww; ww.x = wv[0]; ww.y = wv[1]; ww.z = wv[2]; ww.w = wv[3]; return ww;
}
__device__ __forceinline__ void ffta_bfrag(const LAS float* c128, int jp, int ks, int fr, int fq, u32x4& wr_, u32x4& wi_) {
    unsigned re[4], im[4];
#pragma unroll
    for (int jj = 0; jj < 4; ++jj) { float cr[2], ci[2];
#pragma unroll
        for (int e = 0; e < 2; ++e) { const int j = 2 * jj + e; const int s1 = 32 * ks + 16 * (j >> 2) + 4 * fq + (j & 3); const int m = (s1 * (16 * jp + fr)) & 63; cr[e] = c128[2 * m]; ci[e] = -c128[2 * ((m - 16) & 63)]; }
        re[jj] = pk2(cr[0], cr[1]); im[jj] = pk2(ci[0], ci[1]); }
    wr_.x = re[0]; wr_.y = re[1]; wr_.z = re[2]; wr_.w = re[3]; wi_.x = im[0]; wi_.y = im[1]; wi_.z = im[2]; wi_.w = im[3];
}

__device__ __forceinline__ void p0_prologue(const Args& a, const Ctx& c) {
    LAS float* scr = (LAS float*)(c.lds + c.wave * 16384);
    const int gw = c.vcu * NWAVES + c.wave, NGW = c.G * NWAVES;
    unsigned char* ws = a.ws;
    LAS float* ctab = (LAS float*)(c.lds + RING_BYTES + 1024);
    __syncthreads();
    if (c.tid < 128) { float sn, cs; sincospif((float)c.tid * (1.0f / 64.0f), &sn, &cs); ctab[c.tid] = cs; }
    __syncthreads();
    if (c.vcu < 8) { const int ks = c.vcu;
#pragma unroll
        for (int t = 0; t < 2; ++t) ((GAS u32x4*)(ws + WS_FTC))[((c.wave * 8 + ks) * 2 + t) * 64 + c.lane] = fftc_bfrag(ctab, c.wave, ks, t, c.lane & 15, c.lane >> 4);
    } else if (c.vcu == 8) { u32x4 wr_, wi_; ffta_bfrag(ctab, c.wave >> 1, c.wave & 1, c.lane & 15, c.lane >> 4, wr_, wi_);
        ((GAS u32x4*)(ws + WS_FTA))[(c.wave * 2 + 0) * 64 + c.lane] = wr_; ((GAS u32x4*)(ws + WS_FTA))[(c.wave * 2 + 1) * 64 + c.lane] = wi_; }
#if MK_FFTFUSE
    else if (c.vcu == 9) {
#pragma unroll
        for (int q = 0; q < 8; ++q) ((GAS u32x4*)(ws + WS_FCO))[((c.wave * 4 + (q >> 1)) * 2 + (q & 1)) * 64 + c.lane] = fftc_cfrag(ctab, c.wave, q >> 1, q & 1, c.lane & 15, c.lane >> 4); }
#endif
#pragma unroll 1
    for (int pass = 0; pass < 2; ++pass) {
#if !MK_FFTFUSE
    if ((pass == 0) == (c.wave < 4)) {
        LAS float* sw = (LAS float*)(c.lds + c.wave * 16384);
        for (int it = gw; it < (NL / 2) * 4 * 64 * 4; it += NGW) {
            const int i = it / 1024, r = it % 1024, g = r / 256, nb = (r % 256) / 4, jq = r % 4;
            const float* wsrc = a.ev_w_out + (size_t)i * D * D + (size_t)(QDIM + 128 * g) * D + nb * 32;
            const int n = c.lane & 31, jb = jq * 64 + (c.lane >> 5) * 32;
            float accv[32];
#pragma unroll
            for (int q = 0; q < 32; ++q) accv[q] = 0.f;
            for (int lp = 0; lp < 2; ++lp) {
#pragma unroll 8
                for (int q = 0; q < 32; ++q) { const int ll = 2 * q + (c.lane >> 5); sw[ll * 32 + n] = wsrc[(size_t)(lp * 64 + ll) * D + n]; }
                LDS_WAIT(); asm volatile("" ::: "memory");
                for (int ll = 0; ll < 64; ++ll) { const float wv = sw[ll * 32 + n]; const int l = lp * 64 + ll;
#pragma unroll
                    for (int q = 0; q < 32; ++q) { const int j = jb + q; const int m = ((j & 127) * l) & 127; const float cf = (j < 128) ? ctab[m] : ctab[(m - 32) & 127]; accv[q] = fmaf(cf, wv, accv[q]); } }
                LDS_WAIT(); asm volatile("" ::: "memory");
            }
            bf16_t* dst = (bf16_t*)(ws + WS_EVOUT + i * SZ_EVOUT) + (size_t)(nb * 32 + n) * MIX_LD_EV + QDIM + g * 256 + jb;
#pragma unroll
            for (int q = 0; q < 4; ++q) { u32x4 o; o.x = pk2(accv[8 * q] * (1.f / 1024.f), accv[8 * q + 1] * (1.f / 1024.f)); o.y = pk2(accv[8 * q + 2] * (1.f / 1024.f), accv[8 * q + 3] * (1.f / 1024.f));
                o.z = pk2(accv[8 * q + 4] * (1.f / 1024.f), accv[8 * q + 5] * (1.f / 1024.f)); o.w = pk2(accv[8 * q + 6] * (1.f / 1024.f), accv[8 * q + 7] * (1.f / 1024.f)); *(GAS u32x4*)(dst + 8 * q) = o; }
        }
    }
#endif
    if (pass == 0) {
    for (int it = gw; it < (NL / 2) * 32 * 48; it += NGW) { const int i = it / (32 * 48), r = it % (32 * 48), kb = r / 48, nb = r % 48;
        const int n0 = nb * 64; const int drow = n0 < 2048 ? n0 : (n0 < 2560 ? n0 + 512 : n0 - 512);
        cvt_item(a.ev_w_in + (size_t)i * D * EV_IN, EV_IN, kb * 64, n0, (bf16_t*)(ws + WS_EVIN + i * SZ_EVIN), D, drow, nullptr, scr, c.lane); }
    constexpr int EVO_KB = MK_FFTFUSE ? 32 : 24;
    for (int it = gw; it < (NL / 2) * EVO_KB * 32; it += NGW) { const int i = it / (EVO_KB * 32), r = it % (EVO_KB * 32), kb = r / 32, nb = r % 32;
        cvt_item(a.ev_w_out + (size_t)i * D * D, D, kb * 64, nb * 64, (bf16_t*)(ws + WS_EVOUT + i * SZ_EVOUT), MIX_LD_EV, nb * 64, nullptr, scr, c.lane); }
    for (int it = gw; it < (NL / 2) * 32 * 64; it += NGW) { const int i = it / (32 * 64), r = it % (32 * 64), kb = r / 64, nb = r % 64;
        cvt_item(a.od_w_in + (size_t)i * D * OD_IN, OD_IN, kb * 64, nb * 64, (bf16_t*)(ws + WS_ODIN + i * SZ_ODIN), D, nb * 64, nullptr, scr, c.lane); }
    for (int it = gw; it < (NL / 2) * 32 * 32; it += NGW) { const int i = it / (32 * 32), r = it % (32 * 32), kb = r / 32, nb = r % 32;
        cvt_item(a.od_w_out + (size_t)i * D * D, D, kb * 64, nb * 64, (bf16_t*)(ws + WS_ODOUT + i * SZ_ODOUT), D, nb * 64, nullptr, scr, c.lane); }
    for (int it = gw; it < (NL / 2) * 4 * 4 * 4; it += NGW) { const int ig = it / 16, i = ig / 4, g = ig % 4, r = it % 16, kb = r / 4, nb = r % 4;
        cvt_item(a.od_pool_w + ((size_t)i * 4 + g) * 65536, 256, kb * 64, nb * 64, (bf16_t*)(ws + WS_POOLW + i * SZ_POOL) + g * 65536, 256, nb * 64, a.od_pool_scale + i * POOLD + g * 256, scr, c.lane); }
    }
    }
    __syncthreads();
    {
        float* par = (float*)(ws + WS_PAR); const int gt = c.vcu * NTHREADS + c.tid, NGT = c.G * NTHREADS;
        if (gt == 0) { unsigned long long* pp = (unsigned long long*)(par + PAR_PTRS); pp[0] = (unsigned long long)a.moe_w_gate; pp[1] = (unsigned long long)a.moe_w_up; pp[2] = (unsigned long long)a.moe_w_down; }
        for (int i = gt; i < 384; i += NGT) par[PAR_RELB + i] = a.rel_bias[i];
        for (int i = gt; i < (NL / 2) * NQ; i += NGT) par[PAR_SINK + i] = a.ev_sink[i];
        for (int i = gt; i < NL * D; i += NGT) { par[PAR_GMIX + i] = a.norm_mix_g[i]; par[PAR_GFFN + i] = a.norm_ffn_g[i]; }
        for (int i = gt; i < D; i += NGT) par[PAR_GFIN + i] = a.final_g[i];
        for (int i = gt; i < (NL / 2) * 3 * CONVD; i += NGT) par[PAR_CONV + i] = a.od_conv_w[i];
        for (int i = gt; i < NL * D * NE; i += NGT) { const int l = i / (D * NE), r = i % (D * NE), e = r / D, d = r % D; par[PAR_ROUTER + i] = a.moe_w_router[(size_t)l * D * NE + d * NE + e]; }
    }
    for (int m = gw; m < S; m += 2 * NGW) { const int m1 = (m + NGW) < S ? m + NGW : m;
        const GAS f32x4* xa = (const GAS f32x4*)(a.x_in + (size_t)m * D) + c.lane; const GAS f32x4* xb = (const GAS f32x4*)(a.x_in + (size_t)m1 * D) + c.lane; f32x4 va[8], vb[8];
#pragma unroll
        for (int j = 0; j < 8; ++j) { va[j] = xa[64 * j]; vb[j] = xb[64 * j]; }
        norm_store_bf16(va, a.norm_mix_g, (bf16_t*)(ws + WS_H) + (size_t)m * D, c.lane);
        if (m1 != m) norm_store_bf16(vb, a.norm_mix_g, (bf16_t*)(ws + WS_H) + (size_t)m1 * D, c.lane); }
}

__device__ __forceinline__ void attn_unit(const Args& a, const Ctx& c, int layer_i, int blk, int kvh) {
    const bf16_t* QKF = (const bf16_t*)(a.ws + WS_Z); const bf16_t* VT = (const bf16_t*)(a.ws + WS_VT); bf16_t* MIX = (bf16_t*)(a.ws + WS_MIX);
    LAS unsigned char* band = c.lds;
    LAS float* bt = (LAS float*)(c.lds + 98304);
    const float* par = (const float*)(a.ws + WS_PAR);
    const int kb0 = 128 * (blk - 1);
    bf16x8 qfa[3][4];
    { const int fr_ = c.lane & 15, fq_ = c.lane >> 4; unsigned qoff = (unsigned)(((blk * 8 + c.wave) * 16 + fr_) * QKF_LD + kvh * 3 * HD + 8 * fq_) * 2u; asm volatile("" : "+v"(qoff));
#pragma unroll
      for (int hh = 0; hh < 3; ++hh)
#pragma unroll
          for (int ks = 0; ks < 4; ++ks) qfa[hh][ks] = *(const GAS bf16x8*)((const GAS char*)QKF + (size_t)qoff + hh * HD * 2 + 64 * ks); }
    __syncthreads();
    u32x4 kreg[12];
#pragma unroll
    for (int p = 0; p < 12; ++p) { const int id = c.tid + NTHREADS * p, row = id >> 4, ch = id & 15, key = kb0 + row; const int kc = key < 0 ? 0 : (key > S - 1 ? S - 1 : key);
        kreg[p] = *(const GAS u32x4*)(QKF + (size_t)kc * QKF_LD + QDIM + kvh * HD + ch * 8); }
    for (int i = c.tid; i < 3 * 257; i += NTHREADS) { const int hh = i / 257, r = i % 257; bt[hh * 260 + r] = par[PAR_RELB + t5_bucket(r - 128) * NQ + kvh * 3 + hh] * 1.4426950408889634f; }
#pragma unroll
    for (int p = 0; p < 12; ++p) { const int id = c.tid + NTHREADS * p, row = id >> 4, ch = id & 15, key = kb0 + row;
        if (key >= 0 && key < S) *(LAS u32x4*)(band + row * 256 + ((ch ^ (row & 15)) << 4)) = kreg[p]; }
    __syncthreads();
    const int fr = c.lane & 15, fq = c.lane >> 4, w = c.wave;
    const int q0 = (blk * 8 + w) * 16;
    unsigned pw[3][9][4]; float inv[3];
#pragma unroll
    for (int hh = 0; hh < 3; ++hh) {
        const int h = kvh * 3 + hh; const float snk = par[PAR_SINK + layer_i * NQ + h] * 1.4426950408889634f;
        bf16x8 qf[4];
#pragma unroll
        for (int ks = 0; ks < 4; ++ks) qf[ks] = qfa[hh][ks];
        f32x4 s[17];
#pragma unroll
        for (int kt = 0; kt < 17; ++kt) {
            const int key0 = q0 - WIN + 16 * kt;
            f32x4 acc = (f32x4){0.f, 0.f, 0.f, 0.f};
            if (key0 >= 0 && key0 < S) {
                const LAS unsigned char* kp = band + (16 * (w + kt) + fr) * 256;
#pragma unroll
                for (int ks = 0; ks < 4; ++ks) { const bf16x8 kf = *(const LAS bf16x8*)(kp + (((4 * ks + fq) ^ fr) << 4)); acc = __builtin_amdgcn_mfma_f32_16x16x32_bf16(kf, qf[ks], acc, 0, 0, 0); }
#pragma unroll
                for (int r = 0; r < 4; ++r) { const int rel = 16 * kt - WIN + 4 * fq + r - fr;
                    if (kt == 0 || kt == 16) { const bool ok = (rel >= -WIN) && (rel <= WIN); acc[r] = ok ? acc[r] * 0.12751743082459664f + bt[hh * 260 + (ok ? rel + WIN : 0)] : -1e30f; }
                    else acc[r] = acc[r] * 0.12751743082459664f + bt[hh * 260 + rel + WIN]; }
            } else { acc = (f32x4){-1e30f, -1e30f, -1e30f, -1e30f}; }
            s[kt] = acc;
        }
        float mx = -3.0e38f;
#pragma unroll
        for (int kt = 0; kt < 17; ++kt) mx = fmaxf(mx, fmaxf(fmaxf(s[kt][0], s[kt][1]), fmaxf(s[kt][2], s[kt][3])));
        mx = fmaxf(mx, shx(mx, 16, c.lane)); mx = fmaxf(mx, shx(mx, 32, c.lane)); mx = fmaxf(mx, snk);
        float sum = 0.f;
#pragma unroll
        for (int kt = 0; kt < 17; ++kt)
#pragma unroll
            for (int r = 0; r < 4; ++r) { const float pv = __builtin_amdgcn_exp2f(s[kt][r] - mx); s[kt][r] = pv; sum += pv; }
        sum += shx(sum, 16, c.lane); sum += shx(sum, 32, c.lane);
        inv[hh] = 1.0f / (sum + __builtin_amdgcn_exp2f(snk - mx));
        if (w & 1) {
#pragma unroll
            for (int kp = 0; kp < 9; ++kp) { pw[hh][kp][0] = (kp > 0) ? cvt_pk_bf16_v(s[kp > 0 ? 2 * kp - 1 : 0][0], s[kp > 0 ? 2 * kp - 1 : 0][1]) : 0u; pw[hh][kp][1] = (kp > 0) ? cvt_pk_bf16_v(s[kp > 0 ? 2 * kp - 1 : 0][2], s[kp > 0 ? 2 * kp - 1 : 0][3]) : 0u;
                pw[hh][kp][2] = cvt_pk_bf16_v(s[2 * kp][0], s[2 * kp][1]); pw[hh][kp][3] = cvt_pk_bf16_v(s[2 * kp][2], s[2 * kp][3]); }
        } else {
#pragma unroll
            for (int kp = 0; kp < 9; ++kp) { pw[hh][kp][0] = cvt_pk_bf16_v(s[2 * kp][0], s[2 * kp][1]); pw[hh][kp][1] = cvt_pk_bf16_v(s[2 * kp][2], s[2 * kp][3]);
                pw[hh][kp][2] = (kp < 8) ? cvt_pk_bf16_v(s[kp < 8 ? 2 * kp + 1 : 16][0], s[kp < 8 ? 2 * kp + 1 : 16][1]) : 0u; pw[hh][kp][3] = (kp < 8) ? cvt_pk_bf16_v(s[kp < 8 ? 2 * kp + 1 : 16][2], s[kp < 8 ? 2 * kp + 1 : 16][3]) : 0u; }
        }
        __builtin_amdgcn_sched_barrier(0);
    }
    __syncthreads();
#pragma unroll
    for (int p = 0; p < 12; ++p) { const int id = c.tid + NTHREADS * p, d = id / 48, pc = id % 48, b = pc >> 2, m = pc & 3, key = kb0 + 32 * b + 8 * m;
        u32x4 v = (u32x4){0u, 0u, 0u, 0u};
        if (key >= 0 && key < S) v = *(const GAS u32x4*)(VT + (size_t)(kvh * HD + d) * S + key);
        const int c0 = 4 * b + 2 * (m & 1), t = m >> 1; LAS unsigned char* rowp = band + d * 768;
        u32x2 lo; lo.x = v.x; lo.y = v.y; u32x2 hi; hi.x = v.z; hi.y = v.w;
        *(LAS u32x2*)(rowp + ((((c0 >> 4) << 4) + ((c0 & 15) ^ (d & 15))) << 4) + 8 * t) = lo;
        *(LAS u32x2*)(rowp + (((((c0 + 1) >> 4) << 4) + (((c0 + 1) & 15) ^ (d & 15))) << 4) + 8 * t) = hi; }
    __syncthreads();
#if MK_PV3
    {
        f32x4 o[3][8];
#pragma unroll
        for (int hh = 0; hh < 3; ++hh)
#pragma unroll
            for (int dt = 0; dt < 8; ++dt) o[hh][dt] = (f32x4){0.f, 0.f, 0.f, 0.f};
#pragma unroll
        for (int kp = 0; kp < 9; ++kp) {
            bf16x8 pf[3];
#pragma unroll
            for (int hh = 0; hh < 3; ++hh) { u32x4 pq; pq.x = pw[hh][kp][0]; pq.y = pw[hh][kp][1]; pq.z = pw[hh][kp][2]; pq.w = pw[hh][kp][3]; pf[hh] = __builtin_bit_cast(bf16x8, pq); }
            const int cc = 4 * ((w >> 1) + kp) + fq;
            const int poff = (((cc >> 4) << 4) + ((cc & 15) ^ fr)) << 4;
#pragma unroll
            for (int dt = 0; dt < 8; ++dt) { const bf16x8 vf = *(const LAS bf16x8*)(band + (16 * dt + fr) * 768 + poff);
#pragma unroll
                for (int hh = 0; hh < 3; ++hh) o[hh][dt] = __builtin_amdgcn_mfma_f32_16x16x32_bf16(vf, pf[hh], o[hh][dt], 0, 0, 0); }
        }
#pragma unroll
        for (int hh = 0; hh < 3; ++hh) { const int h = kvh * 3 + hh;
            unsigned ooff = (unsigned)((q0 + fr) * MIX_LD_EV + h * HD + 4 * fq) * 2u; asm volatile("" : "+v"(ooff));
            const float iv = inv[hh];
#pragma unroll
            for (int dt = 0; dt < 8; ++dt) { u32x2 wv; wv.x = cvt_pk_bf16(o[hh][dt][0] * iv, o[hh][dt][1] * iv); wv.y = cvt_pk_bf16(o[hh][dt][2] * iv, o[hh][dt][3] * iv); *(GAS u32x2*)((GAS char*)MIX + (size_t)ooff + 32 * dt) = wv; } }
    }
#else
#pragma unroll
    for (int hh = 0; hh < 3; ++hh) {
        const int h = kvh * 3 + hh;
        f32x4 o[8];
#pragma unroll
        for (int dt = 0; dt < 8; ++dt) o[dt] = (f32x4){0.f, 0.f, 0.f, 0.f};
#pragma unroll
        for (int kp = 0; kp < 9; ++kp) {
            u32x4 pq; pq.x = pw[hh][kp][0]; pq.y = pw[hh][kp][1]; pq.z = pw[hh][kp][2]; pq.w = pw[hh][kp][3];
            const bf16x8 pf = __builtin_bit_cast(bf16x8, pq);
            const int cc = 4 * ((w >> 1) + kp) + fq;
            const int poff = (((cc >> 4) << 4) + ((cc & 15) ^ fr)) << 4;
#pragma unroll
            for (int dt = 0; dt < 8; ++dt) { const bf16x8 vf = *(const LAS bf16x8*)(band + (16 * dt + fr) * 768 + poff);
                o[dt] = __builtin_amdgcn_mfma_f32_16x16x32_bf16(vf, pf, o[dt], 0, 0, 0); }
        }
        unsigned ooff = (unsigned)((q0 + fr) * MIX_LD_EV + h * HD + 4 * fq) * 2u; asm volatile("" : "+v"(ooff));
        const float iv = inv[hh];
#pragma unroll
        for (int dt = 0; dt < 8; ++dt) { u32x2 wv; wv.x = cvt_pk_bf16(o[dt][0] * iv, o[dt][1] * iv); wv.y = cvt_pk_bf16(o[dt][2] * iv, o[dt][3] * iv); *(GAS u32x2*)((GAS char*)MIX + (size_t)ooff + 32 * dt) = wv; }
    }
#endif
}

typedef short v4i16_t __attribute__((ext_vector_type(4)));
__device__ __forceinline__ s16x4 tr_read(const LAS unsigned char* p) { return __builtin_bit_cast(s16x4, __builtin_amdgcn_ds_read_tr16_b64_v4i16((LAS v4i16_t*)p)); }

constexpr int XS = 544;
__device__ __forceinline__ void ffta_unit(const Args& a, const Ctx& c, int g, int sb) {
    const bf16_t* F = (const bf16_t*)(a.ws + WS_Z) + QDIM + KVDIM + g * 128;
    bf16_t* TB = (bf16_t*)(a.ws + WS_TB);
    LAS unsigned char* X = c.lds;
    __syncthreads();
#pragma unroll
    for (int p = 0; p < 4; ++p) { const int id = c.tid + NTHREADS * p, s1 = id >> 5, ch = id & 31, ds2 = ch >> 4, c8 = (ch & 15) * 8;
        const u32x4 v = *(const GAS u32x4*)(F + (size_t)(128 * s1 + 2 * sb + ds2) * QKF_LD + c8);
        *(LAS u32x4*)(X + s1 * XS + (ds2 * 128 + c8) * 2) = v; }
    __syncthreads();
    const int fr = c.lane & 15, fq = c.lane >> 4, w = c.wave;
    bf16x8 af[2][2];
#pragma unroll
    for (int mt = 0; mt < 2; ++mt)
#pragma unroll
        for (int ks = 0; ks < 2; ++ks) {
            const LAS unsigned char* ap = X + (32 * ks + 4 * fq + (fr >> 2)) * XS + (32 * w + 16 * mt + 4 * (fr & 3)) * 2;
            const s16x4 t0 = tr_read(ap), t1 = tr_read(ap + 16 * XS);
            bf16x8 f; f[0] = t0[0]; f[1] = t0[1]; f[2] = t0[2]; f[3] = t0[3]; f[4] = t1[0]; f[5] = t1[1]; f[6] = t1[2]; f[7] = t1[3]; af[mt][ks] = f; }
    f32x4 acc[2][4][2];
#pragma unroll
    for (int jp = 0; jp < 4; ++jp) {
        bf16x8 bfr[2][2];
#pragma unroll
        for (int ks = 0; ks < 2; ++ks) { const GAS u32x4* ft = (const GAS u32x4*)(a.ws + WS_FTA) + ((jp * 2 + ks) * 2) * 64 + c.lane;
            bfr[0][ks] = __builtin_bit_cast(bf16x8, ft[0]); bfr[1][ks] = __builtin_bit_cast(bf16x8, ft[64]); }
#pragma unroll
        for (int mt = 0; mt < 2; ++mt) { f32x4 ar = (f32x4){0.f, 0.f, 0.f, 0.f}, ai = (f32x4){0.f, 0.f, 0.f, 0.f};
#pragma unroll
            for (int ks = 0; ks < 2; ++ks) { ar = __builtin_amdgcn_mfma_f32_16x16x32_bf16(af[mt][ks], bfr[0][ks], ar, 0, 0, 0); ai = __builtin_amdgcn_mfma_f32_16x16x32_bf16(af[mt][ks], bfr[1][ks], ai, 0, 0, 0); }
            acc[mt][jp][0] = ar; acc[mt][jp][1] = ai; }
        __builtin_amdgcn_sched_barrier(0);
    }
    const int s2 = 2 * sb + (w >> 2);
#pragma unroll
    for (int jp = 0; jp < 4; ++jp) { const int k1 = 16 * jp + fr; float sn, cs; sincospif((float)(s2 * k1) * (1.0f / 4096.0f), &sn, &cs);
#pragma unroll
        for (int mt = 0; mt < 2; ++mt) { const f32x4 re = acc[mt][jp][0], im = acc[mt][jp][1]; const int cc = 32 * (w & 3) + 16 * mt + 4 * fq;
            u32x2 tr, ti; tr.x = cvt_pk_bf16(re[0] * cs + im[0] * sn, re[1] * cs + im[1] * sn); tr.y = cvt_pk_bf16(re[2] * cs + im[2] * sn, re[3] * cs + im[3] * sn);
            ti.x = cvt_pk_bf16(im[0] * cs - re[0] * sn, im[1] * cs - re[1] * sn); ti.y = cvt_pk_bf16(im[2] * cs - re[2] * sn, im[3] * cs - re[3] * sn);
            bf16_t* tp = TB + ((size_t)((k1 * 4 + g) * 2) * 128 + s2) * 128 + cc;
            *(GAS u32x2*)tp = tr; *(GAS u32x2*)(tp + 128 * 128) = ti; } }
}

constexpr int TS = 288;
#if MK_FFTFUSE
__device__ __forceinline__ void fftc_unit(const Args& a, const Ctx& c, int k1, int g) {
    const bf16_t* T = (const bf16_t*)(a.ws + WS_TB) + (size_t)((k1 * 4 + g) * 2) * 128 * 128; bf16_t* MIX = (bf16_t*)(a.ws + WS_MIX);
    LAS unsigned char* X = c.lds;
    constexpr int CO_LO = 256 * 288, CO_HI = RING_BYTES + 1024 + 8192;
    __syncthreads();
    u32x4 bft[8][2];
    { const GAS u32x4* ft = (const GAS u32x4*)(a.ws + WS_FTC) + (size_t)(c.wave * 16) * 64 + c.lane;
#pragma unroll
      for (int q = 0; q < 16; ++q) bft[q >> 1][q & 1] = ft[q * 64]; }
#pragma unroll
    for (int p = 0; p < 8; ++p) { const int id = c.tid + NTHREADS * p, row = id >> 4, ch = id & 15; *(LAS u32x4*)(X + row * TS + ch * 16) = *(const GAS u32x4*)(T + (size_t)row * 128 + ch * 8); }
#pragma unroll
    for (int p = 0; p < 8; ++p) { const int f = (c.tid >> 6) + 8 * p; const u32x4 v = ((const GAS u32x4*)(a.ws + WS_FCO))[f * 64 + (c.tid & 63)];
        *(LAS u32x4*)(c.lds + (p < 7 ? CO_LO + f * 1024 : CO_HI + (f - 56) * 1024) + (c.tid & 63) * 16) = v; }
    __syncthreads();
    const int fr = c.lane & 15, fq = c.lane >> 4, w = c.wave;
    f32x4 acc[8][2];
#pragma unroll
    for (int mt = 0; mt < 8; ++mt) { acc[mt][0] = (f32x4){0.f, 0.f, 0.f, 0.f}; acc[mt][1] = (f32x4){0.f, 0.f, 0.f, 0.f}; }
#pragma unroll
    for (int ks = 0; ks < 8; ++ks) {
        bf16x8 bf[2]; bf[0] = __builtin_bit_cast(bf16x8, bft[ks][0]); bf[1] = __builtin_bit_cast(bf16x8, bft[ks][1]);
#pragma unroll
        for (int mt = 0; mt < 8; ++mt) {
            const LAS unsigned char* ap = X + (32 * ks + 4 * fq + (fr >> 2)) * TS + (16 * mt + 4 * (fr & 3)) * 2;
            const s16x4 t0 = tr_read(ap), t1 = tr_read(ap + 16 * TS);
            bf16x8 af; af[0] = t0[0]; af[1] = t0[1]; af[2] = t0[2]; af[3] = t0[3]; af[4] = t1[0]; af[5] = t1[1]; af[6] = t1[2]; af[7] = t1[3];
            acc[mt][0] = __builtin_amdgcn_mfma_f32_16x16x32_bf16(af, bf[0], acc[mt][0], 0, 0, 0);
            acc[mt][1] = __builtin_amdgcn_mfma_f32_16x16x32_bf16(af, bf[1], acc[mt][1], 0, 0, 0);
        }
        __builtin_amdgcn_sched_barrier(0);
    }
    bf16x8 pb[4][2];
#pragma unroll
    for (int kap = 0; kap < 4; ++kap)
#pragma unroll
        for (int pl = 0; pl < 2; ++pl) { u32x4 q; q.x = cvt_pk_bf16(acc[2 * kap][pl][0], acc[2 * kap][pl][1]); q.y = cvt_pk_bf16(acc[2 * kap][pl][2], acc[2 * kap][pl][3]);
            q.z = cvt_pk_bf16(acc[2 * kap + 1][pl][0], acc[2 * kap + 1][pl][1]); q.w = cvt_pk_bf16(acc[2 * kap + 1][pl][2], acc[2 * kap + 1][pl][3]); pb[kap][pl] = __builtin_bit_cast(bf16x8, q); }
    bf16_t* op = MIX + (size_t)(k1 + 64 * (16 * w + fr)) * MIX_LD_EV + QDIM + g * 128 + 4 * fq;
#pragma unroll
    for (int lt = 0; lt < 8; ++lt) { f32x4 o = (f32x4){0.f, 0.f, 0.f, 0.f};
#pragma unroll
        for (int kap = 0; kap < 4; ++kap)
#pragma unroll
            for (int pl = 0; pl < 2; ++pl) { const int f = (lt * 4 + kap) * 2 + pl; const bf16x8 cf = *(const LAS bf16x8*)(c.lds + (f < 56 ? CO_LO + f * 1024 : CO_HI + (f - 56) * 1024) + c.lane * 16);
                o = __builtin_amdgcn_mfma_f32_16x16x32_bf16(cf, pb[kap][pl], o, 0, 0, 0); }
        u32x2 ov; ov.x = cvt_pk_bf16(o[0], o[1]); ov.y = cvt_pk_bf16(o[2], o[3]); *(GAS u32x2*)(op + 16 * lt) = ov; }
}
#else
__device__ __forceinline__ void fftc_unit(const Args& a, const Ctx& c, int k1, int g) {
    const bf16_t* T = (const bf16_t*)(a.ws + WS_TB) + (size_t)((k1 * 4 + g) * 2) * 128 * 128; bf16_t* MIX = (bf16_t*)(a.ws + WS_MIX);
    LAS unsigned char* X = c.lds;
    __syncthreads();
    u32x4 bft[8][2];
    { const GAS u32x4* ft = (const GAS u32x4*)(a.ws + WS_FTC) + (size_t)(c.wave * 16) * 64 + c.lane;
#pragma unroll
      for (int q = 0; q < 16; ++q) bft[q >> 1][q & 1] = ft[q * 64]; }
#pragma unroll
    for (int p = 0; p < 8; ++p) { const int id = c.tid + NTHREADS * p, row = id >> 4, ch = id & 15; *(LAS u32x4*)(X + row * TS + ch * 16) = *(const GAS u32x4*)(T + (size_t)row * 128 + ch * 8); }
    __syncthreads();
    const int fr = c.lane & 15, fq = c.lane >> 4, w = c.wave, pq = w >> 2;
    f32x4 acc[8][2];
#pragma unroll
    for (int mt = 0; mt < 8; ++mt) { acc[mt][0] = (f32x4){0.f, 0.f, 0.f, 0.f}; acc[mt][1] = (f32x4){0.f, 0.f, 0.f, 0.f}; }
#pragma unroll
    for (int ks = 0; ks < 8; ++ks) {
        bf16x8 bf[2]; bf[0] = __builtin_bit_cast(bf16x8, bft[ks][0]); bf[1] = __builtin_bit_cast(bf16x8, bft[ks][1]);
#pragma unroll
        for (int mt = 0; mt < 8; ++mt) {
            const LAS unsigned char* ap = X + (32 * ks + 4 * fq + (fr >> 2)) * TS + (16 * mt + 4 * (fr & 3)) * 2;
            const s16x4 t0 = tr_read(ap), t1 = tr_read(ap + 16 * TS);
            bf16x8 af; af[0] = t0[0]; af[1] = t0[1]; af[2] = t0[2]; af[3] = t0[3]; af[4] = t1[0]; af[5] = t1[1]; af[6] = t1[2]; af[7] = t1[3];
            acc[mt][0] = __builtin_amdgcn_mfma_f32_16x16x32_bf16(af, bf[0], acc[mt][0], 0, 0, 0);
            acc[mt][1] = __builtin_amdgcn_mfma_f32_16x16x32_bf16(af, bf[1], acc[mt][1], 0, 0, 0);
        }
        __builtin_amdgcn_sched_barrier(0);
    }
#pragma unroll
    for (int t = 0; t < 2; ++t) { const int k2 = 32 * (w & 3) + 16 * t + fr; bf16_t* op = MIX + (size_t)(k1 + 64 * k2) * MIX_LD_EV + QDIM + g * 256 + pq * 128 + 4 * fq;
#pragma unroll
        for (int mt = 0; mt < 8; ++mt) { u32x2 o; o.x = cvt_pk_bf16(acc[mt][t][0], acc[mt][t][1]); o.y = cvt_pk_bf16(acc[mt][t][2], acc[mt][t][3]); *(GAS u32x2*)(op + 16 * mt) = o; } }
}
#endif

__device__ __forceinline__ void bf8_to_f32(const u32x4 w, float (&f)[8]) { f[0] = bf_lo(w.x); f[1] = bf_hi(w.x); f[2] = bf_lo(w.y); f[3] = bf_hi(w.y); f[4] = bf_lo(w.z); f[5] = bf_hi(w.z); f[6] = bf_lo(w.w); f[7] = bf_hi(w.w); }
__device__ __forceinline__ void oddmix_unit(const Args& a, const Ctx& c, int layer_i, int unit) {
    const bf16_t* Z = (const bf16_t*)(a.ws + WS_Z); bf16_t* MIX = (bf16_t*)(a.ws + WS_MIX); bf16_t* PO = (bf16_t*)(a.ws + WS_POOLED);
    if (c.wave < 4) {
        const int t0 = unit * 32 + (c.wave >> 1) * 16, ch = ((c.wave & 1) * 64 + c.lane) * 8;
        const float* cw = (const float*)(a.ws + WS_PAR) + PAR_CONV + layer_i * 3 * CONVD + ch;
        float w0[8], w1[8], w2[8];
#pragma unroll
        for (int q = 0; q < 8; ++q) { w0[q] = cw[q]; w1[q] = cw[CONVD + q]; w2[q] = cw[2 * CONVD + q]; }
        float pm[8], pc[8], pn[8], fa[8], fb[8];
#pragma unroll
        for (int q = 0; q < 8; ++q) pm[q] = 0.f;
        if (t0 > 0) { bf8_to_f32(*(const GAS u32x4*)(Z + (size_t)(t0 - 1) * OD_IN + CONVD + ch), fa); bf8_to_f32(*(const GAS u32x4*)(Z + (size_t)(t0 - 1) * OD_IN + 2 * CONVD + ch), fb);
#pragma unroll
            for (int q = 0; q < 8; ++q) pm[q] = fa[q] * fb[q]; }
        bf8_to_f32(*(const GAS u32x4*)(Z + (size_t)t0 * OD_IN + CONVD + ch), fa); bf8_to_f32(*(const GAS u32x4*)(Z + (size_t)t0 * OD_IN + 2 * CONVD + ch), fb);
#pragma unroll
        for (int q = 0; q < 8; ++q) pc[q] = fa[q] * fb[q];
#pragma unroll 4
        for (int t = t0; t < t0 + 16; ++t) {
#pragma unroll
            for (int q = 0; q < 8; ++q) pn[q] = 0.f;
            if (t + 1 < S) { bf8_to_f32(*(const GAS u32x4*)(Z + (size_t)(t + 1) * OD_IN + CONVD + ch), fa); bf8_to_f32(*(const GAS u32x4*)(Z + (size_t)(t + 1) * OD_IN + 2 * CONVD + ch), fb);
#pragma unroll
                for (int q = 0; q < 8; ++q) pn[q] = fa[q] * fb[q]; }
            bf8_to_f32(*(const GAS u32x4*)(Z + (size_t)t * OD_IN + ch), fa);
            float o[8];
#pragma unroll
            for (int q = 0; q < 8; ++q) { o[q] = fa[q] * (w0[q] * pm[q] + w1[q] * pc[q] + w2[q] * pn[q]); pm[q] = pc[q]; pc[q] = pn[q]; }
            u32x4 ov; ov.x = pk2(o[0], o[1]); ov.y = pk2(o[2], o[3]); ov.z = pk2(o[4], o[5]); ov.w = pk2(o[6], o[7]);
            *(GAS u32x4*)(MIX + (size_t)t * D + ch) = ov;
        }
    } else {
        const int g = c.wave - 4, lo = 1 << g, hi = lo - 1;
        const int t0 = unit * 32 + (c.lane >> 5) * 16, ch = g * 256 + (c.lane & 31) * 8;
        const bf16_t* zp = Z + 3 * CONVD + ch;
        float sm[8], fa[8];
#pragma unroll
        for (int q = 0; q < 8; ++q) sm[q] = 0.f;
        for (int tt = t0 - lo; tt <= t0 + hi; ++tt) if (tt >= 0 && tt < S) { bf8_to_f32(*(const GAS u32x4*)(zp + (size_t)tt * OD_IN), fa);
#pragma unroll
            for (int q = 0; q < 8; ++q) sm[q] += fa[q]; }
#pragma unroll 2
        for (int t = t0; t < t0 + 16; ++t) {
            const int aa = t - lo < 0 ? 0 : t - lo, bb = t + hi > S - 1 ? S - 1 : t + hi; const float rc = 1.0f / (float)(bb - aa + 1);
            bf8_to_f32(*(const GAS u32x4*)(zp + (size_t)t * OD_IN), fa);
            u32x4 ov; ov.x = pk2(sm[0] * rc - fa[0], sm[1] * rc - fa[1]); ov.y = pk2(sm[2] * rc - fa[2], sm[3] * rc - fa[3]); ov.z = pk2(sm[4] * rc - fa[4], sm[5] * rc - fa[5]); ov.w = pk2(sm[6] * rc - fa[6], sm[7] * rc - fa[7]);
            { const int tok = t - unit * 32; *(LAS u32x4*)(c.lds + tok * 2048 + ((((ch >> 3) & ~15) | (((ch >> 3) & 15) ^ (tok & 15))) << 4)) = ov; }
            if (t + 1 + hi < S) { bf8_to_f32(*(const GAS u32x4*)(zp + (size_t)(t + 1 + hi) * OD_IN), fa);
#pragma unroll
                for (int q = 0; q < 8; ++q) sm[q] += fa[q]; }
            if (t - lo >= 0) { bf8_to_f32(*(const GAS u32x4*)(zp + (size_t)(t - lo) * OD_IN), fa);
#pragma unroll
                for (int q = 0; q < 8; ++q) sm[q] -= fa[q]; }
        }
    }
    __syncthreads();
    {
        const int fr = c.lane & 15, fq = c.lane >> 4, g = c.wave >> 1, mt0 = 8 * (c.wave & 1);
        const bf16_t* Wp = (const bf16_t*)(a.ws + WS_POOLW + layer_i * SZ_POOL) + (size_t)g * 65536;
        bf16x8 bfr[2][8];
#pragma unroll
        for (int nt = 0; nt < 2; ++nt)
#pragma unroll
            for (int ks = 0; ks < 8; ++ks) { const int tok = 16 * nt + fr, c16 = g * 32 + 4 * ks + fq; bfr[nt][ks] = *(const LAS bf16x8*)(c.lds + tok * 2048 + (((c16 & ~15) | ((c16 & 15) ^ fr)) << 4)); }
        unsigned woff = (unsigned)((16 * mt0 + fr) * 256 + 8 * fq) * 2u; asm volatile("" : "+v"(woff));
        bf16x8 af[8], an[8];
#pragma unroll
        for (int ks = 0; ks < 8; ++ks) af[ks] = *(const GAS bf16x8*)((const GAS char*)Wp + (size_t)woff + 64 * ks);
#pragma unroll 1
        for (int mi = 0; mi < 8; ++mi) {
            if (mi + 1 < 8) {
#pragma unroll
                for (int ks = 0; ks < 8; ++ks) an[ks] = *(const GAS bf16x8*)((const GAS char*)Wp + (size_t)woff + (size_t)(mi + 1) * (16 * 256 * 2) + 64 * ks); }
            f32x4 acc0 = (f32x4){0.f, 0.f, 0.f, 0.f}, acc1 = (f32x4){0.f, 0.f, 0.f, 0.f};
#pragma unroll
            for (int ks = 0; ks < 8; ++ks) { acc0 = __builtin_amdgcn_mfma_f32_16x16x32_bf16(af[ks], bfr[0][ks], acc0, 0, 0, 0); acc1 = __builtin_amdgcn_mfma_f32_16x16x32_bf16(af[ks], bfr[1][ks], acc1, 0, 0, 0); }
            const int dcol = CONVD + g * 256 + 16 * (mt0 + mi) + 4 * fq;
            u32x2 o0; o0.x = cvt_pk_bf16(acc0[0], acc0[1]); o0.y = cvt_pk_bf16(acc0[2], acc0[3]); *(GAS u32x2*)(MIX + (size_t)(unit * 32 + fr) * D + dcol) = o0;
            u32x2 o1; o1.x = cvt_pk_bf16(acc1[0], acc1[1]); o1.y = cvt_pk_bf16(acc1[2], acc1[3]); *(GAS u32x2*)(MIX + (size_t)(unit * 32 + 16 + fr) * D + dcol) = o1;
#pragma unroll
            for (int ks = 0; ks < 8; ++ks) af[ks] = an[ks];
        }
    }
    __syncthreads();
}

template <int G>
__device__ __forceinline__ void oddmix_pool(const bf16_t* zp, int t0, int ltok, int cl, LAS unsigned char* lds) {
    constexpr int LO = 1 << G, HI = LO - 1, W = 2 * LO, NR = 8 + W - 1;
    u32x4 rw[NR];
    const bf16_t* zb = zp + (size_t)t0 * OD_IN;
#pragma unroll
    for (int r = 0; r < NR; ++r) { const int tt = t0 - LO + r; const int d = (tt >= 0 && tt < S) ? (r - LO) * OD_IN : 0; rw[r] = *(const GAS u32x4*)(zb + d); }
    float sm[8], fa[8];
#pragma unroll
    for (int q = 0; q < 8; ++q) sm[q] = 0.f;
#pragma unroll
    for (int r = 0; r < W; ++r) { const int tt = t0 - LO + r; if (tt >= 0 && tt < S) { bf8_to_f32(rw[r], fa);
#pragma unroll
        for (int q = 0; q < 8; ++q) sm[q] += fa[q]; } }
#pragma unroll
    for (int i = 0; i < 8; ++i) { const int t = t0 + i;
        const int aa = t - LO < 0 ? 0 : t - LO, bb = t + HI > S - 1 ? S - 1 : t + HI; const float rc = 1.0f / (float)(bb - aa + 1);
        bf8_to_f32(rw[i + LO], fa);
        u32x4 ov; ov.x = pk2(sm[0] * rc - fa[0], sm[1] * rc - fa[1]); ov.y = pk2(sm[2] * rc - fa[2], sm[3] * rc - fa[3]); ov.z = pk2(sm[4] * rc - fa[4], sm[5] * rc - fa[5]); ov.w = pk2(sm[6] * rc - fa[6], sm[7] * rc - fa[7]);
        { const int tok = ltok + i; *(LAS u32x4*)(lds + tok * 512 + (((cl & ~15) | ((cl & 15) ^ (tok & 15))) << 4)) = ov; }
        if (i < 7) {
            if (t + 1 + HI < S) { bf8_to_f32(rw[i + W], fa);
#pragma unroll
                for (int q = 0; q < 8; ++q) sm[q] += fa[q]; }
            if (t - LO >= 0) { bf8_to_f32(rw[i], fa);
#pragma unroll
                for (int q = 0; q < 8; ++q) sm[q] -= fa[q]; } }
    }
}
__device__ __forceinline__ void oddmix_unit2(const Args& a, const Ctx& c, int layer_i, int unit) {
    const bf16_t* Z = (const bf16_t*)(a.ws + WS_Z); bf16_t* MIX = (bf16_t*)(a.ws + WS_MIX);
    const int tb = unit >> 2, g = unit & 3;
    const int tg = c.tid >> 5, cl = c.tid & 31;
    const int t0 = tb * 128 + tg * 8, ch = g * 256 + cl * 8;
    {
        u32x4 ra[10], rb[10], rg[8];
        const bf16_t* zb = Z + (size_t)t0 * OD_IN + ch;
#pragma unroll
        for (int r = 0; r < 10; ++r) { const int tt = t0 - 1 + r; const int d = (tt >= 0 && tt < S) ? (r - 1) * OD_IN : 0;
            ra[r] = *(const GAS u32x4*)(zb + d + CONVD); rb[r] = *(const GAS u32x4*)(zb + d + 2 * CONVD); }
#pragma unroll
        for (int r = 0; r < 8; ++r) rg[r] = *(const GAS u32x4*)(zb + r * OD_IN);
        const float* cw = (const float*)(a.ws + WS_PAR) + PAR_CONV + layer_i * 3 * CONVD + ch;
        float w0[8], w1[8], w2[8];
#pragma unroll
        for (int q = 0; q < 8; ++q) { w0[q] = cw[q]; w1[q] = cw[CONVD + q]; w2[q] = cw[2 * CONVD + q]; }
        float pm[8], pc[8], pn[8], fa[8], fb[8];
        { bf8_to_f32(ra[0], fa); bf8_to_f32(rb[0], fb); const float v = (t0 - 1 >= 0) ? 1.f : 0.f;
#pragma unroll
          for (int q = 0; q < 8; ++q) pm[q] = fa[q] * fb[q] * v; }
        { bf8_to_f32(ra[1], fa); bf8_to_f32(rb[1], fb);
#pragma unroll
          for (int q = 0; q < 8; ++q) pc[q] = fa[q] * fb[q]; }
#pragma unroll
        for (int i = 0; i < 8; ++i) { const int t = t0 + i;
            bf8_to_f32(ra[i + 2], fa); bf8_to_f32(rb[i + 2], fb); const float v = (t + 1 < S) ? 1.f : 0.f;
#pragma unroll
            for (int q = 0; q < 8; ++q) pn[q] = fa[q] * fb[q] * v;
            bf8_to_f32(rg[i], fa);
            float o[8];
#pragma unroll
            for (int q = 0; q < 8; ++q) { o[q] = fa[q] * (w0[q] * pm[q] + w1[q] * pc[q] + w2[q] * pn[q]); pm[q] = pc[q]; pc[q] = pn[q]; }
            u32x4 ov; ov.x = pk2(o[0], o[1]); ov.y = pk2(o[2], o[3]); ov.z = pk2(o[4], o[5]); ov.w = pk2(o[6], o[7]);
            *(GAS u32x4*)(MIX + (size_t)t * D + ch) = ov; }
    }
    const int fr = c.lane & 15, fq = c.lane >> 4;
    const bf16_t* Wp = (const bf16_t*)(a.ws + WS_POOLW + layer_i * SZ_POOL) + (size_t)g * 65536 + (size_t)(32 * c.wave + fr) * 256 + 8 * fq;
    bf16x8 wf[2][8];
#pragma unroll
    for (int mt = 0; mt < 2; ++mt)
#pragma unroll
        for (int ks = 0; ks < 8; ++ks) wf[mt][ks] = *(const GAS bf16x8*)(Wp + mt * 16 * 256 + 32 * ks);
    { int t0p = t0; asm volatile("" : "+v"(t0p)); const bf16_t* zp = Z + 3 * CONVD + ch;
      if (g == 0) oddmix_pool<0>(zp, t0p, tg * 8, cl, c.lds); else if (g == 1) oddmix_pool<1>(zp, t0p, tg * 8, cl, c.lds); else if (g == 2) oddmix_pool<2>(zp, t0p, tg * 8, cl, c.lds); else oddmix_pool<3>(zp, t0p, tg * 8, cl, c.lds); }
    __syncthreads();
#pragma unroll
    for (int nt = 0; nt < 8; ++nt) {
        bf16x8 bfr[8];
#pragma unroll
        for (int ks = 0; ks < 8; ++ks) { const int tok = 16 * nt + fr, c16 = 4 * ks + fq; bfr[ks] = *(const LAS bf16x8*)(c.lds + tok * 512 + (((c16 & ~15) | ((c16 & 15) ^ fr)) << 4)); }
        f32x4 acc0 = (f32x4){0.f, 0.f, 0.f, 0.f}, acc1 = (f32x4){0.f, 0.f, 0.f, 0.f};
#pragma unroll
        for (int ks = 0; ks < 8; ++ks) { acc0 = __builtin_amdgcn_mfma_f32_16x16x32_bf16(wf[0][ks], bfr[ks], acc0, 0, 0, 0); acc1 = __builtin_amdgcn_mfma_f32_16x16x32_bf16(wf[1][ks], bfr[ks], acc1, 0, 0, 0); }
        bf16_t* op = MIX + (size_t)(tb * 128 + 16 * nt + fr) * D + CONVD + g * 256 + 32 * c.wave + 4 * fq;
        u32x2 o0; o0.x = cvt_pk_bf16(acc0[0], acc0[1]); o0.y = cvt_pk_bf16(acc0[2], acc0[3]); *(GAS u32x2*)op = o0;
        u32x2 o1; o1.x = cvt_pk_bf16(acc1[0], acc1[1]); o1.y = cvt_pk_bf16(acc1[2], acc1[3]); *(GAS u32x2*)(op + 16) = o1;
    }
    __syncthreads();
}

__device__ __forceinline__ void norm_router_stage(const Args& a, const Ctx& c, int layer) {
    LAS float* wT = (LAS float*)c.lds; const float* par = (const float*)(a.ws + WS_PAR); const float* wr = par + PAR_ROUTER + (size_t)layer * D * NE;
    __syncthreads();
    for (int i = c.tid; i < D * NE / 4; i += NTHREADS) ((LAS f32x4*)wT)[i] = ((const GAS f32x4*)wr)[i];
    LAS f32x4* gl = (LAS f32x4*)(c.lds + RING_BYTES + 1024);
    c.tid < D / 4 ? (void)(gl[c.tid] = ((const GAS f32x4*)(par + PAR_GFFN + (size_t)layer * D))[c.tid]) : (void)0;
    __syncthreads();
}
__device__ __forceinline__ void norm_router_phase(const Args& a, const Ctx& c, int layer, bool staged = false) {
    LAS float* wT = (LAS float*)c.lds;
    const float* par = (const float*)(a.ws + WS_PAR); const float* wr = par + PAR_ROUTER + (size_t)layer * D * NE;
    int gw = c.vcu * NWAVES + c.wave; asm volatile("" : "+s"(gw));
    const int NGW = c.G * NWAVES, lane = c.lane;
    float* AFF = (float*)(a.ws + WS_AFF); bf16_t* H = (bf16_t*)(a.ws + WS_H);
    f32x4 n0[8], n1[8];
    { const int mb = (gw + NGW) < S ? gw + NGW : gw;
#pragma unroll
        for (int j = 0; j < 8; ++j) { n0[j] = ((const GAS f32x4*)(a.X + (size_t)gw * D))[lane + 64 * j]; n1[j] = ((const GAS f32x4*)(a.X + (size_t)mb * D))[lane + 64 * j]; } }
    LAS f32x4* gl = (LAS f32x4*)(c.lds + RING_BYTES + 1024);
    if (!staged) {
    __syncthreads();
    for (int i = c.tid; i < D * NE / 4; i += NTHREADS) ((LAS f32x4*)wT)[i] = ((const GAS f32x4*)wr)[i];
    c.tid < D / 4 ? (void)(gl[c.tid] = ((const GAS f32x4*)(par + PAR_GFFN + (size_t)layer * D))[c.tid]) : (void)0;
    }
    __syncthreads();
    for (int m = gw; m < S; m += 2 * NGW) {
        const bool two = (m + NGW) < S; const int m1 = two ? m + NGW : m;
        f32x4 v0[8], v1[8]; float ss0 = 0.f, ss1 = 0.f;
#pragma unroll
        for (int j = 0; j < 8; ++j) { v0[j] = n0[j]; v1[j] = n1[j]; }
        if (m + 2 * NGW < S) { const int ma = m + 2 * NGW, mb = (ma + NGW) < S ? ma + NGW : ma;
#pragma unroll
            for (int j = 0; j < 8; ++j) { n0[j] = ((const GAS f32x4*)(a.X + (size_t)ma * D))[lane + 64 * j]; n1[j] = ((const GAS f32x4*)(a.X + (size_t)mb * D))[lane + 64 * j]; } }
#pragma unroll
        for (int j = 0; j < 8; ++j) { ss0 += (v0[j].x * v0[j].x + v0[j].y * v0[j].y) + (v0[j].z * v0[j].z + v0[j].w * v0[j].w); ss1 += (v1[j].x * v1[j].x + v1[j].y * v1[j].y) + (v1[j].z * v1[j].z + v1[j].w * v1[j].w); }
#pragma unroll
        for (int o = 1; o < 64; o <<= 1) { ss0 += shx(ss0, o, lane); ss1 += shx(ss1, o, lane); }
        const float r0 = rsqrtf(ss0 * (1.0f / D) + EPS), r1 = rsqrtf(ss1 * (1.0f / D) + EPS);
        GAS u32x2* o0 = (GAS u32x2*)(H + (size_t)m * D) + lane; GAS u32x2* o1 = (GAS u32x2*)(H + (size_t)m1 * D) + lane;
#pragma unroll
        for (int j = 0; j < 8; ++j) { const f32x4 w = gl[lane + 64 * j]; v0[j] = v0[j] * r0 * w; v1[j] = v1[j] * r1 * w;
            u32x2 p0; p0.x = cvt_pk_bf16(v0[j].x, v0[j].y); p0.y = cvt_pk_bf16(v0[j].z, v0[j].w); o0[64 * j] = p0;
            u32x2 p1; p1.x = cvt_pk_bf16(v1[j].x, v1[j].y); p1.y = cvt_pk_bf16(v1[j].z, v1[j].w); if (two) o1[64 * j] = p1; }
        float lg0[NE], lg1[NE];
#pragma unroll
        for (int e = 0; e < NE; ++e) { f32x2 a0 = (f32x2){0.f, 0.f}, a1 = (f32x2){0.f, 0.f};
#pragma unroll
            for (int j = 0; j < 8; ++j) { const f32x4 w = *(const LAS f32x4*)(wT + e * D + 4 * lane + 256 * j); const f32x2 wl = (f32x2){w.x, w.y}, wh = (f32x2){w.z, w.w};
                a0 = __builtin_elementwise_fma((f32x2){v0[j].x, v0[j].y}, wl, a0); a0 = __builtin_elementwise_fma((f32x2){v0[j].z, v0[j].w}, wh, a0);
                a1 = __builtin_elementwise_fma((f32x2){v1[j].x, v1[j].y}, wl, a1); a1 = __builtin_elementwise_fma((f32x2){v1[j].z, v1[j].w}, wh, a1); }
            lg0[e] = a0.x + a0.y; lg1[e] = a1.x + a1.y; if (e & 1) __builtin_amdgcn_sched_barrier(0); }
#pragma unroll
        for (int st = 0; st < 4; ++st) { const int o = 32 >> st, n = 8 >> st; const bool up = (lane & o) != 0;
#pragma unroll
            for (int i = 0; i < 8; ++i) if (i < n) { const float s0 = up ? lg0[i] : lg0[i + n], k0 = up ? lg0[i + n] : lg0[i]; const float s1 = up ? lg1[i] : lg1[i + n], k1 = up ? lg1[i + n] : lg1[i];
                lg0[i] = k0 + shx(s0, o, lane); lg1[i] = k1 + shx(s1, o, lane); } }
        float l0 = lg0[0], l1 = lg1[0]; l0 += shx(l0, 2, lane); l1 += shx(l1, 2, lane); l0 += shx(l0, 1, lane); l1 += shx(l1, 1, lane);
        float mx0 = l0, mx1 = l1;
#pragma unroll
        for (int o = 4; o < 64; o <<= 1) { mx0 = fmaxf(mx0, shx(mx0, o, lane)); mx1 = fmaxf(mx1, shx(mx1, o, lane)); }
        const float e0 = expf(l0 - mx0), e1 = expf(l1 - mx1); float sm0 = e0, sm1 = e1;
#pragma unroll
        for (int o = 4; o < 64; o <<= 1) { sm0 += shx(sm0, o, lane); sm1 += shx(sm1, o, lane); }
        const int e = ((lane >> 5) & 1) * 8 + ((lane >> 4) & 1) * 4 + ((lane >> 3) & 1) * 2 + ((lane >> 2) & 1);
        if ((lane & 3) == 0) { AFF[(size_t)e * S + m] = e0 / sm0; if (two) AFF[(size_t)e * S + m1] = e1 / sm1; }
    }
    __syncthreads();
}

__device__ __forceinline__ void select_phase(const Args& a, const Ctx& c, int e) {
    const float* AFF = (const float*)(a.ws + WS_AFF) + (size_t)e * S; int* INV = (int*)(a.ws + WS_INV) + (size_t)e * S; int* IDX = (int*)(a.ws + WS_IDX); float* GATE = (float*)(a.ws + WS_GATE);
    LAS int* red = (LAS int*)c.lds;
    unsigned v[16];
#pragma unroll
    for (int q = 0; q < 4; ++q) { const u32x4 t4 = *(const GAS u32x4*)(AFF + c.tid * 16 + 4 * q); v[4 * q] = t4.x; v[4 * q + 1] = t4.y; v[4 * q + 2] = t4.z; v[4 * q + 3] = t4.w; }
    __syncthreads();
    unsigned prefix = 0; int it = 0;
    for (int sh = 30; sh >= 0; sh -= 2, ++it) {
        const int nb = (sh == 30) ? 1 : 2; const int shift = (sh == 30) ? 30 : sh - 1;
        int cnt[3];
#pragma unroll
        for (int j = 1; j <= 3; ++j) { const unsigned cand = prefix | ((unsigned)j << shift); int cj = 0;
#pragma unroll
            for (int i = 0; i < 16; ++i) cj += (v[i] >= cand) ? 1 : 0;
            cnt[j - 1] = wave_sum_dpp(cj); }
        LAS int* rb = red + (it & 1) * 32;
        if (c.lane == 0) { rb[c.wave * 4 + 0] = cnt[0]; rb[c.wave * 4 + 1] = cnt[1]; rb[c.wave * 4 + 2] = cnt[2]; }
        __syncthreads();
        int t1 = 0, t2 = 0, t3 = 0;
#pragma unroll
        for (int w = 0; w < NWAVES; ++w) { t1 += rb[w * 4 + 0]; t2 += rb[w * 4 + 1]; t3 += rb[w * 4 + 2]; }
        int jsel = 0;
        if (nb == 1) { jsel = (t1 >= CAP) ? 1 : 0; } else { jsel = (t3 >= CAP) ? 3 : ((t2 >= CAP) ? 2 : ((t1 >= CAP) ? 1 : 0)); }
        prefix |= (unsigned)jsel << shift;
        if (sh == 30) sh = 31;
    }
    const unsigned T = prefix;
    int cg = 0, ce = 0;
#pragma unroll
    for (int i = 0; i < 16; ++i) { cg += (v[i] > T) ? 1 : 0; ce += (v[i] == T) ? 1 : 0; }
    int pg = cg, pe = ce;
#pragma unroll
    for (int o = 1; o < 64; o <<= 1) { const int src = (c.lane >= o ? c.lane - o : c.lane) << 2; const int tg = __builtin_amdgcn_ds_bpermute(src, pg), te = __builtin_amdgcn_ds_bpermute(src, pe); if (c.lane >= o) { pg += tg; pe += te; } }
    __syncthreads();
    if (c.lane == 63) { red[64 + c.wave] = pg; red[80 + c.wave] = pe; }
    __syncthreads();
    int bg = 0, be = 0, ng = 0;
#pragma unroll
    for (int w = 0; w < NWAVES; ++w) { const int xg = red[64 + w], xe = red[80 + w]; if (w < c.wave) { bg += xg; be += xe; } ng += xg; }
    pg = pg - cg + bg; pe = pe - ce + be;
    const int need = CAP - ng;
    int slots[16];
#pragma unroll
    for (int i = 0; i < 16; ++i) {
        const int t = c.tid * 16 + i; int slot = -1;
        if (v[i] > T) { slot = pg++; } else if (v[i] == T) { if (pe < need) slot = ng + pe; pe++; }
        slots[i] = slot;
        if (slot >= 0) { IDX[e * CAP + slot] = t; GATE[e * CAP + slot] = __builtin_bit_cast(float, v[i]); }
    }
#pragma unroll
    for (int q = 0; q < 4; ++q) { u32x4 o; o.x = (unsigned)slots[4 * q]; o.y = (unsigned)slots[4 * q + 1]; o.z = (unsigned)slots[4 * q + 2]; o.w = (unsigned)slots[4 * q + 3]; *(GAS u32x4*)(INV + c.tid * 16 + 4 * q) = o; }
}

__device__ __forceinline__ void combine_stage(const Args& a, const Ctx& c, int layer) {
    LAS f32x4* gl = (LAS f32x4*)c.lds; const bool lastl = (layer == NL - 1);
    __syncthreads();
    if (c.tid < D / 4) gl[c.tid] = ((const GAS f32x4*)((const float*)(a.ws + WS_PAR) + (lastl ? PAR_GFIN : PAR_GMIX + (layer + 1) * D)))[c.tid];
    __syncthreads();
}
__device__ __forceinline__ void combine_phase(const Args& a, const Ctx& c, int layer, bool staged = false) {
    int gw = c.vcu * NWAVES + c.wave; asm volatile("" : "+s"(gw));
    const int NGW = c.G * NWAVES, lane = c.lane;
    const bf16_t* Y = (const bf16_t*)(a.ws + WS_Y); const int* INV = (const int*)(a.ws + WS_INV); bf16_t* H = (bf16_t*)(a.ws + WS_H);
    const bool lastl = (layer == NL - 1);
    LAS f32x4* gl = (LAS f32x4*)c.lds;
    f32x4 nv[8]; int ninv = -1;
    { ninv = INV[(size_t)(lane & 15) * S + gw];
#pragma unroll
        for (int j = 0; j < 8; ++j) nv[j] = ((const GAS f32x4*)(a.X + (size_t)gw * D))[lane + 64 * j]; }
    if (!staged) {
    __syncthreads();
    if (c.tid < D / 4) gl[c.tid] = ((const GAS f32x4*)((const float*)(a.ws + WS_PAR) + (lastl ? PAR_GFIN : PAR_GMIX + (layer + 1) * D)))[c.tid];
    __syncthreads();
    }
    for (int m = gw; m < S; m += NGW) {
        GAS f32x4* xr = (GAS f32x4*)(a.X + (size_t)m * D) + lane; f32x4 v[8];
#pragma unroll
        for (int j = 0; j < 8; ++j) v[j] = nv[j];
        const int myinv = ninv;
        if (m + NGW < S) { ninv = INV[(size_t)(lane & 15) * S + m + NGW];
#pragma unroll
            for (int j = 0; j < 8; ++j) nv[j] = ((const GAS f32x4*)(a.X + (size_t)(m + NGW) * D))[lane + 64 * j]; }
        unsigned mask = (unsigned)(__builtin_amdgcn_ballot_w64(myinv >= 0) & 0xFFFFull);
        while (mask) {
            const int e1 = __builtin_ctz(mask); mask &= mask - 1u; const bool two = mask != 0u; const int e2 = two ? __builtin_ctz(mask) : e1; if (two) mask &= mask - 1u;
            const int s1 = __builtin_amdgcn_readlane(myinv, e1), s2 = __builtin_amdgcn_readlane(myinv, e2);
            const GAS u32x2* y1 = (const GAS u32x2*)(Y + ((size_t)e1 * CAP + s1) * D) + lane; const GAS u32x2* y2 = (const GAS u32x2*)(Y + ((size_t)e2 * CAP + s2) * D) + lane;
            u32x2 a1[8], a2[8];
#pragma unroll
            for (int j = 0; j < 8; ++j) { a1[j] = y1[64 * j]; a2[j] = y2[64 * j]; }
#pragma unroll
            for (int j = 0; j < 8; ++j) { v[j].x += bf_lo(a1[j].x); v[j].y += bf_hi(a1[j].x); v[j].z += bf_lo(a1[j].y); v[j].w += bf_hi(a1[j].y); }
            if (two) {
#pragma unroll
                for (int j = 0; j < 8; ++j) { v[j].x += bf_lo(a2[j].x); v[j].y += bf_hi(a2[j].x); v[j].z += bf_lo(a2[j].y); v[j].w += bf_hi(a2[j].y); } }
        }
        float ss = 0.f;
#pragma unroll
        for (int j = 0; j < 8; ++j) ss += (v[j].x * v[j].x + v[j].y * v[j].y) + (v[j].z * v[j].z + v[j].w * v[j].w);
        const float r = rsqrtf(wave_sum(ss, lane) * (1.0f / D) + EPS);
        if (!lastl) {
            GAS u32x2* o8 = (GAS u32x2*)(H + (size_t)m * D) + lane;
#pragma unroll
            for (int j = 0; j < 8; ++j) { xr[64 * j] = v[j]; const f32x4 w = gl[lane + 64 * j]; u32x2 o; o.x = cvt_pk_bf16(v[j].x * r * w.x, v[j].y * r * w.y); o.y = cvt_pk_bf16(v[j].z * r * w.z, v[j].w * r * w.w); o8[64 * j] = o; }
        } else {
#pragma unroll
            for (int j = 0; j < 8; ++j) { const f32x4 w = gl[lane + 64 * j]; f32x4 o; o.x = v[j].x * r * w.x; o.y = v[j].y * r * w.y; o.z = v[j].z * r * w.z; o.w = v[j].w * r * w.w; xr[64 * j] = o; }
        }
    }
    __syncthreads();
}
constexpr int NPH = 1 + 9 * NL;
__global__ void __launch_bounds__(NTHREADS, 2) mk_fwd(Args a) {
    extern __shared__ __attribute__((aligned(16))) unsigned char lds_raw[];
    Ctx c; c.lds = (LAS unsigned char*)lds_raw;
    c.wave = __builtin_amdgcn_readfirstlane((int)threadIdx.x >> 6);
    c.lane = lane_id(); c.tid = c.wave * 64 + c.lane;
    c.G = gridDim.x; { const int bx = blockIdx.x; c.vcu = (c.G % 8 == 0) ? (bx % 8) * (c.G / 8) + bx / 8 : bx; }
    volatile LAS unsigned* MISC = (volatile LAS unsigned*)(c.lds + MISC_OFF);
    for (int u = c.tid; u < (LDS_BYTES - LDSCTL_OFF) / 4; u += NTHREADS) ((LAS unsigned*)(c.lds + LDSCTL_OFF))[u] = 0u;
    const bool leader0 = false; (void)leader0;
    __syncthreads();
    const int lo = a.ph_lo, hi = a.ph_hi;
    unsigned* ctl = (unsigned*)(a.ws + WS_CTL);
    XcdBarrier bar; bar.bar = ctl + CW_BAR; bar.x = 0; bar.st = nullptr;
    if (hi - lo > 1) bar = xcd_barrier_post(ctl + CW_BAR, MISC + 8, c.tid == 0);
    unsigned char* ws = a.ws;
#define IN(k) (lo <= (k) && (k) < hi)
#ifndef MK_PHMASK
#define MK_PHMASK 0x3ff
#endif
#define EN(b) ((MK_PHMASK >> (b)) & 1)
#ifndef MK_REPMASK
#define MK_REPMASK 0
#endif
#ifndef MK_NRSTAGE
#define MK_NRSTAGE 1
#endif
#define REPS_ON(b) (((MK_REPMASK >> (b)) & 1) != 0)
#ifndef MK_REPN
#define MK_REPN 3
#endif
#define REPS(b) (((MK_REPMASK >> (b)) & 1) ? MK_REPN : 1)
#define SEAM(k) do { if (IN((k) + 1)) { const int _ln = lane_id(); xcd_barrier(bar, c.wave == 0 && _ln == 0); } } while (0)
#ifndef MK_SELCVT
#define MK_SELCVT 2400
#endif
#define par0b_() ({ int _b = (int)blockIdx.x; asm volatile("" : "+s"(_b)); _b; })
#define FRESH(cc) Ctx cc = c; cc.lane = lane_id(); cc.tid = cc.wave * 64 + cc.lane

    if (EN(0) && IN(0)) {
        { FRESH(cc); p0_prologue(a, cc); }
        SEAM(0); }

    for (int l = 0; l < NL; ++l) {
        const int pb = 1 + 9 * l, li = l >> 1; const bool odd = (l & 1) != 0;
        if (EN(1) && IN(pb + 0)) {
            pg8::Sched Sc{}; Sc.G = c.G; Sc.c = (int)blockIdx.x; Sc.A = (long)WS_H; Sc.tA = 256 * D * 2; Sc.sA = 0; Sc.sB = 0; Sc.tB = 256 * D * 2; Sc.nM = S / 256; Sc.nG = 1; Sc.gidx = nullptr;
            pg8::EpiBf16 E{}; E.O = (bf16_t*)(ws + WS_Z); E.gcol = 0; E.O2 = (bf16_t*)(ws + WS_VT); E.ldc2 = S;
            if (!odd) { Sc.B = (long)(WS_EVIN + li * SZ_EVIN); Sc.nN = QKF_LD / 256; E.ldc = QKF_LD;
                Sc.nExtra = 64; Sc.nFull = 384; }
            else { Sc.B = (long)(WS_ODIN + li * SZ_ODIN); Sc.nN = OD_IN / 256; E.ldc = OD_IN; Sc.nExtra = 0; Sc.nFull = (S / 256) * (OD_IN / 256); }
#if MK_JITCVT
            int par0 = (int)blockIdx.x; asm volatile("" : "+s"(par0)); par0 &= 1;
            const bool solo = !odd && c.G == 256;
            if (solo) { if (par0b_() >= 128) { FRESH(cc); moe_cvt(a, cc, l, 0, par0b_() - 128, 128); __syncthreads(); } }
            else if (par0 == 0) { FRESH(cc); moe_cvt(a, cc, l, 0); __syncthreads(); }
#endif
            pg8::gemm_phase<pg8::EpiBf16, false>(c.lds, c.wave, (const char*)ws, D, D, D, Sc, E);
#if MK_JITCVT
            int par0b = (int)blockIdx.x; asm volatile("" : "+s"(par0b));
            if (!(!odd && c.G == 256) && (par0b & 1) != 0) { FRESH(cc); moe_cvt(a, cc, l, 0); __syncthreads(); }
#endif
            SEAM(pb + 0);
        }
        if (EN(2) && IN(pb + 1)) {
#if MK_JITCVT && MK_UPHOST
            { int parm = (int)blockIdx.x; asm volatile("" : "+s"(parm)); if ((parm & 1) == 0) { FRESH(cc); moe_cvt(a, cc, l, 1); __syncthreads(); } }
#endif
            if (!odd) {
#ifndef MK_SUB
#define MK_SUB 7
#endif
                _Pragma("unroll 1") for (int rep = 0; rep < REPS(10); ++rep) if (MK_SUB & 1) for (int u = c.vcu; u < 256; u += c.G) { FRESH(cc); attn_unit(a, cc, li, u >> 2, u & 3); }
                _Pragma("unroll 1") for (int rep = 0; rep < REPS(11); ++rep) if (MK_SUB & 2) for (int u = c.vcu; u < 256; u += c.G) { FRESH(cc); ffta_unit(a, cc, u >> 6, u & 63); }
            } else {
                _Pragma("unroll 1") for (int rep = 0; rep < REPS(13); ++rep) if (MK_SUB & 4) for (int u = c.vcu; u < 256; u += c.G) { FRESH(cc); if (MK_ODDMIX2) oddmix_unit2(a, cc, li, u); else oddmix_unit(a, cc, li, u); }
            }
#if MK_JITCVT && MK_UPHOST
            { int parm = (int)blockIdx.x; asm volatile("" : "+s"(parm)); if ((parm & 1) != 0) { __syncthreads(); FRESH(cc); moe_cvt(a, cc, l, 1); __syncthreads(); } }
#endif
            SEAM(pb + 1);
        }
        if (EN(3) && IN(pb + 2)) {
            if (!odd) {
                _Pragma("unroll 1") for (int rep = 0; rep < REPS(12); ++rep) if (MK_SUB & 1) for (int u = c.vcu; u < 256; u += c.G) { FRESH(cc); fftc_unit(a, cc, u >> 2, u & 3); }
                __syncthreads();
            }
            if (!odd)             SEAM(pb + 2);
        }
        if (EN(4) && IN(pb + 3)) {
            const int Kk = odd ? D : MIX_LD_EV;
            pg8::Sched Sc{}; Sc.G = c.G; Sc.c = (int)blockIdx.x; Sc.A = (long)WS_MIX; Sc.sA = 0; Sc.tA = 256 * Kk * 2;
            Sc.B = (long)(odd ? WS_ODOUT + li * SZ_ODOUT : WS_EVOUT + li * SZ_EVOUT); Sc.sB = 0; Sc.tB = 256 * Kk * 2;
            Sc.nM = S / 256; Sc.nN = D / 256; Sc.nG = 1; Sc.gidx = nullptr; Sc.nExtra = 0; Sc.nFull = 256;
            pg8::EpiResF32 E{}; E.R = (l == 0) ? a.x_in : a.X; E.X = a.X; E.ldc = D;
#if MK_JITCVT && !MK_UPHOST
            int par1 = (int)blockIdx.x; asm volatile("" : "+s"(par1)); par1 &= 1;
            if (par1 == 0) { FRESH(cc); moe_cvt(a, cc, l, 1); __syncthreads(); }
#endif
            pg8::gemm_phase<pg8::EpiResF32, false>(c.lds, c.wave, (const char*)ws, Kk, Kk, Kk, Sc, E);
#if MK_JITCVT && !MK_UPHOST
            int par1b = (int)blockIdx.x; asm volatile("" : "+s"(par1b));
            if ((par1b & 1) != 0) { FRESH(cc); moe_cvt(a, cc, l, 1); __syncthreads(); }
#endif
#if MK_NRSTAGE
            if (IN(pb + 4) && EN(5) && !REPS_ON(14)) { FRESH(cc); norm_router_stage(a, cc, l); }
#endif
            SEAM(pb + 3);
        }
        if (EN(5) && IN(pb + 4)) { _Pragma("unroll 1") for (int rep = 0; rep < REPS(14); ++rep) { FRESH(cc); norm_router_phase(a, cc, l, MK_NRSTAGE && EN(4) && IN(pb + 3) && !REPS_ON(14)); } SEAM(pb + 4); }
        if (EN(6) && IN(pb + 5)) { _Pragma("unroll 1") for (int rep = 0; rep < REPS(6); ++rep) { FRESH(cc); int bx = (int)blockIdx.x; asm volatile("" : "+s"(bx));
              if (bx < NE) select_phase(a, cc, bx);
#if MK_JITCVT
              else if (c.G == 256) moe_cvt(a, cc, l, 2, bx - NE, 256 - NE, 0, MK_SELCVT);
#endif
#ifdef MK_SELSLEEP
              else { for (int q = 0; q < MK_SELSLEEP; ++q) __builtin_amdgcn_s_sleep(127); }
#endif
            } SEAM(pb + 5); }
        if (EN(7) && IN(pb + 6)) {
            pg8::Sched Sc{}; Sc.G = c.G; Sc.c = (int)blockIdx.x; Sc.A = (long)WS_H; Sc.sA = 0; Sc.tA = 0; Sc.B = (long)(WS_GU + l * SZ_GU); Sc.sB = (long)2048 * D * 2; Sc.tB = 256 * D * 2;
            Sc.nM = CAP / 256; Sc.nN = 2048 / 256; Sc.nG = NE; Sc.gidx = (const int*)(ws + WS_IDX); Sc.nExtra = 0; Sc.nFull = 512;
            pg8::EpiGU E{}; E.HID = (bf16_t*)(ws + WS_HID);
#if MK_JITCVT
            int par2 = (int)blockIdx.x; asm volatile("" : "+s"(par2)); par2 &= 1;
            if (par2 == 0) { FRESH(cc); moe_cvt(a, cc, l, 2, -1, 0, (c.G == 256) ? MK_SELCVT : 0); __syncthreads(); }
#endif
            pg8::gemm_phase<pg8::EpiGU, true>(c.lds, c.wave, (const char*)ws, D, D, D, Sc, E);
#if MK_JITCVT
            int par2b = (int)blockIdx.x; asm volatile("" : "+s"(par2b));
            if ((par2b & 1) != 0) { FRESH(cc); moe_cvt(a, cc, l, 2, -1, 0, (c.G == 256) ? MK_SELCVT : 0); __syncthreads(); }
#endif
            SEAM(pb + 6);
        }
        if (EN(8) && IN(pb + 7)) {
            pg8::Sched Sc{}; Sc.G = c.G; Sc.c = (int)blockIdx.x; Sc.A = (long)WS_HID; Sc.sA = (long)CAP * EH * 2; Sc.tA = 256 * EH * 2; Sc.B = (long)(WS_DN + l * SZ_DN); Sc.sB = (long)D * EH * 2; Sc.tB = 256 * EH * 2;
            Sc.nM = CAP / 256; Sc.nN = D / 256; Sc.nG = NE; Sc.gidx = nullptr; Sc.nExtra = 0; Sc.nFull = 512;
            pg8::EpiDown E{}; E.Y = (bf16_t*)(ws + WS_Y); E.gate = (const float*)(ws + WS_GATE);
            pg8::gemm_phase<pg8::EpiDown, false>(c.lds, c.wave, (const char*)ws, EH, EH, EH, Sc, E);
#if MK_NRSTAGE
            if (IN(pb + 8) && EN(9)) { FRESH(cc); combine_stage(a, cc, l); }
#endif
            SEAM(pb + 7);
        }
        if (EN(9) && IN(pb + 8)) { FRESH(cc); combine_phase(a, cc, l, MK_NRSTAGE && EN(8) && IN(pb + 7)); SEAM(pb + 8); }
    }
#undef IN
#undef SEAM
}
}


extern "C" void kernel_launch(void* const* d_in, const int* in_sizes, int n_in, void* d_out, int out_size, void* d_ws, size_t ws_size, hipStream_t stream) {
    using namespace mk;
    static int grid = 0;
    if (grid == 0) {
        int dev = 0, cus = 0, per_cu = 0;
        if (hipGetDevice(&dev) != hipSuccess || hipDeviceGetAttribute(&cus, hipDeviceAttributeMultiprocessorCount, dev) != hipSuccess) { fprintf(stderr, "kernel_launch: device query failed\n"); grid = -1; return; }
        if (hipFuncSetAttribute((const void*)mk_fwd, hipFuncAttributeMaxDynamicSharedMemorySize, LDS_BYTES) != hipSuccess) { fprintf(stderr, "kernel_launch: hipFuncSetAttribute failed\n"); grid = -1; return; }
        if (hipOccupancyMaxActiveBlocksPerMultiprocessor(&per_cu, (const void*)mk_fwd, NTHREADS, LDS_BYTES) != hipSuccess || per_cu < 1) fprintf(stderr, "kernel_launch: occupancy query reports %d blocks per CU\n", per_cu);
        (void)hipGetLastError();
        grid = cus;
        if (ws_size < WS_END) { fprintf(stderr, "kernel_launch: workspace too small: %zu < %zu\n", ws_size, (size_t)WS_END); grid = -1; return; }
    }
    if (grid < 0) return;
    (void)hipMemsetAsync((char*)d_ws + WS_CTL, 0, CTL_ZERO_BYTES, stream);
    Args a{};
    a.x_in = (const float*)d_in[0]; a.rel_bias = (const float*)d_in[1]; a.norm_mix_g = (const float*)d_in[2]; a.norm_ffn_g = (const float*)d_in[3]; a.final_g = (const float*)d_in[4];
    a.ev_w_in = (const float*)d_in[5]; a.ev_sink = (const float*)d_in[6]; a.ev_w_out = (const float*)d_in[7];
    a.od_w_in = (const float*)d_in[8]; a.od_conv_w = (const float*)d_in[9]; a.od_pool_w = (const float*)d_in[10]; a.od_pool_scale = (const float*)d_in[11]; a.od_w_out = (const float*)d_in[12];
    a.moe_w_router = (const float*)d_in[13]; a.moe_w_gate = (const float*)d_in[14]; a.moe_w_up = (const float*)d_in[15]; a.moe_w_down = (const float*)d_in[16];
    a.X = (float*)d_out; a.ws = (unsigned char*)d_ws;
#if MK_DEBUG
    mkref::debug_run(a, grid, d_in, d_out, d_ws, ws_size, stream);
#else
#if MK_NLAUNCH == 1
    a.ph_lo = 0; a.ph_hi = NPH;
    hipLaunchKernelGGL(mk_fwd, dim3(grid), dim3(NTHREADS), LDS_BYTES, stream, a);
#else
    for (int p = 0; p < NPH; ++p) { const int type = p == 0 ? 0 : ((p - 1) % 9) + 1; const int layer = p == 0 ? 0 : (p - 1) / 9; (void)layer;
        int reps = 1;
#if defined(MK_HREPMASK)
        if (((MK_HREPMASK >> type) & 1) && ((MK_HREPLAYERS >> layer) & 1)) reps = MK_HREPN;
#endif
        for (int r = 0; r < reps; ++r) { a.ph_lo = p; a.ph_hi = p + 1; hipLaunchKernelGGL(mk_fwd, dim3(grid), dim3(NTHREADS), LDS_BYTES, stream, a); } }
#if defined(MK_HREP_EMPTY)
    for (int r = 0; r < MK_HREP_EMPTY; ++r) { a.ph_lo = NPH; a.ph_hi = NPH; hipLaunchKernelGGL(mk_fwd, dim3(grid), dim3(NTHREADS), LDS_BYTES, stream, a); }
#endif
#endif
    if (hipPeekAtLastError() != hipSuccess) fprintf(stderr, "kernel_launch: launch failed\n");
#endif
}
```

```cpp
#include <hip/hip_runtime.h>
#include <cstdio>
#include <cstdint>

#ifndef MK_DEBUG
#define MK_DEBUG 0
#endif
#ifndef MK_NLAUNCH
#define MK_NLAUNCH 1
#endif

namespace mk {
constexpr int S = 8192, D = 2048;
constexpr int NL = MK_DEBUG ? 2 : 4;
constexpr int HD = 128, NQ = 12, NKV = 4, WIN = 128;
#ifndef MK_FFTFUSE
#define MK_FFTFUSE 1
#endif
constexpr int QDIM = 1536, KVDIM = 512, FDIM = 512, EV_IN = 3072, QKF_LD = 2560, MIX_LD_EV = MK_FFTFUSE ? 2048 : 2560;
constexpr int CONVD = 1024, POOLD = 1024, OD_IN = 4096;
constexpr int NE = 16, EH = 1024, CAP = 1024;
constexpr float EPS = 1e-6f;
constexpr int NWAVES = 8, NTHREADS = 512;

typedef unsigned short bf16_t;
typedef short bf16x8 __attribute__((ext_vector_type(8)));
typedef short s16x4 __attribute__((ext_vector_type(4)));
typedef float f32x4 __attribute__((ext_vector_type(4)));
typedef float f32x2 __attribute__((ext_vector_type(2)));
typedef unsigned u32x4 __attribute__((ext_vector_type(4)));
typedef unsigned u32x2 __attribute__((ext_vector_type(2)));
#define LAS __attribute__((address_space(3)))
#define GAS __attribute__((address_space(1)))
#define LDS_WAIT() asm volatile("s_waitcnt lgkmcnt(0)" ::: "memory")
#define VM_WAIT() asm volatile("s_waitcnt vmcnt(0)" ::: "memory")

constexpr size_t MiB = 1u << 20;
constexpr size_t WS_CTL = 0, CTL_ZERO_BYTES = 1 * MiB;
constexpr size_t WS_AFF = 1 * MiB;
constexpr size_t WS_INV = WS_AFF + 512 * 1024;
constexpr size_t WS_IDX = 2 * MiB;
constexpr size_t WS_GATE = WS_IDX + 64 * 1024;
constexpr size_t WS_PAR = 3 * MiB;
constexpr int PAR_RELB = 0, PAR_SINK = 384, PAR_GMIX = 512, PAR_GFFN = PAR_GMIX + 4 * 2048, PAR_GFIN = PAR_GFFN + 4 * 2048, PAR_CONV = PAR_GFIN + 2048, PAR_ROUTER = 32768, PAR_PTRS = 32000;
constexpr size_t WS_FTC = WS_PAR + 768 * 1024;
constexpr size_t WS_FTA = WS_PAR + 896 * 1024;
constexpr size_t WS_FCO = WS_PAR + 912 * 1024;
constexpr size_t WS_H = 4 * MiB;
constexpr size_t WS_Z = 36 * MiB;
constexpr size_t WS_VT = 100 * MiB;
constexpr size_t WS_MIX = 108 * MiB;
constexpr size_t WS_TB = 148 * MiB;
constexpr size_t WS_POOLED = 164 * MiB;
constexpr size_t WS_HID = 180 * MiB;
constexpr size_t WS_Y = 212 * MiB;
constexpr size_t WS_W = 276 * MiB;
constexpr size_t SZ_EVIN = (size_t)EV_IN * D * 2, SZ_EVOUT = (size_t)D * MIX_LD_EV * 2, SZ_ODIN = (size_t)OD_IN * D * 2, SZ_ODOUT = (size_t)D * D * 2, SZ_POOL = (size_t)4 * 256 * 256 * 2;
constexpr size_t SZ_GU = (size_t)NE * 2048 * D * 2, SZ_DN = (size_t)NE * D * EH * 2;
constexpr size_t WS_EVIN = WS_W, WS_EVOUT = WS_EVIN + (NL / 2) * SZ_EVIN, WS_ODIN = WS_EVOUT + (NL / 2) * SZ_EVOUT, WS_ODOUT = WS_ODIN + (NL / 2) * SZ_ODIN,
                 WS_POOLW = WS_ODOUT + (NL / 2) * SZ_ODOUT, WS_GU = WS_POOLW + (NL / 2) * SZ_POOL, WS_DN = WS_GU + NL * SZ_GU, WS_END = WS_DN + NL * SZ_DN;
constexpr int CW_TMO = 0, CW_CODE = 1, CW_BAR = 4096;

constexpr int RING_BYTES = 131072;
constexpr int LDSCTL_OFF = RING_BYTES, MISC_OFF = LDSCTL_OFF + 320;
constexpr int LDS_BYTES = 163840;

__device__ __forceinline__ unsigned f2bf(float f) { unsigned u = __builtin_bit_cast(unsigned, f); return (u + 0x7fffu + ((u >> 16) & 1u)) >> 16; }
typedef __bf16 bf16x2_t __attribute__((ext_vector_type(2)));
__device__ __forceinline__ unsigned cvt_pk_bf16(float lo, float hi) { const f32x2 v = {lo, hi}; return __builtin_bit_cast(unsigned, __builtin_convertvector(v, bf16x2_t)); }
#ifndef MK_PK2HW
#define MK_PK2HW 1
#endif
__device__ __forceinline__ unsigned pk2(float lo, float hi) { return MK_PK2HW ? cvt_pk_bf16(lo, hi) : (f2bf(lo) | (f2bf(hi) << 16)); }
__device__ __forceinline__ unsigned cvt_pk_bf16_v(float lo, float hi) { unsigned r; asm volatile("v_cvt_pk_bf16_f32 %0, %1, %2" : "=v"(r) : "v"(lo), "v"(hi)); return r; }
__device__ __forceinline__ float bf_lo(unsigned w) { return __builtin_bit_cast(float, w << 16); }
__device__ __forceinline__ float bf_hi(unsigned w) { return __builtin_bit_cast(float, w & 0xffff0000u); }
__device__ __forceinline__ int lane_id() { int l; asm volatile("v_mbcnt_lo_u32_b32 %0, -1, 0\n\tv_mbcnt_hi_u32_b32 %0, -1, %0" : "=v"(l)); return l; }
__device__ __forceinline__ float shx(float v, int o, int lane) { return __builtin_bit_cast(float, __builtin_amdgcn_ds_bpermute((lane ^ o) << 2, __builtin_bit_cast(int, v))); }
__device__ __forceinline__ int shxi(int v, int o, int lane) { return __builtin_amdgcn_ds_bpermute((lane ^ o) << 2, v); }
__device__ __forceinline__ float wave_sum(float v, int lane) {
#pragma unroll
    for (int o = 1; o < 64; o <<= 1) v += shx(v, o, lane);
    return v;
}
__device__ __forceinline__ int wave_sum_dpp(int v) {
    int t = v + __builtin_amdgcn_update_dpp(0, v, 0x111, 0xf, 0xf, true);
    t += __builtin_amdgcn_update_dpp(0, v, 0x112, 0xf, 0xf, true);
    t += __builtin_amdgcn_update_dpp(0, v, 0x113, 0xf, 0xf, true);
    t += __builtin_amdgcn_update_dpp(0, t, 0x114, 0xf, 0xe, true);
    t += __builtin_amdgcn_update_dpp(0, t, 0x118, 0xf, 0xc, true);
    t += __builtin_amdgcn_update_dpp(0, t, 0x142, 0xa, 0xf, true);
    t += __builtin_amdgcn_update_dpp(0, t, 0x143, 0xc, 0xf, true);
    return __builtin_amdgcn_readlane(t, 63);
}
__device__ __forceinline__ int wave_sum_i(int v, int lane) {
#pragma unroll
    for (int o = 1; o < 64; o <<= 1) v += shxi(v, o, lane);
    return v;
}

namespace pg8 {
constexpr int BM = 256, BK = 64, HALF = 128, HTB = HALF * BK * 2, STAGE_BYTES = 8 * HTB, NXCD = 8, WGM = 8;
__host__ __device__ __forceinline__ int lds_byte(int r, int c) { const int st = (r >> 4) * 2 + (c >> 5), rr = r & 15, cc = c & 31, ob = rr * 64 + cc * 2; return st * 1024 + (ob ^ (((ob >> 9) & 1) << 5)); }
__host__ __device__ __forceinline__ void stage_rc(int b, int& R, int& C) { const int st = b / 1024, sb = b % 1024, swz = sb ^ (((sb >> 9) & 1) << 5); R = (st >> 1) * 16 + swz / 64; C = (st & 1) * 32 + (swz % 64) / 2; }
__host__ __device__ __forceinline__ int perm32(int rho) { const int n = rho >> 4, i = rho & 15; return 8 * (i >> 2) + 4 * n + (i & 3); }

struct Unit { long offA, offB; int gio, pm, pn, grp, kind, half, hsel; };

struct Sched {
    long A, B, sA, sB;
    int tA, tB; int nM, nN, nG, G, c; const int* gidx;
    int nExtra;
    int nFull;
    __device__ __forceinline__ bool next(int i, Unit& u) const {
        const int nreg = nM * nN * nG, ntot = nreg + nExtra; const int L0 = i * G + c;
        if (L0 >= nFull + 2 * (ntot - nFull)) return false;
        const bool hf = L0 >= nFull; const int L = hf ? nFull + ((L0 - nFull) >> 1) : L0; const int hs = hf ? ((L0 - nFull) & 1) : 0;
        const bool ex = L >= nreg;
        int wgid = ex ? 0 : L; { const int q = nreg / NXCD, r = nreg % NXCD, xcd = wgid % NXCD, off = wgid / NXCD; wgid = (xcd < r ? xcd * (q + 1) : r * (q + 1) + (xcd - r) * q) + off; }
        int pm, pn, grp;
        if (nG == 1) {
            const int nig = WGM * nN, gid = wgid / nig, fm = gid * WGM, gsz = (nM - fm) < WGM ? (nM - fm) : WGM;
            pm = fm + ((wgid % nig) % gsz); pn = (wgid % nig) / gsz; grp = 0;
        } else { const int per = nM * nN; grp = wgid / per; const int r = wgid % per; pm = r % nM; pn = r / nM; }
        const int j = L - nreg;
        u.pm = ex ? (j & 1) : pm; u.pn = ex ? (j >> 1) : pn; u.grp = ex ? 0 : grp; u.kind = ex ? 1 : 0; u.half = hf ? 1 : 0; u.hsel = hs;
        u.gio = grp * (nM * BM) + pm * BM;
        const long ra = A + grp * sA + (gidx ? 0 : (long)pm * tA), rb = B + grp * sB + (long)pn * tB;
        u.offA = (ex ? B + (long)(nN + (j & 1)) * tB : ra) + (long)hs * ((ex ? tB : tA) >> 1); u.offB = ex ? A + (long)(j >> 1) * tA : rb;
        return true;
    }
};

struct EpiBf16 {
    static constexpr bool PERM = true, INIT_ACC = false, HALVES = true;
    bf16_t* O; int ldc; int gcol; bf16_t* O2; int ldc2;
    __device__ __forceinline__ void operator()(const f32x4 (&acc)[2][2][4][2], const Unit& u, int wr, int wc, int fr, int fq) const {
        bf16_t* base; int ld;
        if (u.kind) { base = O2 + (size_t)(u.pm * BM) * ldc2 + u.pn * BM; ld = ldc2; } else { base = O + (size_t)(u.pm * BM) * ldc + u.pn * BM + u.grp * gcol; ld = ldc; }
        bf16_t* rowp = base + (unsigned)((wr * 64 + fr + u.hsel * HALF) * ld + wc * 32 + 8 * fq);
#pragma unroll
        for (int ai = 0; ai < 2; ++ai) {
            if (ai == 1 && u.half) break;
#pragma unroll
            for (int m = 0; m < 4; ++m) {
#pragma unroll
                for (int bj = 0; bj < 2; ++bj) { const f32x4 v0 = acc[ai][bj][m][0], v1 = acc[ai][bj][m][1];
                    u32x4 w; w.x = cvt_pk_bf16(v0[0], v0[1]); w.y = cvt_pk_bf16(v0[2], v0[3]); w.z = cvt_pk_bf16(v1[0], v1[1]); w.w = cvt_pk_bf16(v1[2], v1[3]);
                    *(u32x4*)(rowp + bj * HALF) = w; }
                rowp += 16 * ld; asm volatile("" : "+v"(rowp)); }
            rowp += (HALF - 64) * ld; }
    }
};
struct EpiResF32 {
    static constexpr bool PERM = false, INIT_ACC = true, HALVES = false;
    const float* R; float* X; int ldc;
    __device__ __forceinline__ void init(f32x4 (&acc)[2][2][4][2], const Unit& u, int wr, int wc, int fr, int fq) const {
        const size_t off0 = (size_t)(u.pm * BM + wr * 64 + fr) * ldc + u.pn * BM + wc * 32 + 4 * fq;
#pragma unroll
        for (int ai = 0; ai < 2; ++ai)
#pragma unroll
            for (int m = 0; m < 4; ++m) { const size_t off = off0 + (size_t)(ai * HALF + m * 16) * ldc;
#pragma unroll
                for (int bj = 0; bj < 2; ++bj)
#pragma unroll
                    for (int n = 0; n < 2; ++n) acc[ai][bj][m][n] = *(const f32x4*)(R + off + bj * HALF + n * 16); }
    }
    __device__ __forceinline__ void operator()(const f32x4 (&acc)[2][2][4][2], const Unit& u, int wr, int wc, int fr, int fq) const {
        const size_t off0 = (size_t)(u.pm * BM + wr * 64 + fr) * ldc + u.pn * BM + wc * 32 + 4 * fq;
#pragma unroll
        for (int ai = 0; ai < 2; ++ai)
#pragma unroll
            for (int m = 0; m < 4; ++m) { const size_t off = off0 + (size_t)(ai * HALF + m * 16) * ldc;
#pragma unroll
                for (int bj = 0; bj < 2; ++bj)
#pragma unroll
                    for (int n = 0; n < 2; ++n) *(f32x4*)(X + off + bj * HALF + n * 16) = acc[ai][bj][m][n]; }
    }
};
__device__ __forceinline__ float silu_mul(float g, float u) { return g * u * __builtin_amdgcn_rcpf(1.0f + __expf(-g)); }
struct EpiGU {
    static constexpr bool PERM = true, INIT_ACC = false, HALVES = false;
    bf16_t* HID;
    __device__ __forceinline__ void operator()(const f32x4 (&acc)[2][2][4][2], const Unit& u, int wr, int wc, int fr, int fq) const {
        bf16_t* base = HID + ((size_t)u.grp * CAP + u.pm * BM + wr * 64 + fr) * EH + u.pn * HALF + wc * 32 + 8 * fq;
#pragma unroll
        for (int ai = 0; ai < 2; ++ai)
#pragma unroll
            for (int m = 0; m < 4; ++m) { const f32x4 g0 = acc[ai][0][m][0], g1 = acc[ai][0][m][1], u0 = acc[ai][1][m][0], u1 = acc[ai][1][m][1];
                u32x4 w; w.x = cvt_pk_bf16(silu_mul(g0[0], u0[0]), silu_mul(g0[1], u0[1])); w.y = cvt_pk_bf16(silu_mul(g0[2], u0[2]), silu_mul(g0[3], u0[3]));
                w.z = cvt_pk_bf16(silu_mul(g1[0], u1[0]), silu_mul(g1[1], u1[1])); w.w = cvt_pk_bf16(silu_mul(g1[2], u1[2]), silu_mul(g1[3], u1[3]));
                *(u32x4*)(base + (size_t)(ai * HALF + m * 16) * EH) = w; }
    }
};
struct EpiDown {
    static constexpr bool PERM = true, INIT_ACC = false, HALVES = false;
    bf16_t* Y; const float* gate;
    __device__ __forceinline__ void operator()(const f32x4 (&acc)[2][2][4][2], const Unit& u, int wr, int wc, int fr, int fq) const {
        const int row0 = u.grp * CAP + u.pm * BM + wr * 64 + fr;
        bf16_t* base = Y + (size_t)row0 * D + u.pn * BM + wc * 32 + 8 * fq;
#pragma unroll
        for (int ai = 0; ai < 2; ++ai)
#pragma unroll
            for (int m = 0; m < 4; ++m) { const float gt = gate[row0 + ai * HALF + m * 16]; bf16_t* rowp = base + (size_t)(ai * HALF + m * 16) * D;
#pragma unroll
                for (int bj = 0; bj < 2; ++bj) { const f32x4 v0 = acc[ai][bj][m][0] * gt, v1 = acc[ai][bj][m][1] * gt;
                    u32x4 w; w.x = cvt_pk_bf16(v0[0], v0[1]); w.y = cvt_pk_bf16(v0[2], v0[3]); w.z = cvt_pk_bf16(v1[0], v1[1]); w.w = cvt_pk_bf16(v1[2], v1[3]);
                    *(u32x4*)(rowp + bj * HALF) = w; } }
    }
};

template <class Epi, bool GATHER>
__device__ __forceinline__ void gemm_phase(LAS unsigned char* lds, const int wid_in, const char* wsb, const int K, const int lda, const int ldb, const Sched& S, const Epi& E) {
    int wid = wid_in; asm volatile("" : "+s"(wid));
    const int lane = lane_id();
    const int tid = wid * 64 + lane, wr = wid >> 2, wc = wid & 3, fr = lane & 15, fq = lane >> 4;
    const int nt = K / BK;
    unsigned voffA[2][2], voffB[2];
#pragma unroll
    for (int i = 0; i < 2; ++i) { int R, C; stage_rc(tid * 16 + i * 8192, R, C); const int Rb = Epi::PERM ? ((R & ~31) + perm32(R & 31)) : R;
        voffA[0][i] = (unsigned)(R * lda + C) * 2u; voffA[1][i] = voffA[0][i]; voffB[i] = (unsigned)(Rb * ldb + C) * 2u; }
    const size_t hstepA = GATHER ? (size_t)0 : (size_t)HALF * lda * 2;
    const size_t kstep = (size_t)(BK * 2);
    const size_t hstepB = (size_t)HALF * ldb * 2;
    const unsigned ldsw = (unsigned)wid * 1024u;
    const int aoff = lds_byte(wr * 64 + fr, fq * 8), boff = lds_byte(wc * 32 + fr, fq * 8);
#define PG8_SA(b, h) (((b) * 2 + (h)) * HTB)
#define PG8_SB(b, h) ((4 + (b) * 2 + (h)) * HTB)
#define PG8_STAGEA(bufoff, gbase, h) do { _Pragma("unroll") for (int _i = 0; _i < 2; ++_i) \
        __builtin_amdgcn_global_load_lds((const unsigned*)((const char*)(gbase) + (h) * hstepA + voffA[GATHER ? (h) : 0][_i]), (LAS unsigned*)(lds + (bufoff) + ldsw + _i * 8192), 16, 0, 0); } while (0)
#define PG8_STAGEB(bufoff, gbase) do { _Pragma("unroll") for (int _i = 0; _i < 2; ++_i) \
        __builtin_amdgcn_global_load_lds((const unsigned*)((const char*)(gbase) + voffB[_i]), (LAS unsigned*)(lds + (bufoff) + ldsw + _i * 8192), 16, 0, 0); } while (0)
#define PG8_LDA(dst, b, h) do { _Pragma("unroll") for (int m = 0; m < 4; ++m) _Pragma("unroll") for (int k = 0; k < 2; ++k) dst[m][k] = *(const LAS bf16x8*)(lds + PG8_SA(b, h) + aoff + m * 2048 + k * 1024); } while (0)
#define PG8_LDB(dst, b, h) do { _Pragma("unroll") for (int n = 0; n < 2; ++n) _Pragma("unroll") for (int k = 0; k < 2; ++k) dst[n][k] = *(const LAS bf16x8*)(lds + PG8_SB(b, h) + boff + n * 2048 + k * 1024); } while (0)
#define PG8_MMA(ai, bj, At, Bt) do { __builtin_amdgcn_s_setprio(1); _Pragma("unroll") for (int m = 0; m < 4; ++m) _Pragma("unroll") for (int n = 0; n < 2; ++n) _Pragma("unroll") for (int k = 0; k < 2; ++k) \
        acc[ai][bj][m][n] = __builtin_amdgcn_mfma_f32_16x16x32_bf16(Bt[n][k], At[m][k], acc[ai][bj][m][n], 0, 0, 0); __builtin_amdgcn_s_setprio(0); } while (0)
#define PG8_WAIT_V(n) asm volatile("s_waitcnt vmcnt(" #n ")" ::: "memory")
#define PG8_WAIT_L(n) asm volatile("s_waitcnt lgkmcnt(" #n ")" ::: "memory")
#define PG8_BAR __builtin_amdgcn_s_barrier()
#define PG8_SCHED __builtin_amdgcn_sched_barrier(0)
#define PG8_GIDX(dst, uu) do { _Pragma("unroll") for (int _i = 0; _i < 2; ++_i) { int _R, _C; stage_rc(tid * 16 + _i * 8192, _R, _C); _Pragma("unroll") for (int _h = 0; _h < 2; ++_h) \
        dst[_h][_i] = (unsigned)(S.gidx[(uu).gio + _R + _h * HALF] * lda + _C) * 2u; } } while (0)
    Unit cur, nxt; int ui = 0;
    if (!S.next(0, cur)) return;
    f32x4 acc[2][2][4][2];
    if constexpr (Epi::INIT_ACC) { E.init(acc, cur, wr, wc, fr, fq); } else {
#pragma unroll
    for (int a = 0; a < 2; ++a)
#pragma unroll
        for (int b = 0; b < 2; ++b)
#pragma unroll
            for (int m = 0; m < 4; ++m)
#pragma unroll
                for (int n = 0; n < 2; ++n) acc[a][b][m][n] = (f32x4){0.f, 0.f, 0.f, 0.f};
    }
    bf16x8 At[4][2], B0[2][2], B1[2][2];
    const char* cA = wsb + cur.offA; const char* cB = wsb + cur.offB;
    if constexpr (GATHER) { PG8_GIDX(voffA, cur); }
    PG8_STAGEB(PG8_SB(0, 0), cB); PG8_STAGEB(PG8_SB(0, 1), cB + hstepB); PG8_STAGEA(PG8_SA(0, 0), cA, 0); PG8_STAGEA(PG8_SA(0, 1), cA, 1);
    if (wr == 1) PG8_BAR;
    PG8_WAIT_V(2); PG8_BAR;
    PG8_STAGEB(PG8_SB(1, 0), cB + kstep); PG8_STAGEA(PG8_SA(1, 0), cA + kstep, 0); PG8_STAGEB(PG8_SB(1, 1), cB + hstepB + kstep);
    PG8_WAIT_V(6); PG8_BAR;
    for (;;) {
        const bool has_next = S.next(ui + 1, nxt);
        const char* nA = has_next ? wsb + nxt.offA : cA; const char* nB = has_next ? wsb + nxt.offB : cB;
        for (int t = 0; t < nt; t += 2) {
            const bool last = (t == nt - 2);
            const char* a1 = cA + (size_t)(t + 1) * kstep;
            const char* a2 = last ? nA : cA + (size_t)(t + 2) * kstep; const char* b2 = last ? nB : cB + (size_t)(t + 2) * kstep;
            const char* a3 = a2 + kstep; const char* b3 = b2 + kstep;
            unsigned nv[2][2];
            if constexpr (GATHER) { if (last && has_next) { PG8_GIDX(nv, nxt); } }
            PG8_LDB(B0, 0, 0); PG8_LDB(B1, 0, 1); PG8_SCHED; PG8_LDA(At, 0, 0); PG8_STAGEA(PG8_SA(1, 1), a1, 1);
            if constexpr (GATHER) { if (last && has_next) {
#pragma unroll
                for (int _h = 0; _h < 2; ++_h)
#pragma unroll
                    for (int _i = 0; _i < 2; ++_i) voffA[_h][_i] = nv[_h][_i]; } }
            PG8_WAIT_V(8); PG8_WAIT_L(0); PG8_BAR; PG8_MMA(0, 0, At, B0); PG8_MMA(0, 1, At, B1); PG8_BAR; PG8_SCHED;
            PG8_LDA(At, 0, 1); PG8_STAGEB(PG8_SB(0, 0), b2); PG8_STAGEB(PG8_SB(0, 1), b2 + hstepB); PG8_STAGEA(PG8_SA(0, 0), a2, 0);
            PG8_WAIT_V(8); PG8_WAIT_L(0); PG8_BAR; if (!(Epi::HALVES && cur.half)) { PG8_MMA(1, 0, At, B0); PG8_MMA(1, 1, At, B1); } PG8_BAR; PG8_SCHED;
            PG8_LDB(B0, 1, 0); PG8_LDB(B1, 1, 1); PG8_SCHED; PG8_LDA(At, 1, 0); PG8_STAGEA(PG8_SA(0, 1), a2, 1);
            PG8_WAIT_V(8); PG8_WAIT_L(0); PG8_BAR; PG8_MMA(0, 0, At, B0); PG8_MMA(0, 1, At, B1); PG8_BAR; PG8_SCHED;
            PG8_LDA(At, 1, 1); PG8_STAGEB(PG8_SB(1, 0), b3); PG8_STAGEB(PG8_SB(1, 1), b3 + hstepB); PG8_STAGEA(PG8_SA(1, 0), a3, 0);
            PG8_WAIT_V(8); PG8_WAIT_L(0); PG8_BAR; if (!(Epi::HALVES && cur.half)) { PG8_MMA(1, 0, At, B0); PG8_MMA(1, 1, At, B1); } PG8_BAR; PG8_SCHED;
        }
        if (wr == 0) PG8_BAR;
        { const int le = lane_id(); E(acc, cur, wr, wc, le & 15, le >> 4); }
        if (!has_next) break;
        if constexpr (Epi::INIT_ACC) { E.init(acc, nxt, wr, wc, fr, fq); } else {
#pragma unroll
        for (int a = 0; a < 2; ++a)
#pragma unroll
            for (int b = 0; b < 2; ++b)
#pragma unroll
                for (int m = 0; m < 4; ++m)
#pragma unroll
                    for (int n = 0; n < 2; ++n) acc[a][b][m][n] = (f32x4){0.f, 0.f, 0.f, 0.f};
        }
        cur = nxt; cA = nA; cB = nB; ++ui;
        if (wr == 1) PG8_BAR;
    }
    PG8_WAIT_V(0);
    PG8_BAR;
#undef PG8_SA
#undef PG8_SB
#undef PG8_STAGEA
#undef PG8_STAGEB
#undef PG8_LDA
#undef PG8_LDB
#undef PG8_MMA
#undef PG8_WAIT_V
#undef PG8_WAIT_L
#undef PG8_BAR
#undef PG8_SCHED
#undef PG8_GIDX
}
}
#define XB_TMO      128
#define XB_XCNT(j)  (256  + 64 * (j))
#define XB_XSUB(j)  (1280 + 64 * (j))
#define XB_XGEN(j)  (2304 + 64 * (j))
#define XB_TOP      3328
#define XB_TOPGEN   3392
#define XCD_BAR_WORDS 3456
#define XB_SPIN_CAP (1u << 18)
__device__ __forceinline__ unsigned xb_ld(unsigned* p)              { return __hip_atomic_load(p, __ATOMIC_RELAXED, __HIP_MEMORY_SCOPE_AGENT); }
__device__ __forceinline__ unsigned xb_add(unsigned* p, unsigned v) { return __hip_atomic_fetch_add(p, v, __ATOMIC_RELAXED, __HIP_MEMORY_SCOPE_AGENT); }
__device__ __forceinline__ unsigned xb_xcc_id() { return (unsigned)__builtin_amdgcn_s_getreg((3 << 11) | 20) & 0xFu; }
#define XB_SPIN(cond, bar) do { unsigned _sp = 0; while (cond) { __builtin_amdgcn_s_sleep(1); \
    if ((++_sp & 255u) == 0u) { if (xb_ld(&(bar)[XB_TMO])) break; if (_sp > XB_SPIN_CAP) { atomicAdd(&(bar)[XB_TMO], 1u); break; } } } } while (0)
struct XcdBarrier { unsigned* bar; unsigned x; volatile LAS unsigned* st; };
__device__ __forceinline__ XcdBarrier xcd_barrier_post(unsigned* bar, volatile LAS unsigned* st, bool leader) {
    XcdBarrier b; b.bar = bar; b.x = xb_xcc_id(); b.st = st;
    if (leader) (void)xb_add(&bar[XB_XCNT(b.x)], 1u);
    return b;
}
__device__ __forceinline__ void xcd_barrier_complete(unsigned* bar, unsigned x, unsigned& nloc, unsigned& nx) {
    const unsigned G = gridDim.x * gridDim.y * gridDim.z;
    unsigned sum, cnt, mine, sp = 0u;
    for (;;) {
        sum = 0u; cnt = 0u; mine = 0u;
#pragma unroll
        for (unsigned j = 0; j < 16; ++j) { const unsigned c = xb_ld(&bar[XB_XCNT(j)]); sum += c; cnt += (c > 0u) ? 1u : 0u; mine = (j == x) ? c : mine; }
        if (sum == G) break;
        __builtin_amdgcn_s_sleep(1);
        if ((++sp & 255u) == 0u) { if (xb_ld(&bar[XB_TMO])) break; if (sp > XB_SPIN_CAP) { atomicAdd(&bar[XB_TMO], 1u); break; } }
    }
    nloc = mine > 0u ? mine : 1u; nx = cnt > 0u ? cnt : 1u;
}
__device__ __forceinline__ void xcd_barrier(const XcdBarrier& b, bool leader) {
    asm volatile("s_waitcnt vmcnt(0)" ::: "memory");
    __syncthreads();
    if (leader) {
        unsigned* bar = b.bar;
        __builtin_amdgcn_s_waitcnt(0);
        unsigned nloc = b.st[0], nx = b.st[1];
        if (nloc == 0u) { xcd_barrier_complete(bar, b.x, nloc, nx); b.st[0] = nloc; b.st[1] = nx; }
        const unsigned old = xb_add(&bar[XB_XSUB(b.x)], 1u);
        const unsigned gen = old / nloc;
        if (old + 1u == (gen + 1u) * nloc) {
            __builtin_amdgcn_fence(__ATOMIC_RELEASE, "agent");
            asm volatile("s_waitcnt vmcnt(0)" ::: "memory");
            const unsigned og = xb_add(&bar[XB_TOP], 1u);
            const unsigned tg = og / nx;
            if (og + 1u == (tg + 1u) * nx) xb_add(&bar[XB_TOPGEN], 1u);
            else XB_SPIN(xb_ld(&bar[XB_TOPGEN]) == tg, bar);
            __builtin_amdgcn_fence(__ATOMIC_ACQUIRE, "agent");
            xb_add(&bar[XB_XGEN(b.x)], 1u);
            asm volatile("s_waitcnt vmcnt(0)" ::: "memory");
        } else {
            XB_SPIN(xb_ld(&bar[XB_XGEN(b.x)]) == gen, bar);
            __builtin_amdgcn_fence(__ATOMIC_ACQUIRE, "agent");
            asm volatile("s_waitcnt vmcnt(0)" ::: "memory");
        }
    }
    __syncthreads();
}

struct Args {
    const float* x_in; const float* rel_bias; const float* norm_mix_g; const float* norm_ffn_g; const float* final_g;
    const float* ev_w_in; const float* ev_sink; const float* ev_w_out;
    const float* od_w_in; const float* od_conv_w; const float* od_pool_w; const float* od_pool_scale; const float* od_w_out;
    const float* moe_w_router; const float* moe_w_gate; const float* moe_w_up; const float* moe_w_down;
    float* X; unsigned char* ws; int ph_lo, ph_hi;
};
struct Ctx { LAS unsigned char* lds; int tid, lane, wave, vcu, G; };

__device__ __forceinline__ int t5_bucket(int rel) {
    const int n = rel < 0 ? -rel : rel; int b;
    if (n < 8) b = n; else if (n < 12) b = 8; else if (n < 16) b = 9; else if (n < 23) b = 10; else if (n < 32) b = 11;
    else if (n < 46) b = 12; else if (n < 64) b = 13; else if (n < 91) b = 14; else b = 15;
    return b + (rel > 0 ? 16 : 0);
}

__device__ __forceinline__ void cvt_item(const float* W, int ldw, int k0, int n0, bf16_t* WT, int ldd, int drow, const float* nscale, LAS float* scr, int lane) {
    const int lr = lane >> 4, lc = (lane & 15) * 4;
    f32x4 v[16];
    const float* src = W + (size_t)(k0 + lr) * ldw + n0 + lc;
#pragma unroll
    for (int i = 0; i < 16; ++i) v[i] = __builtin_nontemporal_load((const GAS f32x4*)(src + (size_t)(4 * i) * ldw));
#pragma unroll
    for (int i = 0; i < 16; ++i) { const int row = 4 * i + lr; *(LAS f32x4*)(scr + row * 64 + (lc ^ (4 * ((row >> 3) & 7)))) = v[i]; }
    LDS_WAIT(); asm volatile("" ::: "memory");
    const int c = lane & 7;
#pragma unroll
    for (int j = 0; j < 8; ++j) { const int n = (lane >> 3) + 8 * j; const LAS float* sp = scr + (8 * c) * 64 + (n ^ (4 * c)); const float sc = nscale ? nscale[n0 + n] : 1.0f;
        u32x4 o; o.x = pk2(sp[0 * 64] * sc, sp[1 * 64] * sc); o.y = pk2(sp[2 * 64] * sc, sp[3 * 64] * sc); o.z = pk2(sp[4 * 64] * sc, sp[5 * 64] * sc); o.w = pk2(sp[6 * 64] * sc, sp[7 * 64] * sc);
        __builtin_nontemporal_store(o, (GAS u32x4*)(WT + (size_t)(drow + n) * ldd + k0 + 8 * c)); }
    LDS_WAIT(); asm volatile("" ::: "memory");
}
__device__ __forceinline__ void norm_store_bf16(const f32x4 (&v)[8], const float* g, bf16_t* orow, int lane) {
    float ss = 0.f;
#pragma unroll
    for (int j = 0; j < 8; ++j) ss += (v[j].x * v[j].x + v[j].y * v[j].y) + (v[j].z * v[j].z + v[j].w * v[j].w);
    const float r = rsqrtf(wave_sum(ss, lane) * (1.0f / D) + EPS);
    GAS u32x2* o8 = (GAS u32x2*)orow + lane; const GAS f32x4* g4 = (const GAS f32x4*)g + lane;
#pragma unroll
    for (int j = 0; j < 8; ++j) { const f32x4 w = g4[64 * j]; u32x2 o; o.x = pk2(v[j].x * r * w.x, v[j].y * r * w.y); o.y = pk2(v[j].z * r * w.z, v[j].w * r * w.w); o8[64 * j] = o; }
}

#ifndef MK_ODDMIX2
#define MK_ODDMIX2 1
#endif
#ifndef MK_PV3
#define MK_PV3 1
#endif
#ifndef MK_UPHOST
#define MK_UPHOST 1
#endif
#ifndef MK_JITCVT
#define MK_JITCVT 1
#endif
__device__ __forceinline__ void moe_cvt(const Args& a, const Ctx& c, int l, int part, int rank0 = -1, int nrank = 0, int it_lo = 0, int it_hi = NE * 16 * 32) {
    LAS float* scr = (LAS float*)(c.lds + c.wave * 16384);
    int gw = (rank0 >= 0 ? rank0 : c.vcu) * NWAVES + c.wave; asm volatile("" : "+s"(gw));
    const int NGW = (rank0 >= 0 ? nrank : c.G) * NWAVES;
    unsigned char* ws = a.ws;
    const float* wsrc = (const float*)(((const unsigned long long*)((const float*)(ws + WS_PAR) + PAR_PTRS))[part]);
    if (part < 2) {
        for (int it = it_lo + gw; it < it_hi; it += NGW) { const int le = l * NE + it / 512, r2 = it % 512, kb = r2 / 16, nb = r2 % 16;
            const float* src = wsrc + (size_t)le * D * EH; const int n0 = nb * 64;
            cvt_item(src, EH, kb * 64, n0, (bf16_t*)(ws + WS_GU) + (size_t)le * 2048 * D, D, (n0 >> 7) * 256 + part * 128 + (n0 & 127), nullptr, scr, c.lane); }
    } else {
        for (int it = it_lo + gw; it < it_hi; it += NGW) { const int le = l * NE + it / 512, r = it % 512, kb = r / 32, nb = r % 32;
            cvt_item(wsrc + (size_t)le * EH * D, D, kb * 64, nb * 64, (bf16_t*)(ws + WS_DN) + (size_t)le * D * EH, EH, nb * 64, nullptr, scr, c.lane); }
    }
}

__device__ __forceinline__ u32x4 fftc_bfrag(const LAS float* c128, int w, int ks, int t, int fr, int fq) {
#if MK_FFTFUSE
    const int pq = t, k2 = 16 * w + fr; unsigned wv[4];
#else
    const int pq = w >> 2, k2 = 32 * (w & 3) + 16 * t + fr; unsigned wv[4];
#endif
#pragma unroll
    for (int jj = 0; jj < 4; ++jj) { float v[2];
#pragma unroll
        for (int e = 0; e < 2; ++e) { const int j = 2 * jj + e; const int ss = 32 * ks + 16 * (j >> 2) + 4 * fq + (j & 3); const int ri = ss >> 7, s2 = ss & 127; const int m = (s2 * k2) & 127;
            const float cs = c128[m], sn = c128[(m - 32) & 127];
            v[e] = (pq == 0) ? (ri == 0 ? cs : sn) : (ri == 0 ? -sn : cs); }
        wv[jj] = pk2(v[0], v[1]); }
    u32x4 ww; ww.x = wv[0]; ww.y = wv[1]; ww.z = wv[2]; ww.w = wv[3]; return ww;
}
__device__ __forceinline__ u32x4 fftc_cfrag(const LAS float* c128, int lt, int kap, int plane, int fr, int fq) {
    const int l = 16 * lt + fr; unsigned wv[4];
#pragma unroll
    for (int jj = 0; jj < 4; ++jj) { float v[2];
#pragma unroll
        for (int e = 0; e < 2; ++e) { const int j = 2 * jj + e; const int cch = 32 * kap + 16 * (j >> 2) + 4 * fq + (j & 3); const int m = (l * cch) & 127;
            v[e] = (plane == 0 ? c128[m] : c128[(m - 32) & 127]) * (1.0f / 1024.0f); }
        wv[jj] = pk2(v[0], v[1]); }
    u32x4 ww; ww.x = wv[0]; ww.y = wv[1]; ww.z = wv[2]; ww.w = wv[3]; return ww;
}
__device__ __forceinline__ void ffta_bfrag(const LAS float* c128, int jp, int ks, int fr, int fq, u32x4& wr_, u32x4& wi_) {
    unsigned re[4], im[4];
#pragma unroll
    for (int jj = 0; jj < 4; ++jj) { float cr[2], ci[2];
#pragma unroll
        for (int e = 0; e < 2; ++e) { const int j = 2 * jj + e; const int s1 = 32 * ks + 16 * (j >> 2) + 4 * fq + (j & 3); const int m = (s1 * (16 * jp + fr)) & 63; cr[e] = c128[2 * m]; ci[e] = -c128[2 * ((m - 16) & 63)]; }
        re[jj] = pk2(cr[0], cr[1]); im[jj] = pk2(ci[0], ci[1]); }
    wr_.x = re[0]; wr_.y = re[1]; wr_.z = re[2]; wr_.w = re[3]; wi_.x = im[0]; wi_.y = im[1]; wi_.z = im[2]; wi_.w = im[3];
}

__device__ __forceinline__ void p0_prologue(const Args& a, const Ctx& c) {
    LAS float* scr = (LAS float*)(c.lds + c.wave * 16384);
    const int gw = c.vcu * NWAVES + c.wave, NGW = c.G * NWAVES;
    unsigned char* ws = a.ws;
    LAS float* ctab = (LAS float*)(c.lds + RING_BYTES + 1024);
    __syncthreads();
    if (c.tid < 128) { float sn, cs; sincospif((float)c.tid * (1.0f / 64.0f), &sn, &cs); ctab[c.tid] = cs; }
    __syncthreads();
    if (c.vcu < 8) { const int ks = c.vcu;
#pragma unroll
        for (int t = 0; t < 2; ++t) ((GAS u32x4*)(ws + WS_FTC))[((c.wave * 8 + ks) * 2 + t) * 64 + c.lane] = fftc_bfrag(ctab, c.wave, ks, t, c.lane & 15, c.lane >> 4);
    } else if (c.vcu == 8) { u32x4 wr_, wi_; ffta_bfrag(ctab, c.wave >> 1, c.wave & 1, c.lane & 15, c.lane >> 4, wr_, wi_);
        ((GAS u32x4*)(ws + WS_FTA))[(c.wave * 2 + 0) * 64 + c.lane] = wr_; ((GAS u32x4*)(ws + WS_FTA))[(c.wave * 2 + 1) * 64 + c.lane] = wi_; }
#if MK_FFTFUSE
    else if (c.vcu == 9) {
#pragma unroll
        for (int q = 0; q < 8; ++q) ((GAS u32x4*)(ws + WS_FCO))[((c.wave * 4 + (q >> 1)) * 2 + (q & 1)) * 64 + c.lane] = fftc_cfrag(ctab, c.wave, q >> 1, q & 1, c.lane & 15, c.lane >> 4); }
#endif
#pragma unroll 1
    for (int pass = 0; pass < 2; ++pass) {
#if !MK_FFTFUSE
    if ((pass == 0) == (c.wave < 4)) {
        LAS float* sw = (LAS float*)(c.lds + c.wave * 16384);
        for (int it = gw; it < (NL / 2) * 4 * 64 * 4; it += NGW) {
            const int i = it / 1024, r = it % 1024, g = r / 256, nb = (r % 256) / 4, jq = r % 4;
            const float* wsrc = a.ev_w_out + (size_t)i * D * D + (size_t)(QDIM + 128 * g) * D + nb * 32;
            const int n = c.lane & 31, jb = jq * 64 + (c.lane >> 5) * 32;
            float accv[32];
#pragma unroll
            for (int q = 0; q < 32; ++q) accv[q] = 0.f;
            for (int lp = 0; lp < 2; ++lp) {
#pragma unroll 8
                for (int q = 0; q < 32; ++q) { const int ll = 2 * q + (c.lane >> 5); sw[ll * 32 + n] = wsrc[(size_t)(lp * 64 + ll) * D + n]; }
                LDS_WAIT(); asm volatile("" ::: "memory");
                for (int ll = 0; ll < 64; ++ll) { const float wv = sw[ll * 32 + n]; const int l = lp * 64 + ll;
#pragma unroll
                    for (int q = 0; q < 32; ++q) { const int j = jb + q; const int m = ((j & 127) * l) & 127; const float cf = (j < 128) ? ctab[m] : ctab[(m - 32) & 127]; accv[q] = fmaf(cf, wv, accv[q]); } }
                LDS_WAIT(); asm volatile("" ::: "memory");
            }
            bf16_t* dst = (bf16_t*)(ws + WS_EVOUT + i * SZ_EVOUT) + (size_t)(nb * 32 + n) * MIX_LD_EV + QDIM + g * 256 + jb;
#pragma unroll
            for (int q = 0; q < 4; ++q) { u32x4 o; o.x = pk2(accv[8 * q] * (1.f / 1024.f), accv[8 * q + 1] * (1.f / 1024.f)); o.y = pk2(accv[8 * q + 2] * (1.f / 1024.f), accv[8 * q + 3] * (1.f / 1024.f));
                o.z = pk2(accv[8 * q + 4] * (1.f / 1024.f), accv[8 * q + 5] * (1.f / 1024.f)); o.w = pk2(accv[8 * q + 6] * (1.f / 1024.f), accv[8 * q + 7] * (1.f / 1024.f)); *(GAS u32x4*)(dst + 8 * q) = o; }
        }
    }
#endif
    if (pass == 0) {
    for (int it = gw; it < (NL / 2) * 32 * 48; it += NGW) { const int i = it / (32 * 48), r = it % (32 * 48), kb = r / 48, nb = r % 48;
        const int n0 = nb * 64; const int drow = n0 < 2048 ? n0 : (n0 < 2560 ? n0 + 512 : n0 - 512);
        cvt_item(a.ev_w_in + (size_t)i * D * EV_IN, EV_IN, kb * 64, n0, (bf16_t*)(ws + WS_EVIN + i * SZ_EVIN), D, drow, nullptr, scr, c.lane); }
    constexpr int EVO_KB = MK_FFTFUSE ? 32 : 24;
    for (int it = gw; it < (NL / 2) * EVO_KB * 32; it += NGW) { const int i = it / (EVO_KB * 32), r = it % (EVO_KB * 32), kb = r / 32, nb = r % 32;
        cvt_item(a.ev_w_out + (size_t)i * D * D, D, kb * 64, nb * 64, (bf16_t*)(ws + WS_EVOUT + i * SZ_EVOUT), MIX_LD_EV, nb * 64, nullptr, scr, c.lane); }
    for (int it = gw; it < (NL / 2) * 32 * 64; it += NGW) { const int i = it / (32 * 64), r = it % (32 * 64), kb = r / 64, nb = r % 64;
        cvt_item(a.od_w_in + (size_t)i * D * OD_IN, OD_IN, kb * 64, nb * 64, (bf16_t*)(ws + WS_ODIN + i * SZ_ODIN), D, nb * 64, nullptr, scr, c.lane); }
    for (int it = gw; it < (NL / 2) * 32 * 32; it += NGW) { const int i = it / (32 * 32), r = it % (32 * 32), kb = r / 32, nb = r % 32;
        cvt_item(a.od_w_out + (size_t)i * D * D, D, kb * 64, nb * 64, (bf16_t*)(ws + WS_ODOUT + i * SZ_ODOUT), D, nb * 64, nullptr, scr, c.lane); }
    for (int it = gw; it < (NL / 2) * 4 * 4 * 4; it += NGW) { const int ig = it / 16, i = ig / 4, g = ig % 4, r = it % 16, kb = r / 4, nb = r % 4;
        cvt_item(a.od_pool_w + ((size_t)i * 4 + g) * 65536, 256, kb * 64, nb * 64, (bf16_t*)(ws + WS_POOLW + i * SZ_POOL) + g * 65536, 256, nb * 64, a.od_pool_scale + i * POOLD + g * 256, scr, c.lane); }
    }
    }
    __syncthreads();
    {
        float* par = (float*)(ws + WS_PAR); const int gt = c.vcu * NTHREADS + c.tid, NGT = c.G * NTHREADS;
        if (gt == 0) { unsigned long long* pp = (unsigned long long*)(par + PAR_PTRS); pp[0] = (unsigned long long)a.moe_w_gate; pp[1] = (unsigned long long)a.moe_w_up; pp[2] = (unsigned long long)a.moe_w_down; }
        for (int i = gt; i < 384; i += NGT) par[PAR_RELB + i] = a.rel_bias[i];
        for (int i = gt; i < (NL / 2) * NQ; i += NGT) par[PAR_SINK + i] = a.ev_sink[i];
        for (int i = gt; i < NL * D; i += NGT) { par[PAR_GMIX + i] = a.norm_mix_g[i]; par[PAR_GFFN + i] = a.norm_ffn_g[i]; }
        for (int i = gt; i < D; i += NGT) par[PAR_GFIN + i] = a.final_g[i];
        for (int i = gt; i < (NL / 2) * 3 * CONVD; i += NGT) par[PAR_CONV + i] = a.od_conv_w[i];
        for (int i = gt; i < NL * D * NE; i += NGT) { const int l = i / (D * NE), r = i % (D * NE), e = r / D, d = r % D; par[PAR_ROUTER + i] = a.moe_w_router[(size_t)l * D * NE + d * NE + e]; }
    }
    for (int m = gw; m < S; m += 2 * NGW) { const int m1 = (m + NGW) < S ? m + NGW : m;
        const GAS f32x4* xa = (const GAS f32x4*)(a.x_in + (size_t)m * D) + c.lane; const GAS f32x4* xb = (const GAS f32x4*)(a.x_in + (size_t)m1 * D) + c.lane; f32x4 va[8], vb[8];
#pragma unroll
        for (int j = 0; j < 8; ++j) { va[j] = xa[64 * j]; vb[j] = xb[64 * j]; }
        norm_store_bf16(va, a.norm_mix_g, (bf16_t*)(ws + WS_H) + (size_t)m * D, c.lane);
        if (m1 != m) norm_store_bf16(vb, a.norm_mix_g, (bf16_t*)(ws + WS_H) + (size_t)m1 * D, c.lane); }
}

__device__ __forceinline__ void attn_unit(const Args& a, const Ctx& c, int layer_i, int blk, int kvh) {
    const bf16_t* QKF = (const bf16_t*)(a.ws + WS_Z); const bf16_t* VT = (const bf16_t*)(a.ws + WS_VT); bf16_t* MIX = (bf16_t*)(a.ws + WS_MIX);
    LAS unsigned char* band = c.lds;
    LAS float* bt = (LAS float*)(c.lds + 98304);
    const float* par = (const float*)(a.ws + WS_PAR);
    const int kb0 = 128 * (blk - 1);
    bf16x8 qfa[3][4];
    { const int fr_ = c.lane & 15, fq_ = c.lane >> 4; unsigned qoff = (unsigned)(((blk * 8 + c.wave) * 16 + fr_) * QKF_LD + kvh * 3 * HD + 8 * fq_) * 2u; asm volatile("" : "+v"(qoff));
#pragma unroll
      for (int hh = 0; hh < 3; ++hh)
#pragma unroll
          for (int ks = 0; ks < 4; ++ks) qfa[hh][ks] = *(const GAS bf16x8*)((const GAS char*)QKF + (size_t)qoff + hh * HD * 2 + 64 * ks); }
    __syncthreads();
    u32x4 kreg[12];
#pragma unroll
    for (int p = 0; p < 12; ++p) { const int id = c.tid + NTHREADS * p, row = id >> 4, ch = id & 15, key = kb0 + row; const int kc = key < 0 ? 0 : (key > S - 1 ? S - 1 : key);
        kreg[p] = *(const GAS u32x4*)(QKF + (size_t)kc * QKF_LD + QDIM + kvh * HD + ch * 8); }
    for (int i = c.tid; i < 3 * 257; i += NTHREADS) { const int hh = i / 257, r = i % 257; bt[hh * 260 + r] = par[PAR_RELB + t5_bucket(r - 128) * NQ + kvh * 3 + hh] * 1.4426950408889634f; }
#pragma unroll
    for (int p = 0; p < 12; ++p) { const int id = c.tid + NTHREADS * p, row = id >> 4, ch = id & 15, key = kb0 + row;
        if (key >= 0 && key < S) *(LAS u32x4*)(band + row * 256 + ((ch ^ (row & 15)) << 4)) = kreg[p]; }
    __syncthreads();
    const int fr = c.lane & 15, fq = c.lane >> 4, w = c.wave;
    const int q0 = (blk * 8 + w) * 16;
    unsigned pw[3][9][4]; float inv[3];
#pragma unroll
    for (int hh = 0; hh < 3; ++hh) {
        const int h = kvh * 3 + hh; const float snk = par[PAR_SINK + layer_i * NQ + h] * 1.4426950408889634f;
        bf16x8 qf[4];
#pragma unroll
        for (int ks = 0; ks < 4; ++ks) qf[ks] = qfa[hh][ks];
        f32x4 s[17];
#pragma unroll
        for (int kt = 0; kt < 17; ++kt) {
            const int key0 = q0 - WIN + 16 * kt;
            f32x4 acc = (f32x4){0.f, 0.f, 0.f, 0.f};
            if (key0 >= 0 && key0 < S) {
                const LAS unsigned char* kp = band + (16 * (w + kt) + fr) * 256;
#pragma unroll
                for (int ks = 0; ks < 4; ++ks) { const bf16x8 kf = *(const LAS bf16x8*)(kp + (((4 * ks + fq) ^ fr) << 4)); acc = __builtin_amdgcn_mfma_f32_16x16x32_bf16(kf, qf[ks], acc, 0, 0, 0); }
#pragma unroll
                for (int r = 0; r < 4; ++r) { const int rel = 16 * kt - WIN + 4 * fq + r - fr;
                    if (kt == 0 || kt == 16) { const bool ok = (rel >= -WIN) && (rel <= WIN); acc[r] = ok ? acc[r] * 0.12751743082459664f + bt[hh * 260 + (ok ? rel + WIN : 0)] : -1e30f; }
                    else acc[r] = acc[r] * 0.12751743082459664f + bt[hh * 260 + rel + WIN]; }
            } else { acc = (f32x4){-1e30f, -1e30f, -1e30f, -1e30f}; }
            s[kt] = acc;
        }
        float mx = -3.0e38f;
#pragma unroll
        for (int kt = 0; kt < 17; ++kt) mx = fmaxf(mx, fmaxf(fmaxf(s[kt][0], s[kt][1]), fmaxf(s[kt][2], s[kt][3])));
        mx = fmaxf(mx, shx(mx, 16, c.lane)); mx = fmaxf(mx, shx(mx, 32, c.lane)); mx = fmaxf(mx, snk);
        float sum = 0.f;
#pragma unroll
        for (int kt = 0; kt < 17; ++kt)
#pragma unroll
            for (int r = 0; r < 4; ++r) { const float pv = __builtin_amdgcn_exp2f(s[kt][r] - mx); s[kt][r] = pv; sum += pv; }
        sum += shx(sum, 16, c.lane); sum += shx(sum, 32, c.lane);
        inv[hh] = 1.0f / (sum + __builtin_amdgcn_exp2f(snk - mx));
        if (w & 1) {
#pragma unroll
            for (int kp = 0; kp < 9; ++kp) { pw[hh][kp][0] = (kp > 0) ? cvt_pk_bf16_v(s[kp > 0 ? 2 * kp - 1 : 0][0], s[kp > 0 ? 2 * kp - 1 : 0][1]) : 0u; pw[hh][kp][1] = (kp > 0) ? cvt_pk_bf16_v(s[kp > 0 ? 2 * kp - 1 : 0][2], s[kp > 0 ? 2 * kp - 1 : 0][3]) : 0u;
                pw[hh][kp][2] = cvt_pk_bf16_v(s[2 * kp][0], s[2 * kp][1]); pw[hh][kp][3] = cvt_pk_bf16_v(s[2 * kp][2], s[2 * kp][3]); }
        } else {
#pragma unroll
            for (int kp = 0; kp < 9; ++kp) { pw[hh][kp][0] = cvt_pk_bf16_v(s[2 * kp][0], s[2 * kp][1]); pw[hh][kp][1] = cvt_pk_bf16_v(s[2 * kp][2], s[2 * kp][3]);
                pw[hh][kp][2] = (kp < 8) ? cvt_pk_bf16_v(s[kp < 8 ? 2 * kp + 1 : 16][0], s[kp < 8 ? 2 * kp + 1 : 16][1]) : 0u; pw[hh][kp][3] = (kp < 8) ? cvt_pk_bf16_v(s[kp < 8 ? 2 * kp + 1 : 16][2], s[kp < 8 ? 2 * kp + 1 : 16][3]) : 0u; }
        }
        __builtin_amdgcn_sched_barrier(0);
    }
    __syncthreads();
#pragma unroll
    for (int p = 0; p < 12; ++p) { const int id = c.tid + NTHREADS * p, d = id / 48, pc = id % 48, b = pc >> 2, m = pc & 3, key = kb0 + 32 * b + 8 * m;
        u32x4 v = (u32x4){0u, 0u, 0u, 0u};
        if (key >= 0 && key < S) v = *(const GAS u32x4*)(VT + (size_t)(kvh * HD + d) * S + key);
        const int c0 = 4 * b + 2 * (m & 1), t = m >> 1; LAS unsigned char* rowp = band + d * 768;
        u32x2 lo; lo.x = v.x; lo.y = v.y; u32x2 hi; hi.x = v.z; hi.y = v.w;
        *(LAS u32x2*)(rowp + ((((c0 >> 4) << 4) + ((c0 & 15) ^ (d & 15))) << 4) + 8 * t) = lo;
        *(LAS u32x2*)(rowp + (((((c0 + 1) >> 4) << 4) + (((c0 + 1) & 15) ^ (d & 15))) << 4) + 8 * t) = hi; }
    __syncthreads();
#if MK_PV3
    {
        f32x4 o[3][8];
#pragma unroll
        for (int hh = 0; hh < 3; ++hh)
#pragma unroll
            for (int dt = 0; dt < 8; ++dt) o[hh][dt] = (f32x4){0.f, 0.f, 0.f, 0.f};
#pragma unroll
        for (int kp = 0; kp < 9; ++kp) {
            bf16x8 pf[3];
#pragma unroll
            for (int hh = 0; hh < 3; ++hh) { u32x4 pq; pq.x = pw[hh][kp][0]; pq.y = pw[hh][kp][1]; pq.z = pw[hh][kp][2]; pq.w = pw[hh][kp][3]; pf[hh] = __builtin_bit_cast(bf16x8, pq); }
            const int cc = 4 * ((w >> 1) + kp) + fq;
            const int poff = (((cc >> 4) << 4) + ((cc & 15) ^ fr)) << 4;
#pragma unroll
            for (int dt = 0; dt < 8; ++dt) { const bf16x8 vf = *(const LAS bf16x8*)(band + (16 * dt + fr) * 768 + poff);
#pragma unroll
                for (int hh = 0; hh < 3; ++hh) o[hh][dt] = __builtin_amdgcn_mfma_f32_16x16x32_bf16(vf, pf[hh], o[hh][dt], 0, 0, 0); }
        }
#pragma unroll
        for (int hh = 0; hh < 3; ++hh) { const int h = kvh * 3 + hh;
            unsigned ooff = (unsigned)((q0 + fr) * MIX_LD_EV + h * HD + 4 * fq) * 2u; asm volatile("" : "+v"(ooff));
            const float iv = inv[hh];
#pragma unroll
            for (int dt = 0; dt < 8; ++dt) { u32x2 wv; wv.x = cvt_pk_bf16(o[hh][dt][0] * iv, o[hh][dt][1] * iv); wv.y = cvt_pk_bf16(o[hh][dt][2] * iv, o[hh][dt][3] * iv); *(GAS u32x2*)((GAS char*)MIX + (size_t)ooff + 32 * dt) = wv; } }
    }
#else
#pragma unroll
    for (int hh = 0; hh < 3; ++hh) {
        const int h = kvh * 3 + hh;
        f32x4 o[8];
#pragma unroll
        for (int dt = 0; dt < 8; ++dt) o[dt] = (f32x4){0.f, 0.f, 0.f, 0.f};
#pragma unroll
        for (int kp = 0; kp < 9; ++kp) {
            u32x4 pq; pq.x = pw[hh][kp][0]; pq.y = pw[hh][kp][1]; pq.z = pw[hh][kp][2]; pq.w = pw[hh][kp][3];
            const bf16x8 pf = __builtin_bit_cast(bf16x8, pq);
            const int cc = 4 * ((w >> 1) + kp) + fq;
            const int poff = (((cc >> 4) << 4) + ((cc & 15) ^ fr)) << 4;
#pragma unroll
            for (int dt = 0; dt < 8; ++dt) { const bf16x8 vf = *(const LAS bf16x8*)(band + (16 * dt + fr) * 768 + poff);
                o[dt] = __builtin_amdgcn_mfma_f32_16x16x32_bf16(vf, pf, o[dt], 0, 0, 0); }
        }
        unsigned ooff = (unsigned)((q0 + fr) * MIX_LD_EV + h * HD + 4 * fq) * 2u; asm volatile("" : "+v"(ooff));
        const float iv = inv[hh];
#pragma unroll
        for (int dt = 0; dt < 8; ++dt) { u32x2 wv; wv.x = cvt_pk_bf16(o[dt][0] * iv, o[dt][1] * iv); wv.y = cvt_pk_bf16(o[dt][2] * iv, o[dt][3] * iv); *(GAS u32x2*)((GAS char*)MIX + (size_t)ooff + 32 * dt) = wv; }
    }
#endif
}

typedef short v4i16_t __attribute__((ext_vector_type(4)));
__device__ __forceinline__ s16x4 tr_read(const LAS unsigned char* p) { return __builtin_bit_cast(s16x4, __builtin_amdgcn_ds_read_tr16_b64_v4i16((LAS v4i16_t*)p)); }

constexpr int XS = 544;
__device__ __forceinline__ void ffta_unit(const Args& a, const Ctx& c, int g, int sb) {
    const bf16_t* F = (const bf16_t*)(a.ws + WS_Z) + QDIM + KVDIM + g * 128;
    bf16_t* TB = (bf16_t*)(a.ws + WS_TB);
    LAS unsigned char* X = c.lds;
    __syncthreads();
#pragma unroll
    for (int p = 0; p < 4; ++p) { const int id = c.tid + NTHREADS * p, s1 = id >> 5, ch = id & 31, ds2 = ch >> 4, c8 = (ch & 15) * 8;
        const u32x4 v = *(const GAS u32x4*)(F + (size_t)(128 * s1 + 2 * sb + ds2) * QKF_LD + c8);
        *(LAS u32x4*)(X + s1 * XS + (ds2 * 128 + c8) * 2) = v; }
    __syncthreads();
    const int fr = c.lane & 15, fq = c.lane >> 4, w = c.wave;
    bf16x8 af[2][2];
#pragma unroll
    for (int mt = 0; mt < 2; ++mt)
#pragma unroll
        for (int ks = 0; ks < 2; ++ks) {
            const LAS unsigned char* ap = X + (32 * ks + 4 * fq + (fr >> 2)) * XS + (32 * w + 16 * mt + 4 * (fr & 3)) * 2;
            const s16x4 t0 = tr_read(ap), t1 = tr_read(ap + 16 * XS);
            bf16x8 f; f[0] = t0[0]; f[1] = t0[1]; f[2] = t0[2]; f[3] = t0[3]; f[4] = t1[0]; f[5] = t1[1]; f[6] = t1[2]; f[7] = t1[3]; af[mt][ks] = f; }
    f32x4 acc[2][4][2];
#pragma unroll
    for (int jp = 0; jp < 4; ++jp) {
        bf16x8 bfr[2][2];
#pragma unroll
        for (int ks = 0; ks < 2; ++ks) { const GAS u32x4* ft = (const GAS u32x4*)(a.ws + WS_FTA) + ((jp * 2 + ks) * 2) * 64 + c.lane;
            bfr[0][ks] = __builtin_bit_cast(bf16x8, ft[0]); bfr[1][ks] = __builtin_bit_cast(bf16x8, ft[64]); }
#pragma unroll
        for (int mt = 0; mt < 2; ++mt) { f32x4 ar = (f32x4){0.f, 0.f, 0.f, 0.f}, ai = (f32x4){0.f, 0.f, 0.f, 0.f};
#pragma unroll
            for (int ks = 0; ks < 2; ++ks) { ar = __builtin_amdgcn_mfma_f32_16x16x32_bf16(af[mt][ks], bfr[0][ks], ar, 0, 0, 0); ai = __builtin_amdgcn_mfma_f32_16x16x32_bf16(af[mt][ks], bfr[1][ks], ai, 0, 0, 0); }
            acc[mt][jp][0] = ar; acc[mt][jp][1] = ai; }
        __builtin_amdgcn_sched_barrier(0);
    }
    const int s2 = 2 * sb + (w >> 2);
#pragma unroll
    for (int jp = 0; jp < 4; ++jp) { const int k1 = 16 * jp + fr; float sn, cs; sincospif((float)(s2 * k1) * (1.0f / 4096.0f), &sn, &cs);
#pragma unroll
        for (int mt = 0; mt < 2; ++mt) { const f32x4 re = acc[mt][jp][0], im = acc[mt][jp][1]; const int cc = 32 * (w & 3) + 16 * mt + 4 * fq;
            u32x2 tr, ti; tr.x = cvt_pk_bf16(re[0] * cs + im[0] * sn, re[1] * cs + im[1] * sn); tr.y = cvt_pk_bf16(re[2] * cs + im[2] * sn, re[3] * cs + im[3] * sn);
            ti.x = cvt_pk_bf16(im[0] * cs - re[0] * sn, im[1] * cs - re[1] * sn); ti.y = cvt_pk_bf16(im[2] * cs - re[2] * sn, im[3] * cs - re[3] * sn);
            bf16_t* tp = TB + ((size_t)((k1 * 4 + g) * 2) * 128 + s2) * 128 + cc;
            *(GAS u32x2*)tp = tr; *(GAS u32x2*)(tp + 128 * 128) = ti; } }
}

constexpr int TS = 288;
#if MK_FFTFUSE
__device__ __forceinline__ void fftc_unit(const Args& a, const Ctx& c, int k1, int g) {
    const bf16_t* T = (const bf16_t*)(a.ws + WS_TB) + (size_t)((k1 * 4 + g) * 2) * 128 * 128; bf16_t* MIX = (bf16_t*)(a.ws + WS_MIX);
    LAS unsigned char* X = c.lds;
    constexpr int CO_LO = 256 * 288, CO_HI = RING_BYTES + 1024 + 8192;
    __syncthreads();
    u32x4 bft[8][2];
    { const GAS u32x4* ft = (const GAS u32x4*)(a.ws + WS_FTC) + (size_t)(c.wave * 16) * 64 + c.lane;
#pragma unroll
      for (int q = 0; q < 16; ++q) bft[q >> 1][q & 1] = ft[q * 64]; }
#pragma unroll
    for (int p = 0; p < 8; ++p) { const int id = c.tid + NTHREADS * p, row = id >> 4, ch = id & 15; *(LAS u32x4*)(X + row * TS + ch * 16) = *(const GAS u32x4*)(T + (size_t)row * 128 + ch * 8); }
#pragma unroll
    for (int p = 0; p < 8; ++p) { const int f = (c.tid >> 6) + 8 * p; const u32x4 v = ((const GAS u32x4*)(a.ws + WS_FCO))[f * 64 + (c.tid & 63)];
        *(LAS u32x4*)(c.lds + (p < 7 ? CO_LO + f * 1024 : CO_HI + (f - 56) * 1024) + (c.tid & 63) * 16) = v; }
    __syncthreads();
    const int fr = c.lane & 15, fq = c.lane >> 4, w = c.wave;
    f32x4 acc[8][2];
#pragma unroll
    for (int mt = 0; mt < 8; ++mt) { acc[mt][0] = (f32x4){0.f, 0.f, 0.f, 0.f}; acc[mt][1] = (f32x4){0.f, 0.f, 0.f, 0.f}; }
#pragma unroll
    for (int ks = 0; ks < 8; ++ks) {
        bf16x8 bf[2]; bf[0] = __builtin_bit_cast(bf16x8, bft[ks][0]); bf[1] = __builtin_bit_cast(bf16x8, bft[ks][1]);
#pragma unroll
        for (int mt = 0; mt < 8; ++mt) {
            const LAS unsigned char* ap = X + (32 * ks + 4 * fq + (fr >> 2)) * TS + (16 * mt + 4 * (fr & 3)) * 2;
            const s16x4 t0 = tr_read(ap), t1 = tr_read(ap + 16 * TS);
            bf16x8 af; af[0] = t0[0]; af[1] = t0[1]; af[2] = t0[2]; af[3] = t0[3]; af[4] = t1[0]; af[5] = t1[1]; af[6] = t1[2]; af[7] = t1[3];
            acc[mt][0] = __builtin_amdgcn_mfma_f32_16x16x32_bf16(af, bf[0], acc[mt][0], 0, 0, 0);
            acc[mt][1] = __builtin_amdgcn_mfma_f32_16x16x32_bf16(af, bf[1], acc[mt][1], 0, 0, 0);
        }
        __builtin_amdgcn_sched_barrier(0);
    }
    bf16x8 pb[4][2];
#pragma unroll
    for (int kap = 0; kap < 4; ++kap)
#pragma unroll
        for (int pl = 0; pl < 2; ++pl) { u32x4 q; q.x = cvt_pk_bf16(acc[2 * kap][pl][0], acc[2 * kap][pl][1]); q.y = cvt_pk_bf16(acc[2 * kap][pl][2], acc[2 * kap][pl][3]);
            q.z = cvt_pk_bf16(acc[2 * kap + 1][pl][0], acc[2 * kap + 1][pl][1]); q.w = cvt_pk_bf16(acc[2 * kap + 1][pl][2], acc[2 * kap + 1][pl][3]); pb[kap][pl] = __builtin_bit_cast(bf16x8, q); }
    bf16_t* op = MIX + (size_t)(k1 + 64 * (16 * w + fr)) * MIX_LD_EV + QDIM + g * 128 + 4 * fq;
#pragma unroll
    for (int lt = 0; lt < 8; ++lt) { f32x4 o = (f32x4){0.f, 0.f, 0.f, 0.f};
#pragma unroll
        for (int kap = 0; kap < 4; ++kap)
#pragma unroll
            for (int pl = 0; pl < 2; ++pl) { const int f = (lt * 4 + kap) * 2 + pl; const bf16x8 cf = *(const LAS bf16x8*)(c.lds + (f < 56 ? CO_LO + f * 1024 : CO_HI + (f - 56) * 1024) + c.lane * 16);
                o = __builtin_amdgcn_mfma_f32_16x16x32_bf16(cf, pb[kap][pl], o, 0, 0, 0); }
        u32x2 ov; ov.x = cvt_pk_bf16(o[0], o[1]); ov.y = cvt_pk_bf16(o[2], o[3]); *(GAS u32x2*)(op + 16 * lt) = ov; }
}
#else
__device__ __forceinline__ void fftc_unit(const Args& a, const Ctx& c, int k1, int g) {
    const bf16_t* T = (const bf16_t*)(a.ws + WS_TB) + (size_t)((k1 * 4 + g) * 2) * 128 * 128; bf16_t* MIX = (bf16_t*)(a.ws + WS_MIX);
    LAS unsigned char* X = c.lds;
    __syncthreads();
    u32x4 bft[8][2];
    { const GAS u32x4* ft = (const GAS u32x4*)(a.ws + WS_FTC) + (size_t)(c.wave * 16) * 64 + c.lane;
#pragma unroll
      for (int q = 0; q < 16; ++q) bft[q >> 1][q & 1] = ft[q * 64]; }
#pragma unroll
    for (int p = 0; p < 8; ++p) { const int id = c.tid + NTHREADS * p, row = id >> 4, ch = id & 15; *(LAS u32x4*)(X + row * TS + ch * 16) = *(const GAS u32x4*)(T + (size_t)row * 128 + ch * 8); }
    __syncthreads();
    const int fr = c.lane & 15, fq = c.lane >> 4, w = c.wave, pq = w >> 2;
    f32x4 acc[8][2];
#pragma unroll
    for (int mt = 0; mt < 8; ++mt) { acc[mt][0] = (f32x4){0.f, 0.f, 0.f, 0.f}; acc[mt][1] = (f32x4){0.f, 0.f, 0.f, 0.f}; }
#pragma unroll
    for (int ks = 0; ks < 8; ++ks) {
        bf16x8 bf[2]; bf[0] = __builtin_bit_cast(bf16x8, bft[ks][0]); bf[1] = __builtin_bit_cast(bf16x8, bft[ks][1]);
#pragma unroll
        for (int mt = 0; mt < 8; ++mt) {
            const LAS unsigned char* ap = X + (32 * ks + 4 * fq + (fr >> 2)) * TS + (16 * mt + 4 * (fr & 3)) * 2;
            const s16x4 t0 = tr_read(ap), t1 = tr_read(ap + 16 * TS);
            bf16x8 af; af[0] = t0[0]; af[1] = t0[1]; af[2] = t0[2]; af[3] = t0[3]; af[4] = t1[0]; af[5] = t1[1]; af[6] = t1[2]; af[7] = t1[3];
            acc[mt][0] = __builtin_amdgcn_mfma_f32_16x16x32_bf16(af, bf[0], acc[mt][0], 0, 0, 0);
            acc[mt][1] = __builtin_amdgcn_mfma_f32_16x16x32_bf16(af, bf[1], acc[mt][1], 0, 0, 0);
        }
        __builtin_amdgcn_sched_barrier(0);
    }
#pragma unroll
    for (int t = 0; t < 2; ++t) { const int k2 = 32 * (w & 3) + 16 * t + fr; bf16_t* op = MIX + (size_t)(k1 + 64 * k2) * MIX_LD_EV + QDIM + g * 256 + pq * 128 + 4 * fq;
#pragma unroll
        for (int mt = 0; mt < 8; ++mt) { u32x2 o; o.x = cvt_pk_bf16(acc[mt][t][0], acc[mt][t][1]); o.y = cvt_pk_bf16(acc[mt][t][2], acc[mt][t][3]); *(GAS u32x2*)(op + 16 * mt) = o; } }
}
#endif

__device__ __forceinline__ void bf8_to_f32(const u32x4 w, float (&f)[8]) { f[0] = bf_lo(w.x); f[1] = bf_hi(w.x); f[2] = bf_lo(w.y); f[3] = bf_hi(w.y); f[4] = bf_lo(w.z); f[5] = bf_hi(w.z); f[6] = bf_lo(w.w); f[7] = bf_hi(w.w); }
__device__ __forceinline__ void oddmix_unit(const Args& a, const Ctx& c, int layer_i, int unit) {
    const bf16_t* Z = (const bf16_t*)(a.ws + WS_Z); bf16_t* MIX = (bf16_t*)(a.ws + WS_MIX); bf16_t* PO = (bf16_t*)(a.ws + WS_POOLED);
    if (c.wave < 4) {
        const int t0 = unit * 32 + (c.wave >> 1) * 16, ch = ((c.wave & 1) * 64 + c.lane) * 8;
        const float* cw = (const float*)(a.ws + WS_PAR) + PAR_CONV + layer_i * 3 * CONVD + ch;
        float w0[8], w1[8], w2[8];
#pragma unroll
        for (int q = 0; q < 8; ++q) { w0[q] = cw[q]; w1[q] = cw[CONVD + q]; w2[q] = cw[2 * CONVD + q]; }
        float pm[8], pc[8], pn[8], fa[8], fb[8];
#pragma unroll
        for (int q = 0; q < 8; ++q) pm[q] = 0.f;
        if (t0 > 0) { bf8_to_f32(*(const GAS u32x4*)(Z + (size_t)(t0 - 1) * OD_IN + CONVD + ch), fa); bf8_to_f32(*(const GAS u32x4*)(Z + (size_t)(t0 - 1) * OD_IN + 2 * CONVD + ch), fb);
#pragma unroll
            for (int q = 0; q < 8; ++q) pm[q] = fa[q] * fb[q]; }
        bf8_to_f32(*(const GAS u32x4*)(Z + (size_t)t0 * OD_IN + CONVD + ch), fa); bf8_to_f32(*(const GAS u32x4*)(Z + (size_t)t0 * OD_IN + 2 * CONVD + ch), fb);
#pragma unroll
        for (int q = 0; q < 8; ++q) pc[q] = fa[q] * fb[q];
#pragma unroll 4
        for (int t = t0; t < t0 + 16; ++t) {
#pragma unroll
            for (int q = 0; q < 8; ++q) pn[q] = 0.f;
            if (t + 1 < S) { bf8_to_f32(*(const GAS u32x4*)(Z + (size_t)(t + 1) * OD_IN + CONVD + ch), fa); bf8_to_f32(*(const GAS u32x4*)(Z + (size_t)(t + 1) * OD_IN + 2 * CONVD + ch), fb);
#pragma unroll
                for (int q = 0; q < 8; ++q) pn[q] = fa[q] * fb[q]; }
            bf8_to_f32(*(const GAS u32x4*)(Z + (size_t)t * OD_IN + ch), fa);
            float o[8];
#pragma unroll
            for (int q = 0; q < 8; ++q) { o[q] = fa[q] * (w0[q] * pm[q] + w1[q] * pc[q] + w2[q] * pn[q]); pm[q] = pc[q]; pc[q] = pn[q]; }
            u32x4 ov; ov.x = pk2(o[0], o[1]); ov.y = pk2(o[2], o[3]); ov.z = pk2(o[4], o[5]); ov.w = pk2(o[6], o[7]);
            *(GAS u32x4*)(MIX + (size_t)t * D + ch) = ov;
        }
    } else {
        const int g = c.wave - 4, lo = 1 << g, hi = lo - 1;
        const int t0 = unit * 32 + (c.lane >> 5) * 16, ch = g * 256 + (c.lane & 31) * 8;
        const bf16_t* zp = Z + 3 * CONVD + ch;
        float sm[8], fa[8];
#pragma unroll
        for (int q = 0; q < 8; ++q) sm[q] = 0.f;
        for (int tt = t0 - lo; tt <= t0 + hi; ++tt) if (tt >= 0 && tt < S) { bf8_to_f32(*(const GAS u32x4*)(zp + (size_t)tt * OD_IN), fa);
#pragma unroll
            for (int q = 0; q < 8; ++q) sm[q] += fa[q]; }
#pragma unroll 2
        for (int t = t0; t < t0 + 16; ++t) {
            const int aa = t - lo < 0 ? 0 : t - lo, bb = t + hi > S - 1 ? S - 1 : t + hi; const float rc = 1.0f / (float)(bb - aa + 1);
            bf8_to_f32(*(const GAS u32x4*)(zp + (size_t)t * OD_IN), fa);
            u32x4 ov; ov.x = pk2(sm[0] * rc - fa[0], sm[1] * rc - fa[1]); ov.y = pk2(sm[2] * rc - fa[2], sm[3] * rc - fa[3]); ov.z = pk2(sm[4] * rc - fa[4], sm[5] * rc - fa[5]); ov.w = pk2(sm[6] * rc - fa[6], sm[7] * rc - fa[7]);
            { const int tok = t - unit * 32; *(LAS u32x4*)(c.lds + tok * 2048 + ((((ch >> 3) & ~15) | (((ch >> 3) & 15) ^ (tok & 15))) << 4)) = ov; }
            if (t + 1 + hi < S) { bf8_to_f32(*(const GAS u32x4*)(zp + (size_t)(t + 1 + hi) * OD_IN), fa);
#pragma unroll
                for (int q = 0; q < 8; ++q) sm[q] += fa[q]; }
            if (t - lo >= 0) { bf8_to_f32(*(const GAS u32x4*)(zp + (size_t)(t - lo) * OD_IN), fa);
#pragma unroll
                for (int q = 0; q < 8; ++q) sm[q] -= fa[q]; }
        }
    }
    __syncthreads();
    {
        const int fr = c.lane & 15, fq = c.lane >> 4, g = c.wave >> 1, mt0 = 8 * (c.wave & 1);
        const bf16_t* Wp = (const bf16_t*)(a.ws + WS_POOLW + layer_i * SZ_POOL) + (size_t)g * 65536;
        bf16x8 bfr[2][8];
#pragma unroll
        for (int nt = 0; nt < 2; ++nt)
#pragma unroll
            for (int ks = 0; ks < 8; ++ks) { const int tok = 16 * nt + fr, c16 = g * 32 + 4 * ks + fq; bfr[nt][ks] = *(const LAS bf16x8*)(c.lds + tok * 2048 + (((c16 & ~15) | ((c16 & 15) ^ fr)) << 4)); }
        unsigned woff = (unsigned)((16 * mt0 + fr) * 256 + 8 * fq) * 2u; asm volatile("" : "+v"(woff));
        bf16x8 af[8], an[8];
#pragma unroll
        for (int ks = 0; ks < 8; ++ks) af[ks] = *(const GAS bf16x8*)((const GAS char*)Wp + (size_t)woff + 64 * ks);
#pragma unroll 1
        for (int mi = 0; mi < 8; ++mi) {
            if (mi + 1 < 8) {
#pragma unroll
                for (int ks = 0; ks < 8; ++ks) an[ks] = *(const GAS bf16x8*)((const GAS char*)Wp + (size_t)woff + (size_t)(mi + 1) * (16 * 256 * 2) + 64 * ks); }
            f32x4 acc0 = (f32x4){0.f, 0.f, 0.f, 0.f}, acc1 = (f32x4){0.f, 0.f, 0.f, 0.f};
#pragma unroll
            for (int ks = 0; ks < 8; ++ks) { acc0 = __builtin_amdgcn_mfma_f32_16x16x32_bf16(af[ks], bfr[0][ks], acc0, 0, 0, 0); acc1 = __builtin_amdgcn_mfma_f32_16x16x32_bf16(af[ks], bfr[1][ks], acc1, 0, 0, 0); }
            const int dcol = CONVD + g * 256 + 16 * (mt0 + mi) + 4 * fq;
            u32x2 o0; o0.x = cvt_pk_bf16(acc0[0], acc0[1]); o0.y = cvt_pk_bf16(acc0[2], acc0[3]); *(GAS u32x2*)(MIX + (size_t)(unit * 32 + fr) * D + dcol) = o0;
            u32x2 o1; o1.x = cvt_pk_bf16(acc1[0], acc1[1]); o1.y = cvt_pk_bf16(acc1[2], acc1[3]); *(GAS u32x2*)(MIX + (size_t)(unit * 32 + 16 + fr) * D + dcol) = o1;
#pragma unroll
            for (int ks = 0; ks < 8; ++ks) af[ks] = an[ks];
        }
    }
    __syncthreads();
}

template <int G>
__device__ __forceinline__ void oddmix_pool(const bf16_t* zp, int t0, int ltok, int cl, LAS unsigned char* lds) {
    constexpr int LO = 1 << G, HI = LO - 1, W = 2 * LO, NR = 8 + W - 1;
    u32x4 rw[NR];
    const bf16_t* zb = zp + (size_t)t0 * OD_IN;
#pragma unroll
    for (int r = 0; r < NR; ++r) { const int tt = t0 - LO + r; const int d = (tt >= 0 && tt < S) ? (r - LO) * OD_IN : 0; rw[r] = *(const GAS u32x4*)(zb + d); }
    float sm[8], fa[8];
#pragma unroll
    for (int q = 0; q < 8; ++q) sm[q] = 0.f;
#pragma unroll
    for (int r = 0; r < W; ++r) { const int tt = t0 - LO + r; if (tt >= 0 && tt < S) { bf8_to_f32(rw[r], fa);
#pragma unroll
        for (int q = 0; q < 8; ++q) sm[q] += fa[q]; } }
#pragma unroll
    for (int i = 0; i < 8; ++i) { const int t = t0 + i;
        const int aa = t - LO < 0 ? 0 : t - LO, bb = t + HI > S - 1 ? S - 1 : t + HI; const float rc = 1.0f / (float)(bb - aa + 1);
        bf8_to_f32(rw[i + LO], fa);
        u32x4 ov; ov.x = pk2(sm[0] * rc - fa[0], sm[1] * rc - fa[1]); ov.y = pk2(sm[2] * rc - fa[2], sm[3] * rc - fa[3]); ov.z = pk2(sm[4] * rc - fa[4], sm[5] * rc - fa[5]); ov.w = pk2(sm[6] * rc - fa[6], sm[7] * rc - fa[7]);
        { const int tok = ltok + i; *(LAS u32x4*)(lds + tok * 512 + (((cl & ~15) | ((cl & 15) ^ (tok & 15))) << 4)) = ov; }
        if (i < 7) {
            if (t + 1 + HI < S) { bf8_to_f32(rw[i + W], fa);
#pragma unroll
                for (int q = 0; q < 8; ++q) sm[q] += fa[q]; }
            if (t - LO >= 0) { bf8_to_f32(rw[i], fa);
#pragma unroll
                for (int q = 0; q < 8; ++q) sm[q] -= fa[q]; } }
    }
}
__device__ __forceinline__ void oddmix_unit2(const Args& a, const Ctx& c, int layer_i, int unit) {
    const bf16_t* Z = (const bf16_t*)(a.ws + WS_Z); bf16_t* MIX = (bf16_t*)(a.ws + WS_MIX);
    const int tb = unit >> 2, g = unit & 3;
    const int tg = c.tid >> 5, cl = c.tid & 31;
    const int t0 = tb * 128 + tg * 8, ch = g * 256 + cl * 8;
    {
        u32x4 ra[10], rb[10], rg[8];
        const bf16_t* zb = Z + (size_t)t0 * OD_IN + ch;
#pragma unroll
        for (int r = 0; r < 10; ++r) { const int tt = t0 - 1 + r; const int d = (tt >= 0 && tt < S) ? (r - 1) * OD_IN : 0;
            ra[r] = *(const GAS u32x4*)(zb + d + CONVD); rb[r] = *(const GAS u32x4*)(zb + d + 2 * CONVD); }
#pragma unroll
        for (int r = 0; r < 8; ++r) rg[r] = *(const GAS u32x4*)(zb + r * OD_IN);
        const float* cw = (const float*)(a.ws + WS_PAR) + PAR_CONV + layer_i * 3 * CONVD + ch;
        float w0[8], w1[8], w2[8];
#pragma unroll
        for (int q = 0; q < 8; ++q) { w0[q] = cw[q]; w1[q] = cw[CONVD + q]; w2[q] = cw[2 * CONVD + q]; }
        float pm[8], pc[8], pn[8], fa[8], fb[8];
        { bf8_to_f32(ra[0], fa); bf8_to_f32(rb[0], fb); const float v = (t0 - 1 >= 0) ? 1.f : 0.f;
#pragma unroll
          for (int q = 0; q < 8; ++q) pm[q] = fa[q] * fb[q] * v; }
        { bf8_to_f32(ra[1], fa); bf8_to_f32(rb[1], fb);
#pragma unroll
          for (int q = 0; q < 8; ++q) pc[q] = fa[q] * fb[q]; }
#pragma unroll
        for (int i = 0; i < 8; ++i) { const int t = t0 + i;
            bf8_to_f32(ra[i + 2], fa); bf8_to_f32(rb[i + 2], fb); const float v = (t + 1 < S) ? 1.f : 0.f;
#pragma unroll
            for (int q = 0; q < 8; ++q) pn[q] = fa[q] * fb[q] * v;
            bf8_to_f32(rg[i], fa);
            float o[8];
#pragma unroll
            for (int q = 0; q < 8; ++q) { o[q] = fa[q] * (w0[q] * pm[q] + w1[q] * pc[q] + w2[q] * pn[q]); pm[q] = pc[q]; pc[q] = pn[q]; }
            u32x4 ov; ov.x = pk2(o[0], o[1]); ov.y = pk2(o[2], o[3]); ov.z = pk2(o[4], o[5]); ov.w = pk2(o[6], o[7]);
            *(GAS u32x4*)(MIX + (size_t)t * D + ch) = ov; }
    }
    const int fr = c.lane & 15, fq = c.lane >> 4;
    const bf16_t* Wp = (const bf16_t*)(a.ws + WS_POOLW + layer_i * SZ_POOL) + (size_t)g * 65536 + (size_t)(32 * c.wave + fr) * 256 + 8 * fq;
    bf16x8 wf[2][8];
#pragma unroll
    for (int mt = 0; mt < 2; ++mt)
#pragma unroll
        for (int ks = 0; ks < 8; ++ks) wf[mt][ks] = *(const GAS bf16x8*)(Wp + mt * 16 * 256 + 32 * ks);
    { int t0p = t0; asm volatile("" : "+v"(t0p)); const bf16_t* zp = Z + 3 * CONVD + ch;
      if (g == 0) oddmix_pool<0>(zp, t0p, tg * 8, cl, c.lds); else if (g == 1) oddmix_pool<1>(zp, t0p, tg * 8, cl, c.lds); else if (g == 2) oddmix_pool<2>(zp, t0p, tg * 8, cl, c.lds); else oddmix_pool<3>(zp, t0p, tg * 8, cl, c.lds); }
    __syncthreads();
#pragma unroll
    for (int nt = 0; nt < 8; ++nt) {
        bf16x8 bfr[8];
#pragma unroll
        for (int ks = 0; ks < 8; ++ks) { const int tok = 16 * nt + fr, c16 = 4 * ks + fq; bfr[ks] = *(const LAS bf16x8*)(c.lds + tok * 512 + (((c16 & ~15) | ((c16 & 15) ^ fr)) << 4)); }
        f32x4 acc0 = (f32x4){0.f, 0.f, 0.f, 0.f}, acc1 = (f32x4){0.f, 0.f, 0.f, 0.f};
#pragma unroll
        for (int ks = 0; ks < 8; ++ks) { acc0 = __builtin_amdgcn_mfma_f32_16x16x32_bf16(wf[0][ks], bfr[ks], acc0, 0, 0, 0); acc1 = __builtin_amdgcn_mfma_f32_16x16x32_bf16(wf[1][ks], bfr[ks], acc1, 0, 0, 0); }
        bf16_t* op = MIX + (size_t)(tb * 128 + 16 * nt + fr) * D + CONVD + g * 256 + 32 * c.wave + 4 * fq;
        u32x2 o0; o0.x = cvt_pk_bf16(acc0[0], acc0[1]); o0.y = cvt_pk_bf16(acc0[2], acc0[3]); *(GAS u32x2*)op = o0;
        u32x2 o1; o1.x = cvt_pk_bf16(acc1[0], acc1[1]); o1.y = cvt_pk_bf16(acc1[2], acc1[3]); *(GAS u32x2*)(op + 16) = o1;
    }
    __syncthreads();
}

__device__ __forceinline__ void norm_router_stage(const Args& a, const Ctx& c, int layer) {
    LAS float* wT = (LAS float*)c.lds; const float* par = (const float*)(a.ws + WS_PAR); const float* wr = par + PAR_ROUTER + (size_t)layer * D * NE;
    __syncthreads();
    for (int i = c.tid; i < D * NE / 4; i += NTHREADS) ((LAS f32x4*)wT)[i] = ((const GAS f32x4*)wr)[i];
    LAS f32x4* gl = (LAS f32x4*)(c.lds + RING_BYTES + 1024);
    c.tid < D / 4 ? (void)(gl[c.tid] = ((const GAS f32x4*)(par + PAR_GFFN + (size_t)layer * D))[c.tid]) : (void)0;
    __syncthreads();
}
__device__ __forceinline__ void norm_router_phase(const Args& a, const Ctx& c, int layer, bool staged = false) {
    LAS float* wT = (LAS float*)c.lds;
    const float* par = (const float*)(a.ws + WS_PAR); const float* wr = par + PAR_ROUTER + (size_t)layer * D * NE;
    int gw = c.vcu * NWAVES + c.wave; asm volatile("" : "+s"(gw));
    const int NGW = c.G * NWAVES, lane = c.lane;
    float* AFF = (float*)(a.ws + WS_AFF); bf16_t* H = (bf16_t*)(a.ws + WS_H);
    f32x4 n0[8], n1[8];
    { const int mb = (gw + NGW) < S ? gw + NGW : gw;
#pragma unroll
        for (int j = 0; j < 8; ++j) { n0[j] = ((const GAS f32x4*)(a.X + (size_t)gw * D))[lane + 64 * j]; n1[j] = ((const GAS f32x4*)(a.X + (size_t)mb * D))[lane + 64 * j]; } }
    LAS f32x4* gl = (LAS f32x4*)(c.lds + RING_BYTES + 1024);
    if (!staged) {
    __syncthreads();
    for (int i = c.tid; i < D * NE / 4; i += NTHREADS) ((LAS f32x4*)wT)[i] = ((const GAS f32x4*)wr)[i];
    c.tid < D / 4 ? (void)(gl[c.tid] = ((const GAS f32x4*)(par + PAR_GFFN + (size_t)layer * D))[c.tid]) : (void)0;
    }
    __syncthreads();
    for (int m = gw; m < S; m += 2 * NGW) {
        const bool two = (m + NGW) < S; const int m1 = two ? m + NGW : m;
        f32x4 v0[8], v1[8]; float ss0 = 0.f, ss1 = 0.f;
#pragma unroll
        for (int j = 0; j < 8; ++j) { v0[j] = n0[j]; v1[j] = n1[j]; }
        if (m + 2 * NGW < S) { const int ma = m + 2 * NGW, mb = (ma + NGW) < S ? ma + NGW : ma;
#pragma unroll
            for (int j = 0; j < 8; ++j) { n0[j] = ((const GAS f32x4*)(a.X + (size_t)ma * D))[lane + 64 * j]; n1[j] = ((const GAS f32x4*)(a.X + (size_t)mb * D))[lane + 64 * j]; } }
#pragma unroll
        for (int j = 0; j < 8; ++j) { ss0 += (v0[j].x * v0[j].x + v0[j].y * v0[j].y) + (v0[j].z * v0[j].z + v0[j].w * v0[j].w); ss1 += (v1[j].x * v1[j].x + v1[j].y * v1[j].y) + (v1[j].z * v1[j].z + v1[j].w * v1[j].w); }
#pragma unroll
        for (int o = 1; o < 64; o <<= 1) { ss0 += shx(ss0, o, lane); ss1 += shx(ss1, o, lane); }
        const float r0 = rsqrtf(ss0 * (1.0f / D) + EPS), r1 = rsqrtf(ss1 * (1.0f / D) + EPS);
        GAS u32x2* o0 = (GAS u32x2*)(H + (size_t)m * D) + lane; GAS u32x2* o1 = (GAS u32x2*)(H + (size_t)m1 * D) + lane;
#pragma unroll
        for (int j = 0; j < 8; ++j) { const f32x4 w = gl[lane + 64 * j]; v0[j] = v0[j] * r0 * w; v1[j] = v1[j] * r1 * w;
            u32x2 p0; p0.x = cvt_pk_bf16(v0[j].x, v0[j].y); p0.y = cvt_pk_bf16(v0[j].z, v0[j].w); o0[64 * j] = p0;
            u32x2 p1; p1.x = cvt_pk_bf16(v1[j].x, v1[j].y); p1.y = cvt_pk_bf16(v1[j].z, v1[j].w); if (two) o1[64 * j] = p1; }
        float lg0[NE], lg1[NE];
#pragma unroll
        for (int e = 0; e < NE; ++e) { f32x2 a0 = (f32x2){0.f, 0.f}, a1 = (f32x2){0.f, 0.f};
#pragma unroll
            for (int j = 0; j < 8; ++j) { const f32x4 w = *(const LAS f32x4*)(wT + e * D + 4 * lane + 256 * j); const f32x2 wl = (f32x2){w.x, w.y}, wh = (f32x2){w.z, w.w};
                a0 = __builtin_elementwise_fma((f32x2){v0[j].x, v0[j].y}, wl, a0); a0 = __builtin_elementwise_fma((f32x2){v0[j].z, v0[j].w}, wh, a0);
                a1 = __builtin_elementwise_fma((f32x2){v1[j].x, v1[j].y}, wl, a1); a1 = __builtin_elementwise_fma((f32x2){v1[j].z, v1[j].w}, wh, a1); }
            lg0[e] = a0.x + a0.y; lg1[e] = a1.x + a1.y; if (e & 1) __builtin_amdgcn_sched_barrier(0); }
#pragma unroll
        for (int st = 0; st < 4; ++st) { const int o = 32 >> st, n = 8 >> st; const bool up = (lane & o) != 0;
#pragma unroll
            for (int i = 0; i < 8; ++i) if (i < n) { const float s0 = up ? lg0[i] : lg0[i + n], k0 = up ? lg0[i + n] : lg0[i]; const float s1 = up ? lg1[i] : lg1[i + n], k1 = up ? lg1[i + n] : lg1[i];
                lg0[i] = k0 + shx(s0, o, lane); lg1[i] = k1 + shx(s1, o, lane); } }
        float l0 = lg0[0], l1 = lg1[0]; l0 += shx(l0, 2, lane); l1 += shx(l1, 2, lane); l0 += shx(l0, 1, lane); l1 += shx(l1, 1, lane);
        float mx0 = l0, mx1 = l1;
#pragma unroll
        for (int o = 4; o < 64; o <<= 1) { mx0 = fmaxf(mx0, shx(mx0, o, lane)); mx1 = fmaxf(mx1, shx(mx1, o, lane)); }
        const float e0 = expf(l0 - mx0), e1 = expf(l1 - mx1); float sm0 = e0, sm1 = e1;
#pragma unroll
        for (int o = 4; o < 64; o <<= 1) { sm0 += shx(sm0, o, lane); sm1 += shx(sm1, o, lane); }
        const int e = ((lane >> 5) & 1) * 8 + ((lane >> 4) & 1) * 4 + ((lane >> 3) & 1) * 2 + ((lane >> 2) & 1);
        if ((lane & 3) == 0) { AFF[(size_t)e * S + m] = e0 / sm0; if (two) AFF[(size_t)e * S + m1] = e1 / sm1; }
    }
    __syncthreads();
}

__device__ __forceinline__ void select_phase(const Args& a, const Ctx& c, int e) {
    const float* AFF = (const float*)(a.ws + WS_AFF) + (size_t)e * S; int* INV = (int*)(a.ws + WS_INV) + (size_t)e * S; int* IDX = (int*)(a.ws + WS_IDX); float* GATE = (float*)(a.ws + WS_GATE);
    LAS int* red = (LAS int*)c.lds;
    unsigned v[16];
#pragma unroll
    for (int q = 0; q < 4; ++q) { const u32x4 t4 = *(const GAS u32x4*)(AFF + c.tid * 16 + 4 * q); v[4 * q] = t4.x; v[4 * q + 1] = t4.y; v[4 * q + 2] = t4.z; v[4 * q + 3] = t4.w; }
    __syncthreads();
    unsigned prefix = 0; int it = 0;
    for (int sh = 30; sh >= 0; sh -= 2, ++it) {
        const int nb = (sh == 30) ? 1 : 2; const int shift = (sh == 30) ? 30 : sh - 1;
        int cnt[3];
#pragma unroll
        for (int j = 1; j <= 3; ++j) { const unsigned cand = prefix | ((unsigned)j << shift); int cj = 0;
#pragma unroll
            for (int i = 0; i < 16; ++i) cj += (v[i] >= cand) ? 1 : 0;
            cnt[j - 1] = wave_sum_dpp(cj); }
        LAS int* rb = red + (it & 1) * 32;
        if (c.lane == 0) { rb[c.wave * 4 + 0] = cnt[0]; rb[c.wave * 4 + 1] = cnt[1]; rb[c.wave * 4 + 2] = cnt[2]; }
        __syncthreads();
        int t1 = 0, t2 = 0, t3 = 0;
#pragma unroll
        for (int w = 0; w < NWAVES; ++w) { t1 += rb[w * 4 + 0]; t2 += rb[w * 4 + 1]; t3 += rb[w * 4 + 2]; }
        int jsel = 0;
        if (nb == 1) { jsel = (t1 >= CAP) ? 1 : 0; } else { jsel = (t3 >= CAP) ? 3 : ((t2 >= CAP) ? 2 : ((t1 >= CAP) ? 1 : 0)); }
        prefix |= (unsigned)jsel << shift;
        if (sh == 30) sh = 31;
    }
    const unsigned T = prefix;
    int cg = 0, ce = 0;
#pragma unroll
    for (int i = 0; i < 16; ++i) { cg += (v[i] > T) ? 1 : 0; ce += (v[i] == T) ? 1 : 0; }
    int pg = cg, pe = ce;
#pragma unroll
    for (int o = 1; o < 64; o <<= 1) { const int src = (c.lane >= o ? c.lane - o : c.lane) << 2; const int tg = __builtin_amdgcn_ds_bpermute(src, pg), te = __builtin_amdgcn_ds_bpermute(src, pe); if (c.lane >= o) { pg += tg; pe += te; } }
    __syncthreads();
    if (c.lane == 63) { red[64 + c.wave] = pg; red[80 + c.wave] = pe; }
    __syncthreads();
    int bg = 0, be = 0, ng = 0;
#pragma unroll
    for (int w = 0; w < NWAVES; ++w) { const int xg = red[64 + w], xe = red[80 + w]; if (w < c.wave) { bg += xg; be += xe; } ng += xg; }
    pg = pg - cg + bg; pe = pe - ce + be;
    const int need = CAP - ng;
    int slots[16];
#pragma unroll
    for (int i = 0; i < 16; ++i) {
        const int t = c.tid * 16 + i; int slot = -1;
        if (v[i] > T) { slot = pg++; } else if (v[i] == T) { if (pe < need) slot = ng + pe; pe++; }
        slots[i] = slot;
        if (slot >= 0) { IDX[e * CAP + slot] = t; GATE[e * CAP + slot] = __builtin_bit_cast(float, v[i]); }
    }
#pragma unroll
    for (int q = 0; q < 4; ++q) { u32x4 o; o.x = (unsigned)slots[4 * q]; o.y = (unsigned)slots[4 * q + 1]; o.z = (unsigned)slots[4 * q + 2]; o.w = (unsigned)slots[4 * q + 3]; *(GAS u32x4*)(INV + c.tid * 16 + 4 * q) = o; }
}

__device__ __forceinline__ void combine_stage(const Args& a, const Ctx& c, int layer) {
    LAS f32x4* gl = (LAS f32x4*)c.lds; const bool lastl = (layer == NL - 1);
    __syncthreads();
    if (c.tid < D / 4) gl[c.tid] = ((const GAS f32x4*)((const float*)(a.ws + WS_PAR) + (lastl ? PAR_GFIN : PAR_GMIX + (layer + 1) * D)))[c.tid];
    __syncthreads();
}
__device__ __forceinline__ void combine_phase(const Args& a, const Ctx& c, int layer, bool staged = false) {
    int gw = c.vcu * NWAVES + c.wave; asm volatile("" : "+s"(gw));
    const int NGW = c.G * NWAVES, lane = c.lane;
    const bf16_t* Y = (const bf16_t*)(a.ws + WS_Y); const int* INV = (const int*)(a.ws + WS_INV); bf16_t* H = (bf16_t*)(a.ws + WS_H);
    const bool lastl = (layer == NL - 1);
    LAS f32x4* gl = (LAS f32x4*)c.lds;
    f32x4 nv[8]; int ninv = -1;
    { ninv = INV[(size_t)(lane & 15) * S + gw];
#pragma unroll
        for (int j = 0; j < 8; ++j) nv[j] = ((const GAS f32x4*)(a.X + (size_t)gw * D))[lane + 64 * j]; }
    if (!staged) {
    __syncthreads();
    if (c.tid < D / 4) gl[c.tid] = ((const GAS f32x4*)((const float*)(a.ws + WS_PAR) + (lastl ? PAR_GFIN : PAR_GMIX + (layer + 1) * D)))[c.tid];
    __syncthreads();
    }
    for (int m = gw; m < S; m += NGW) {
        GAS f32x4* xr = (GAS f32x4*)(a.X + (size_t)m * D) + lane; f32x4 v[8];
#pragma unroll
        for (int j = 0; j < 8; ++j) v[j] = nv[j];
        const int myinv = ninv;
        if (m + NGW < S) { ninv = INV[(size_t)(lane & 15) * S + m + NGW];
#pragma unroll
            for (int j = 0; j < 8; ++j) nv[j] = ((const GAS f32x4*)(a.X + (size_t)(m + NGW) * D))[lane + 64 * j]; }
        unsigned mask = (unsigned)(__builtin_amdgcn_ballot_w64(myinv >= 0) & 0xFFFFull);
        while (mask) {
            const int e1 = __builtin_ctz(mask); mask &= mask - 1u; const bool two = mask != 0u; const int e2 = two ? __builtin_ctz(mask) : e1; if (two) mask &= mask - 1u;
            const int s1 = __builtin_amdgcn_readlane(myinv, e1), s2 = __builtin_amdgcn_readlane(myinv, e2);
            const GAS u32x2* y1 = (const GAS u32x2*)(Y + ((size_t)e1 * CAP + s1) * D) + lane; const GAS u32x2* y2 = (const GAS u32x2*)(Y + ((size_t)e2 * CAP + s2) * D) + lane;
            u32x2 a1[8], a2[8];
#pragma unroll
            for (int j = 0; j < 8; ++j) { a1[j] = y1[64 * j]; a2[j] = y2[64 * j]; }
#pragma unroll
            for (int j = 0; j < 8; ++j) { v[j].x += bf_lo(a1[j].x); v[j].y += bf_hi(a1[j].x); v[j].z += bf_lo(a1[j].y); v[j].w += bf_hi(a1[j].y); }
            if (two) {
#pragma unroll
                for (int j = 0; j < 8; ++j) { v[j].x += bf_lo(a2[j].x); v[j].y += bf_hi(a2[j].x); v[j].z += bf_lo(a2[j].y); v[j].w += bf_hi(a2[j].y); } }
        }
        float ss = 0.f;
#pragma unroll
        for (int j = 0; j < 8; ++j) ss += (v[j].x * v[j].x + v[j].y * v[j].y) + (v[j].z * v[j].z + v[j].w * v[j].w);
        const float r = rsqrtf(wave_sum(ss, lane) * (1.0f / D) + EPS);
        if (!lastl) {
            GAS u32x2* o8 = (GAS u32x2*)(H + (size_t)m * D) + lane;
#pragma unroll
            for (int j = 0; j < 8; ++j) { xr[64 * j] = v[j]; const f32x4 w = gl[lane + 64 * j]; u32x2 o; o.x = cvt_pk_bf16(v[j].x * r * w.x, v[j].y * r * w.y); o.y = cvt_pk_bf16(v[j].z * r * w.z, v[j].w * r * w.w); o8[64 * j] = o; }
        } else {
#pragma unroll
            for (int j = 0; j < 8; ++j) { const f32x4 w = gl[lane + 64 * j]; f32x4 o; o.x = v[j].x * r * w.x; o.y = v[j].y * r * w.y; o.z = v[j].z * r * w.z; o.w = v[j].w * r * w.w; xr[64 * j] = o; }
        }
    }
    __syncthreads();
}
constexpr int NPH = 1 + 9 * NL;
__global__ void __launch_bounds__(NTHREADS, 2) mk_fwd(Args a) {
    extern __shared__ __attribute__((aligned(16))) unsigned char lds_raw[];
    Ctx c; c.lds = (LAS unsigned char*)lds_raw;
    c.wave = __builtin_amdgcn_readfirstlane((int)threadIdx.x >> 6);
    c.lane = lane_id(); c.tid = c.wave * 64 + c.lane;
    c.G = gridDim.x; { const int bx = blockIdx.x; c.vcu = (c.G % 8 == 0) ? (bx % 8) * (c.G / 8) + bx / 8 : bx; }
    volatile LAS unsigned* MISC = (volatile LAS unsigned*)(c.lds + MISC_OFF);
    for (int u = c.tid; u < (LDS_BYTES - LDSCTL_OFF) / 4; u += NTHREADS) ((LAS unsigned*)(c.lds + LDSCTL_OFF))[u] = 0u;
    const bool leader0 = false; (void)leader0;
    __syncthreads();
    const int lo = a.ph_lo, hi = a.ph_hi;
    unsigned* ctl = (unsigned*)(a.ws + WS_CTL);
    XcdBarrier bar; bar.bar = ctl + CW_BAR; bar.x = 0; bar.st = nullptr;
    if (hi - lo > 1) bar = xcd_barrier_post(ctl + CW_BAR, MISC + 8, c.tid == 0);
    unsigned char* ws = a.ws;
#define IN(k) (lo <= (k) && (k) < hi)
#ifndef MK_PHMASK
#define MK_PHMASK 0x3ff
#endif
#define EN(b) ((MK_PHMASK >> (b)) & 1)
#ifndef MK_REPMASK
#define MK_REPMASK 0
#endif
#ifndef MK_NRSTAGE
#define MK_NRSTAGE 1
#endif
#define REPS_ON(b) (((MK_REPMASK >> (b)) & 1) != 0)
#ifndef MK_REPN
#define MK_REPN 3
#endif
#define REPS(b) (((MK_REPMASK >> (b)) & 1) ? MK_REPN : 1)
#define SEAM(k) do { if (IN((k) + 1)) { const int _ln = lane_id(); xcd_barrier(bar, c.wave == 0 && _ln == 0); } } while (0)
#ifndef MK_SELCVT
#define MK_SELCVT 2400
#endif
#define par0b_() ({ int _b = (int)blockIdx.x; asm volatile("" : "+s"(_b)); _b; })
#define FRESH(cc) Ctx cc = c; cc.lane = lane_id(); cc.tid = cc.wave * 64 + cc.lane

    if (EN(0) && IN(0)) {
        { FRESH(cc); p0_prologue(a, cc); }
        SEAM(0); }

    for (int l = 0; l < NL; ++l) {
        const int pb = 1 + 9 * l, li = l >> 1; const bool odd = (l & 1) != 0;
        if (EN(1) && IN(pb + 0)) {
            pg8::Sched Sc{}; Sc.G = c.G; Sc.c = (int)blockIdx.x; Sc.A = (long)WS_H; Sc.tA = 256 * D * 2; Sc.sA = 0; Sc.sB = 0; Sc.tB = 256 * D * 2; Sc.nM = S / 256; Sc.nG = 1; Sc.gidx = nullptr;
            pg8::EpiBf16 E{}; E.O = (bf16_t*)(ws + WS_Z); E.gcol = 0; E.O2 = (bf16_t*)(ws + WS_VT); E.ldc2 = S;
            if (!odd) { Sc.B = (long)(WS_EVIN + li * SZ_EVIN); Sc.nN = QKF_LD / 256; E.ldc = QKF_LD;
                Sc.nExtra = 64; Sc.nFull = 384; }
            else { Sc.B = (long)(WS_ODIN + li * SZ_ODIN); Sc.nN = OD_IN / 256; E.ldc = OD_IN; Sc.nExtra = 0; Sc.nFull = (S / 256) * (OD_IN / 256); }
#if MK_JITCVT
            int par0 = (int)blockIdx.x; asm volatile("" : "+s"(par0)); par0 &= 1;
            const bool solo = !odd && c.G == 256;
            if (solo) { if (par0b_() >= 128) { FRESH(cc); moe_cvt(a, cc, l, 0, par0b_() - 128, 128); __syncthreads(); } }
            else if (par0 == 0) { FRESH(cc); moe_cvt(a, cc, l, 0); __syncthreads(); }
#endif
            pg8::gemm_phase<pg8::EpiBf16, false>(c.lds, c.wave, (const char*)ws, D, D, D, Sc, E);
#if MK_JITCVT
            int par0b = (int)blockIdx.x; asm volatile("" : "+s"(par0b));
            if (!(!odd && c.G == 256) && (par0b & 1) != 0) { FRESH(cc); moe_cvt(a, cc, l, 0); __syncthreads(); }
#endif
            SEAM(pb + 0);
        }
        if (EN(2) && IN(pb + 1)) {
#if MK_JITCVT && MK_UPHOST
            { int parm = (int)blockIdx.x; asm volatile("" : "+s"(parm)); if ((parm & 1) == 0) { FRESH(cc); moe_cvt(a, cc, l, 1); __syncthreads(); } }
#endif
            if (!odd) {
#ifndef MK_SUB
#define MK_SUB 7
#endif
                _Pragma("unroll 1") for (int rep = 0; rep < REPS(10); ++rep) if (MK_SUB & 1) for (int u = c.vcu; u < 256; u += c.G) { FRESH(cc); attn_unit(a, cc, li, u >> 2, u & 3); }
                _Pragma("unroll 1") for (int rep = 0; rep < REPS(11); ++rep) if (MK_SUB & 2) for (int u = c.vcu; u < 256; u += c.G) { FRESH(cc); ffta_unit(a, cc, u >> 6, u & 63); }
            } else {
                _Pragma("unroll 1") for (int rep = 0; rep < REPS(13); ++rep) if (MK_SUB & 4) for (int u = c.vcu; u < 256; u += c.G) { FRESH(cc); if (MK_ODDMIX2) oddmix_unit2(a, cc, li, u); else oddmix_unit(a, cc, li, u); }
            }
#if MK_JITCVT && MK_UPHOST
            { int parm = (int)blockIdx.x; asm volatile("" : "+s"(parm)); if ((parm & 1) != 0) { __syncthreads(); FRESH(cc); moe_cvt(a, cc, l, 1); __syncthreads(); } }
#endif
            SEAM(pb + 1);
        }
        if (EN(3) && IN(pb + 2)) {
            if (!odd) {
                _Pragma("unroll 1") for (int rep = 0; rep < REPS(12); ++rep) if (MK_SUB & 1) for (int u = c.vcu; u < 256; u += c.G) { FRESH(cc); fftc_unit(a, cc, u >> 2, u & 3); }
                __syncthreads();
            }
            if (!odd)             SEAM(pb + 2);
        }
        if (EN(4) && IN(pb + 3)) {
            const int Kk = odd ? D : MIX_LD_EV;
            pg8::Sched Sc{}; Sc.G = c.G; Sc.c = (int)blockIdx.x; Sc.A = (long)WS_MIX; Sc.sA = 0; Sc.tA = 256 * Kk * 2;
            Sc.B = (long)(odd ? WS_ODOUT + li * SZ_ODOUT : WS_EVOUT + li * SZ_EVOUT); Sc.sB = 0; Sc.tB = 256 * Kk * 2;
            Sc.nM = S / 256; Sc.nN = D / 256; Sc.nG = 1; Sc.gidx = nullptr; Sc.nExtra = 0; Sc.nFull = 256;
            pg8::EpiResF32 E{}; E.R = (l == 0) ? a.x_in : a.X; E.X = a.X; E.ldc = D;
#if MK_JITCVT && !MK_UPHOST
            int par1 = (int)blockIdx.x; asm volatile("" : "+s"(par1)); par1 &= 1;
            if (par1 == 0) { FRESH(cc); moe_cvt(a, cc, l, 1); __syncthreads(); }
#endif
            pg8::gemm_phase<pg8::EpiResF32, false>(c.lds, c.wave, (const char*)ws, Kk, Kk, Kk, Sc, E);
#if MK_JITCVT && !MK_UPHOST
            int par1b = (int)blockIdx.x; asm volatile("" : "+s"(par1b));
            if ((par1b & 1) != 0) { FRESH(cc); moe_cvt(a, cc, l, 1); __syncthreads(); }
#endif
#if MK_NRSTAGE
            if (IN(pb + 4) && EN(5) && !REPS_ON(14)) { FRESH(cc); norm_router_stage(a, cc, l); }
#endif
            SEAM(pb + 3);
        }
        if (EN(5) && IN(pb + 4)) { _Pragma("unroll 1") for (int rep = 0; rep < REPS(14); ++rep) { FRESH(cc); norm_router_phase(a, cc, l, MK_NRSTAGE && EN(4) && IN(pb + 3) && !REPS_ON(14)); } SEAM(pb + 4); }
        if (EN(6) && IN(pb + 5)) { _Pragma("unroll 1") for (int rep = 0; rep < REPS(6); ++rep) { FRESH(cc); int bx = (int)blockIdx.x; asm volatile("" : "+s"(bx));
              if (bx < NE) select_phase(a, cc, bx);
#if MK_JITCVT
              else if (c.G == 256) moe_cvt(a, cc, l, 2, bx - NE, 256 - NE, 0, MK_SELCVT);
#endif
#ifdef MK_SELSLEEP
              else { for (int q = 0; q < MK_SELSLEEP; ++q) __builtin_amdgcn_s_sleep(127); }
#endif
            } SEAM(pb + 5); }
        if (EN(7) && IN(pb + 6)) {
            pg8::Sched Sc{}; Sc.G = c.G; Sc.c = (int)blockIdx.x; Sc.A = (long)WS_H; Sc.sA = 0; Sc.tA = 0; Sc.B = (long)(WS_GU + l * SZ_GU); Sc.sB = (long)2048 * D * 2; Sc.tB = 256 * D * 2;
            Sc.nM = CAP / 256; Sc.nN = 2048 / 256; Sc.nG = NE; Sc.gidx = (const int*)(ws + WS_IDX); Sc.nExtra = 0; Sc.nFull = 512;
            pg8::EpiGU E{}; E.HID = (bf16_t*)(ws + WS_HID);
#if MK_JITCVT
            int par2 = (int)blockIdx.x; asm volatile("" : "+s"(par2)); par2 &= 1;
            if (par2 == 0) { FRESH(cc); moe_cvt(a, cc, l, 2, -1, 0, (c.G == 256) ? MK_SELCVT : 0); __syncthreads(); }
#endif
            pg8::gemm_phase<pg8::EpiGU, true>(c.lds, c.wave, (const char*)ws, D, D, D, Sc, E);
#if MK_JITCVT
            int par2b = (int)blockIdx.x; asm volatile("" : "+s"(par2b));
            if ((par2b & 1) != 0) { FRESH(cc); moe_cvt(a, cc, l, 2, -1, 0, (c.G == 256) ? MK_SELCVT : 0); __syncthreads(); }
#endif
            SEAM(pb + 6);
        }
        if (EN(8) && IN(pb + 7)) {
            pg8::Sched Sc{}; Sc.G = c.G; Sc.c = (int)blockIdx.x; Sc.A = (long)WS_HID; Sc.sA = (long)CAP * EH * 2; Sc.tA = 256 * EH * 2; Sc.B = (long)(WS_DN + l * SZ_DN); Sc.sB = (long)D * EH * 2; Sc.tB = 256 * EH * 2;
            Sc.nM = CAP / 256; Sc.nN = D / 256; Sc.nG = NE; Sc.gidx = nullptr; Sc.nExtra = 0; Sc.nFull = 512;
            pg8::EpiDown E{}; E.Y = (bf16_t*)(ws + WS_Y); E.gate = (const float*)(ws + WS_GATE);
            pg8::gemm_phase<pg8::EpiDown, false>(c.lds, c.wave, (const char*)ws, EH, EH, EH, Sc, E);
#if MK_NRSTAGE
            if (IN(pb + 8) && EN(9)) { FRESH(cc); combine_stage(a, cc, l); }
#endif
            SEAM(pb + 7);
        }
        if (EN(9) && IN(pb + 8)) { FRESH(cc); combine_phase(a, cc, l, MK_NRSTAGE && EN(8) && IN(pb + 7)); SEAM(pb + 8); }
    }
#undef IN
#undef SEAM
}
}


extern "C" void kernel_launch(void* const* d_in, const int* in_sizes, int n_in, void* d_out, int out_size, void* d_ws, size_t ws_size, hipStream_t stream) {
    using namespace mk;
    static int grid = 0;
    if (grid == 0) {
        int dev = 0, cus = 0, per_cu = 0;
        if (hipGetDevice(&dev) != hipSuccess || hipDeviceGetAttribute(&cus, hipDeviceAttributeMultiprocessorCount, dev) != hipSuccess) { fprintf(stderr, "kernel_launch: device query failed\n"); grid = -1; return; }
        if (hipFuncSetAttribute((const void*)mk_fwd, hipFuncAttributeMaxDynamicSharedMemorySize, LDS_BYTES) != hipSuccess) { fprintf(stderr, "kernel_launch: hipFuncSetAttribute failed\n"); grid = -1; return; }
        if (hipOccupancyMaxActiveBlocksPerMultiprocessor(&per_cu, (const void*)mk_fwd, NTHREADS, LDS_BYTES) != hipSuccess || per_cu < 1) fprintf(stderr, "kernel_launch: occupancy query reports %d blocks per CU\n", per_cu);
        (void)hipGetLastError();
        grid = cus;
        if (ws_size < WS_END) { fprintf(stderr, "kernel_launch: workspace too small: %zu < %zu\n", ws_size, (size_t)WS_END); grid = -1; return; }
    }
    if (grid < 0) return;
    (void)hipMemsetAsync((char*)d_ws + WS_CTL, 0, CTL_ZERO_BYTES, stream);
    Args a{};
    a.x_in = (const float*)d_in[0]; a.rel_bias = (const float*)d_in[1]; a.norm_mix_g = (const float*)d_in[2]; a.norm_ffn_g = (const float*)d_in[3]; a.final_g = (const float*)d_in[4];
    a.ev_w_in = (const float*)d_in[5]; a.ev_sink = (const float*)d_in[6]; a.ev_w_out = (const float*)d_in[7];
    a.od_w_in = (const float*)d_in[8]; a.od_conv_w = (const float*)d_in[9]; a.od_pool_w = (const float*)d_in[10]; a.od_pool_scale = (const float*)d_in[11]; a.od_w_out = (const float*)d_in[12];
    a.moe_w_router = (const float*)d_in[13]; a.moe_w_gate = (const float*)d_in[14]; a.moe_w_up = (const float*)d_in[15]; a.moe_w_down = (const float*)d_in[16];
    a.X = (float*)d_out; a.ws = (unsigned char*)d_ws;
#if MK_DEBUG
    mkref::debug_run(a, grid, d_in, d_out, d_ws, ws_size, stream);
#else
#if MK_NLAUNCH == 1
    a.ph_lo = 0; a.ph_hi = NPH;
    hipLaunchKernelGGL(mk_fwd, dim3(grid), dim3(NTHREADS), LDS_BYTES, stream, a);
#else
    for (int p = 0; p < NPH; ++p) { const int type = p == 0 ? 0 : ((p - 1) % 9) + 1; const int layer = p == 0 ? 0 : (p - 1) / 9; (void)layer;
        int reps = 1;
#if defined(MK_HREPMASK)
        if (((MK_HREPMASK >> type) & 1) && ((MK_HREPLAYERS >> layer) & 1)) reps = MK_HREPN;
#endif
        for (int r = 0; r < reps; ++r) { a.ph_lo = p; a.ph_hi = p + 1; hipLaunchKernelGGL(mk_fwd, dim3(grid), dim3(NTHREADS), LDS_BYTES, stream, a); } }
#if defined(MK_HREP_EMPTY)
    for (int r = 0; r < MK_HREP_EMPTY; ++r) { a.ph_lo = NPH; a.ph_hi = NPH; hipLaunchKernelGGL(mk_fwd, dim3(grid), dim3(NTHREADS), LDS_BYTES, stream, a); }
#endif
#endif
    if (hipPeekAtLastError() != hipSuccess) fprintf(stderr, "kernel_launch: launch failed\n");
#endif
}
```

```cpp
#include <hip/hip_runtime.h>
#include <cstdio>
#include <cstdint>

#ifndef MK_DEBUG
#define MK_DEBUG 0
#endif
#ifndef MK_NLAUNCH
#define MK_NLAUNCH 1
#endif

namespace mk {
constexpr int S = 8192, D = 2048;
constexpr int NL = MK_DEBUG ? 2 : 4;
constexpr int HD = 128, NQ = 12, NKV = 4, WIN = 128;
#ifndef MK_FFTFUSE
#define MK_FFTFUSE 1
#endif
constexpr int QDIM = 1536, KVDIM = 512, FDIM = 512, EV_IN = 3072, QKF_LD = 2560, MIX_LD_EV = MK_FFTFUSE ? 2048 : 2560;
constexpr int CONVD = 1024, POOLD = 1024, OD_IN = 4096;
constexpr int NE = 16, EH = 1024, CAP = 1024;
constexpr float EPS = 1e-6f;
constexpr int NWAVES = 8, NTHREADS = 512;

typedef unsigned short bf16_t;
typedef short bf16x8 __attribute__((ext_vector_type(8)));
typedef short s16x4 __attribute__((ext_vector_type(4)));
typedef float f32x4 __attribute__((ext_vector_type(4)));
typedef float f32x2 __attribute__((ext_vector_type(2)));
typedef unsigned u32x4 __attribute__((ext_vector_type(4)));
typedef unsigned u32x2 __attribute__((ext_vector_type(2)));
#define LAS __attribute__((address_space(3)))
#define GAS __attribute__((address_space(1)))
#define LDS_WAIT() asm volatile("s_waitcnt lgkmcnt(0)" ::: "memory")
#define VM_WAIT() asm volatile("s_waitcnt vmcnt(0)" ::: "memory")

constexpr size_t MiB = 1u << 20;
constexpr size_t WS_CTL = 0, CTL_ZERO_BYTES = 1 * MiB;
constexpr size_t WS_AFF = 1 * MiB;
constexpr size_t WS_INV = WS_AFF + 512 * 1024;
constexpr size_t WS_IDX = 2 * MiB;
constexpr size_t WS_GATE = WS_IDX + 64 * 1024;
constexpr size_t WS_PAR = 3 * MiB;
constexpr int PAR_RELB = 0, PAR_SINK = 384, PAR_GMIX = 512, PAR_GFFN = PAR_GMIX + 4 * 2048, PAR_GFIN = PAR_GFFN + 4 * 2048, PAR_CONV = PAR_GFIN + 2048, PAR_ROUTER = 32768, PAR_PTRS = 32000;
constexpr size_t WS_FTC = WS_PAR + 768 * 1024;
constexpr size_t WS_FTA = WS_PAR + 896 * 1024;
constexpr size_t WS_FCO = WS_PAR + 912 * 1024;
constexpr size_t WS_H = 4 * MiB;
constexpr size_t WS_Z = 36 * MiB;
constexpr size_t WS_VT = 100 * MiB;
constexpr size_t WS_MIX = 108 * MiB;
constexpr size_t WS_TB = 148 * MiB;
constexpr size_t WS_POOLED = 164 * MiB;
constexpr size_t WS_HID = 180 * MiB;
constexpr size_t WS_Y = 212 * MiB;
constexpr size_t WS_W = 276 * MiB;
constexpr size_t SZ_EVIN = (size_t)EV_IN * D * 2, SZ_EVOUT = (size_t)D * MIX_LD_EV * 2, SZ_ODIN = (size_t)OD_IN * D * 2, SZ_ODOUT = (size_t)D * D * 2, SZ_POOL = (size_t)4 * 256 * 256 * 2;
constexpr size_t SZ_GU = (size_t)NE * 2048 * D * 2, SZ_DN = (size_t)NE * D * EH * 2;
constexpr size_t WS_EVIN = WS_W, WS_EVOUT = WS_EVIN + (NL / 2) * SZ_EVIN, WS_ODIN = WS_EVOUT + (NL / 2) * SZ_EVOUT, WS_ODOUT = WS_ODIN + (NL / 2) * SZ_ODIN,
                 WS_POOLW = WS_ODOUT + (NL / 2) * SZ_ODOUT, WS_GU = WS_POOLW + (NL / 2) * SZ_POOL, WS_DN = WS_GU + NL * SZ_GU, WS_END = WS_DN + NL * SZ_DN;
constexpr int CW_TMO = 0, CW_CODE = 1, CW_BAR = 4096;

constexpr int RING_BYTES = 131072;
constexpr int LDSCTL_OFF = RING_BYTES, MISC_OFF = LDSCTL_OFF + 320;
constexpr int LDS_BYTES = 163840;

__device__ __forceinline__ unsigned f2bf(float f) { unsigned u = __builtin_bit_cast(unsigned, f); return (u + 0x7fffu + ((u >> 16) & 1u)) >> 16; }
typedef __bf16 bf16x2_t __attribute__((ext_vector_type(2)));
__device__ __forceinline__ unsigned cvt_pk_bf16(float lo, float hi) { const f32x2 v = {lo, hi}; return __builtin_bit_cast(unsigned, __builtin_convertvector(v, bf16x2_t)); }
#ifndef MK_PK2HW
#define MK_PK2HW 1
#endif
__device__ __forceinline__ unsigned pk2(float lo, float hi) { return MK_PK2HW ? cvt_pk_bf16(lo, hi) : (f2bf(lo) | (f2bf(hi) << 16)); }
__device__ __forceinline__ unsigned cvt_pk_bf16_v(float lo, float hi) { unsigned r; asm volatile("v_cvt_pk_bf16_f32 %0, %1, %2" : "=v"(r) : "v"(lo), "v"(hi)); return r; }
__device__ __forceinline__ float bf_lo(unsigned w) { return __builtin_bit_cast(float, w << 16); }
__device__ __forceinline__ float bf_hi(unsigned w) { return __builtin_bit_cast(float, w & 0xffff0000u); }
__device__ __forceinline__ int lane_id() { int l; asm volatile("v_mbcnt_lo_u32_b32 %0, -1, 0\n\tv_mbcnt_hi_u32_b32 %0, -1, %0" : "=v"(l)); return l; }
__device__ __forceinline__ float shx(float v, int o, int lane) { return __builtin_bit_cast(float, __builtin_amdgcn_ds_bpermute((lane ^ o) << 2, __builtin_bit_cast(int, v))); }
__device__ __forceinline__ int shxi(int v, int o, int lane) { return __builtin_amdgcn_ds_bpermute((lane ^ o) << 2, v); }
__device__ __forceinline__ float wave_sum(float v, int lane) {
#pragma unroll
    for (int o = 1; o < 64; o <<= 1) v += shx(v, o, lane);
    return v;
}
__device__ __forceinline__ int wave_sum_dpp(int v) {
    int t = v + __builtin_amdgcn_update_dpp(0, v, 0x111, 0xf, 0xf, true);
    t += __builtin_amdgcn_update_dpp(0, v, 0x112, 0xf, 0xf, true);
    t += __builtin_amdgcn_update_dpp(0, v, 0x113, 0xf, 0xf, true);
    t += __builtin_amdgcn_update_dpp(0, t, 0x114, 0xf, 0xe, true);
    t += __builtin_amdgcn_update_dpp(0, t, 0x118, 0xf, 0xc, true);
    t += __builtin_amdgcn_update_dpp(0, t, 0x142, 0xa, 0xf, true);
    t += __builtin_amdgcn_update_dpp(0, t, 0x143, 0xc, 0xf, true);
    return __builtin_amdgcn_readlane(t, 63);
}
__device__ __forceinline__ int wave_sum_i(int v, int lane) {
#pragma unroll
    for (int o = 1; o < 64; o <<= 1) v += shxi(v, o, lane);
    return v;
}

namespace pg8 {
constexpr int BM = 256, BK = 64, HALF = 128, HTB = HALF * BK * 2, STAGE_BYTES = 8 * HTB, NXCD = 8, WGM = 8;
__host__ __device__ __forceinline__ int lds_byte(int r, int c) { const int st = (r >> 4) * 2 + (c >> 5), rr = r & 15, cc = c & 31, ob = rr * 64 + cc * 2; return st * 1024 + (ob ^ (((ob >> 9) & 1) << 5)); }
__host__ __device__ __forceinline__ void stage_rc(int b, int& R, int& C) { const int st = b / 1024, sb = b % 1024, swz = sb ^ (((sb >> 9) & 1) << 5); R = (st >> 1) * 16 + swz / 64; C = (st & 1) * 32 + (swz % 64) / 2; }
__host__ __device__ __forceinline__ int perm32(int rho) { const int n = rho >> 4, i = rho & 15; return 8 * (i >> 2) + 4 * n + (i & 3); }

struct Unit { long offA, offB; int gio, pm, pn, grp, kind, half, hsel; };

struct Sched {
    long A, B, sA, sB;
    int tA, tB; int nM, nN, nG, G, c; const int* gidx;
    int nExtra;
    int nFull;
    __device__ __forceinline__ bool next(int i, Unit& u) const {
        const int nreg = nM * nN * nG, ntot = nreg + nExtra; const int L0 = i * G + c;
        if (L0 >= nFull + 2 * (ntot - nFull)) return false;
        const bool hf = L0 >= nFull; const int L = hf ? nFull + ((L0 - nFull) >> 1) : L0; const int hs = hf ? ((L0 - nFull) & 1) : 0;
        const bool ex = L >= nreg;
        int wgid = ex ? 0 : L; { const int q = nreg / NXCD, r = nreg % NXCD, xcd = wgid % NXCD, off = wgid / NXCD; wgid = (xcd < r ? xcd * (q + 1) : r * (q + 1) + (xcd - r) * q) + off; }
        int pm, pn, grp;
        if (nG == 1) {
            const int nig = WGM * nN, gid = wgid / nig, fm = gid * WGM, gsz = (nM - fm) < WGM ? (nM - fm) : WGM;
            pm = fm + ((wgid % nig) % gsz); pn = (wgid % nig) / gsz; grp = 0;
        } else { const int per = nM * nN; grp = wgid / per; const int r = wgid % per; pm = r % nM; pn = r / nM; }
        const int j = L - nreg;
        u.pm = ex ? (j & 1) : pm; u.pn = ex ? (j >> 1) : pn; u.grp = ex ? 0 : grp; u.kind = ex ? 1 : 0; u.half = hf ? 1 : 0; u.hsel = hs;
        u.gio = grp * (nM * BM) + pm * BM;
        const long ra = A + grp * sA + (gidx ? 0 : (long)pm * tA), rb = B + grp * sB + (long)pn * tB;
        u.offA = (ex ? B + (long)(nN + (j & 1)) * tB : ra) + (long)hs * ((ex ? tB : tA) >> 1); u.offB = ex ? A + (long)(j >> 1) * tA : rb;
        return true;
    }
};

struct EpiBf16 {
    static constexpr bool PERM = true, INIT_ACC = false, HALVES = true;
    bf16_t* O; int ldc; int gcol; bf16_t* O2; int ldc2;
    __device__ __forceinline__ void operator()(const f32x4 (&acc)[2][2][4][2], const Unit& u, int wr, int wc, int fr, int fq) const {
        bf16_t* base; int ld;
        if (u.kind) { base = O2 + (size_t)(u.pm * BM) * ldc2 + u.pn * BM; ld = ldc2; } else { base = O + (size_t)(u.pm * BM) * ldc + u.pn * BM + u.grp * gcol; ld = ldc; }
        bf16_t* rowp = base + (unsigned)((wr * 64 + fr + u.hsel * HALF) * ld + wc * 32 + 8 * fq);
#pragma unroll
        for (int ai = 0; ai < 2; ++ai) {
            if (ai == 1 && u.half) break;
#pragma unroll
            for (int m = 0; m < 4; ++m) {
#pragma unroll
                for (int bj = 0; bj < 2; ++bj) { const f32x4 v0 = acc[ai][bj][m][0], v1 = acc[ai][bj][m][1];
                    u32x4 w; w.x = cvt_pk_bf16(v0[0], v0[1]); w.y = cvt_pk_bf16(v0[2], v0[3]); w.z = cvt_pk_bf16(v1[0], v1[1]); w.w = cvt_pk_bf16(v1[2], v1[3]);
                    *(u32x4*)(rowp + bj * HALF) = w; }
                rowp += 16 * ld; asm volatile("" : "+v"(rowp)); }
            rowp += (HALF - 64) * ld; }
    }
};
struct EpiResF32 {
    static constexpr bool PERM = false, INIT_ACC = true, HALVES = false;
    const float* R; float* X; int ldc;
    __device__ __forceinline__ void init(f32x4 (&acc)[2][2][4][2], const Unit& u, int wr, int wc, int fr, int fq) const {
        const size_t off0 = (size_t)(u.pm * BM + wr * 64 + fr) * ldc + u.pn * BM + wc * 32 + 4 * fq;
#pragma unroll
        for (int ai = 0; ai < 2; ++ai)
#pragma unroll
            for (int m = 0; m < 4; ++m) { const size_t off = off0 + (size_t)(ai * HALF + m * 16) * ldc;
#pragma unroll
                for (int bj = 0; bj < 2; ++bj)
#pragma unroll
                    for (int n = 0; n < 2; ++n) acc[ai][bj][m][n] = *(const f32x4*)(R + off + bj * HALF + n * 16); }
    }
    __device__ __forceinline__ void operator()(const f32x4 (&acc)[2][2][4][2], const Unit& u, int wr, int wc, int fr, int fq) const {
        const size_t off0 = (size_t)(u.pm * BM + wr * 64 + fr) * ldc + u.pn * BM + wc * 32 + 4 * fq;
#pragma unroll
        for (int ai = 0; ai < 2; ++ai)
#pragma unroll
            for (int m = 0; m < 4; ++m) { const size_t off = off0 + (size_t)(ai * HALF + m * 16) * ldc;
#pragma unroll
                for (int bj = 0; bj < 2; ++bj)
#pragma unroll
                    for (int n = 0; n < 2; ++n) *(f32x4*)(X + off + bj * HALF + n * 16) = acc[ai][bj][m][n]; }
    }
};
__device__ __forceinline__ float silu_mul(float g, float u) { return g * u * __builtin_amdgcn_rcpf(1.0f + __expf(-g)); }
struct EpiGU {
    static constexpr bool PERM = true, INIT_ACC = false, HALVES = false;
    bf16_t* HID;
    __device__ __forceinline__ void operator()(const f32x4 (&acc)[2][2][4][2], const Unit& u, int wr, int wc, int fr, int fq) const {
        bf16_t* base = HID + ((size_t)u.grp * CAP + u.pm * BM + wr * 64 + fr) * EH + u.pn * HALF + wc * 32 + 8 * fq;
#pragma unroll
        for (int ai = 0; ai < 2; ++ai)
#pragma unroll
            for (int m = 0; m < 4; ++m) { const f32x4 g0 = acc[ai][0][m][0], g1 = acc[ai][0][m][1], u0 = acc[ai][1][m][0], u1 = acc[ai][1][m][1];
                u32x4 w; w.x = cvt_pk_bf16(silu_mul(g0[0], u0[0]), silu_mul(g0[1], u0[1])); w.y = cvt_pk_bf16(silu_mul(g0[2], u0[2]), silu_mul(g0[3], u0[3]));
                w.z = cvt_pk_bf16(silu_mul(g1[0], u1[0]), silu_mul(g1[1], u1[1])); w.w = cvt_pk_bf16(silu_mul(g1[2], u1[2]), silu_mul(g1[3], u1[3]));
                *(u32x4*)(base + (size_t)(ai * HALF + m * 16) * EH) = w; }
    }
};
struct EpiDown {
    static constexpr bool PERM = true, INIT_ACC = false, HALVES = false;
    bf16_t* Y; const float* gate;
    __device__ __forceinline__ void operator()(const f32x4 (&acc)[2][2][4][2], const Unit& u, int wr, int wc, int fr, int fq) const {
        const int row0 = u.grp * CAP + u.pm * BM + wr * 64 + fr;
        bf16_t* base = Y + (size_t)row0 * D + u.pn * BM + wc * 32 + 8 * fq;
#pragma unroll
        for (int ai = 0; ai < 2; ++ai)
#pragma unroll
            for (int m = 0; m < 4; ++m) { const float gt = gate[row0 + ai * HALF + m * 16]; bf16_t* rowp = base + (size_t)(ai * HALF + m * 16) * D;
#pragma unroll
                for (int bj = 0; bj < 2; ++bj) { const f32x4 v0 = acc[ai][bj][m][0] * gt, v1 = acc[ai][bj][m][1] * gt;
                    u32x4 w; w.x = cvt_pk_bf16(v0[0], v0[1]); w.y = cvt_pk_bf16(v0[2], v0[3]); w.z = cvt_pk_bf16(v1[0], v1[1]); w.w = cvt_pk_bf16(v1[2], v1[3]);
                    *(u32x4*)(rowp + bj * HALF) = w; } }
    }
};

template <class Epi, bool GATHER>
__device__ __forceinline__ void gemm_phase(LAS unsigned char* lds, const int wid_in, const char* wsb, const int K, const int lda, const int ldb, const Sched& S, const Epi& E) {
    int wid = wid_in; asm volatile("" : "+s"(wid));
    const int lane = lane_id();
    const int tid = wid * 64 + lane, wr = wid >> 2, wc = wid & 3, fr = lane & 15, fq = lane >> 4;
    const int nt = K / BK;
    unsigned voffA[2][2], voffB[2];
#pragma unroll
    for (int i = 0; i < 2; ++i) { int R, C; stage_rc(tid * 16 + i * 8192, R, C); const int Rb = Epi::PERM ? ((R & ~31) + perm32(R & 31)) : R;
        voffA[0][i] = (unsigned)(R * lda + C) * 2u; voffA[1][i] = voffA[0][i]; voffB[i] = (unsigned)(Rb * ldb + C) * 2u; }
    const size_t hstepA = GATHER ? (size_t)0 : (size_t)HALF * lda * 2;
    const size_t kstep = (size_t)(BK * 2);
    const size_t hstepB = (size_t)HALF * ldb * 2;
    const unsigned ldsw = (unsigned)wid * 1024u;
    const int aoff = lds_byte(wr * 64 + fr, fq * 8), boff = lds_byte(wc * 32 + fr, fq * 8);
#define PG8_SA(b, h) (((b) * 2 + (h)) * HTB)
#define PG8_SB(b, h) ((4 + (b) * 2 + (h)) * HTB)
#define PG8_STAGEA(bufoff, gbase, h) do { _Pragma("unroll") for (int _i = 0; _i < 2; ++_i) \
        __builtin_amdgcn_global_load_lds((const unsigned*)((const char*)(gbase) + (h) * hstepA + voffA[GATHER ? (h) : 0][_i]), (LAS unsigned*)(lds + (bufoff) + ldsw + _i * 8192), 16, 0, 0); } while (0)
#define PG8_STAGEB(bufoff, gbase) do { _Pragma("unroll") for (int _i = 0; _i < 2; ++_i) \
        __builtin_amdgcn_global_load_lds((const unsigned*)((const char*)(gbase) + voffB[_i]), (LAS unsigned*)(lds + (bufoff) + ldsw + _i * 8192), 16, 0, 0); } while (0)
#define PG8_LDA(dst, b, h) do { _Pragma("unroll") for (int m = 0; m < 4; ++m) _Pragma("unroll") for (int k = 0; k < 2; ++k) dst[m][k] = *(const LAS bf16x8*)(lds + PG8_SA(b, h) + aoff + m * 2048 + k * 1024); } while (0)
#define PG8_LDB(dst, b, h) do { _Pragma("unroll") for (int n = 0; n < 2; ++n) _Pragma("unroll") for (int k = 0; k < 2; ++k) dst[n][k] = *(const LAS bf16x8*)(lds + PG8_SB(b, h) + boff + n * 2048 + k * 1024); } while (0)
#define PG8_MMA(ai, bj, At, Bt) do { __builtin_amdgcn_s_setprio(1); _Pragma("unroll") for (int m = 0; m < 4; ++m) _Pragma("unroll") for (int n = 0; n < 2; ++n) _Pragma("unroll") for (int k = 0; k < 2; ++k) \
        acc[ai][bj][m][n] = __builtin_amdgcn_mfma_f32_16x16x32_bf16(Bt[n][k], At[m][k], acc[ai][bj][m][n], 0, 0, 0); __builtin_amdgcn_s_setprio(0); } while (0)
#define PG8_WAIT_V(n) asm volatile("s_waitcnt vmcnt(" #n ")" ::: "memory")
#define PG8_WAIT_L(n) asm volatile("s_waitcnt lgkmcnt(" #n ")" ::: "memory")
#define PG8_BAR __builtin_amdgcn_s_barrier()
#define PG8_SCHED __builtin_amdgcn_sched_barrier(0)
#define PG8_GIDX(dst, uu) do { _Pragma("unroll") for (int _i = 0; _i < 2; ++_i) { int _R, _C; stage_rc(tid * 16 + _i * 8192, _R, _C); _Pragma("unroll") for (int _h = 0; _h < 2; ++_h) \
        dst[_h][_i] = (unsigned)(S.gidx[(uu).gio + _R + _h * HALF] * lda + _C) * 2u; } } while (0)
    Unit cur, nxt; int ui = 0;
    if (!S.next(0, cur)) return;
    f32x4 acc[2][2][4][2];
    if constexpr (Epi::INIT_ACC) { E.init(acc, cur, wr, wc, fr, fq); } else {
#pragma unroll
    for (int a = 0; a < 2; ++a)
#pragma unroll
        for (int b = 0; b < 2; ++b)
#pragma unroll
            for (int m = 0; m < 4; ++m)
#pragma unroll
                for (int n = 0; n < 2; ++n) acc[a][b][m][n] = (f32x4){0.f, 0.f, 0.f, 0.f};
    }
    bf16x8 At[4][2], B0[2][2], B1[2][2];
    const char* cA = wsb + cur.offA; const char* cB = wsb + cur.offB;
    if constexpr (GATHER) { PG8_GIDX(voffA, cur); }
    PG8_STAGEB(PG8_SB(0, 0), cB); PG8_STAGEB(PG8_SB(0, 1), cB + hstepB); PG8_STAGEA(PG8_SA(0, 0), cA, 0); PG8_STAGEA(PG8_SA(0, 1), cA, 1);
    if (wr == 1) PG8_BAR;
    PG8_WAIT_V(2); PG8_BAR;
    PG8_STAGEB(PG8_SB(1, 0), cB + kstep); PG8_STAGEA(PG8_SA(1, 0), cA + kstep, 0); PG8_STAGEB(PG8_SB(1, 1), cB + hstepB + kstep);
    PG8_WAIT_V(6); PG8_BAR;
    for (;;) {
        const bool has_next = S.next(ui + 1, nxt);
        const char* nA = has_next ? wsb + nxt.offA : cA; const char* nB = has_next ? wsb + nxt.offB : cB;
        for (int t = 0; t < nt; t += 2) {
            const bool last = (t == nt - 2);
            const char* a1 = cA + (size_t)(t + 1) * kstep;
            const char* a2 = last ? nA : cA + (size_t)(t + 2) * kstep; const char* b2 = last ? nB : cB + (size_t)(t + 2) * kstep;
            const char* a3 = a2 + kstep; const char* b3 = b2 + kstep;
            unsigned nv[2][2];
            if constexpr (GATHER) { if (last && has_next) { PG8_GIDX(nv, nxt); } }
            PG8_LDB(B0, 0, 0); PG8_LDB(B1, 0, 1); PG8_SCHED; PG8_LDA(At, 0, 0); PG8_STAGEA(PG8_SA(1, 1), a1, 1);
            if constexpr (GATHER) { if (last && has_next) {
#pragma unroll
                for (int _h = 0; _h < 2; ++_h)
#pragma unroll
                    for (int _i = 0; _i < 2; ++_i) voffA[_h][_i] = nv[_h][_i]; } }
            PG8_WAIT_V(8); PG8_WAIT_L(0); PG8_BAR; PG8_MMA(0, 0, At, B0); PG8_MMA(0, 1, At, B1); PG8_BAR; PG8_SCHED;
            PG8_LDA(At, 0, 1); PG8_STAGEB(PG8_SB(0, 0), b2); PG8_STAGEB(PG8_SB(0, 1), b2 + hstepB); PG8_STAGEA(PG8_SA(0, 0), a2, 0);
            PG8_WAIT_V(8); PG8_WAIT_L(0); PG8_BAR; if (!(Epi::HALVES && cur.half)) { PG8_MMA(1, 0, At, B0); PG8_MMA(1, 1, At, B1); } PG8_BAR; PG8_SCHED;
            PG8_LDB(B0, 1, 0); PG8_LDB(B1, 1, 1); PG8_SCHED; PG8_LDA(At, 1, 0); PG8_STAGEA(PG8_SA(0, 1), a2, 1);
            PG8_WAIT_V(8); PG8_WAIT_L(0); PG8_BAR; PG8_MMA(0, 0, At, B0); PG8_MMA(0, 1, At, B1); PG8_BAR; PG8_SCHED;
            PG8_LDA(At, 1, 1); PG8_STAGEB(PG8_SB(1, 0), b3); PG8_STAGEB(PG8_SB(1, 1), b3 + hstepB); PG8_STAGEA(PG8_SA(1, 0), a3, 0);
            PG8_WAIT_V(8); PG8_WAIT_L(0); PG8_BAR; if (!(Epi::HALVES && cur.half)) { PG8_MMA(1, 0, At, B0); PG8_MMA(1, 1, At, B1); } PG8_BAR; PG8_SCHED;
        }
        if (wr == 0) PG8_BAR;
        { const int le = lane_id(); E(acc, cur, wr, wc, le & 15, le >> 4); }
        if (!has_next) break;
        if constexpr (Epi::INIT_ACC) { E.init(acc, nxt, wr, wc, fr, fq); } else {
#pragma unroll
        for (int a = 0; a < 2; ++a)
#pragma unroll
            for (int b = 0; b < 2; ++b)
#pragma unroll
                for (int m = 0; m < 4; ++m)
#pragma unroll
                    for (int n = 0; n < 2; ++n) acc[a][b][m][n] = (f32x4){0.f, 0.f, 0.f, 0.f};
        }
        cur = nxt; cA = nA; cB = nB; ++ui;
        if (wr == 1) PG8_BAR;
    }
    PG8_WAIT_V(0);
    PG8_BAR;
#undef PG8_SA
#undef PG8_SB
#undef PG8_STAGEA
#undef PG8_STAGEB
#undef PG8_LDA
#undef PG8_LDB
#undef PG8_MMA
#undef PG8_WAIT_V
#undef PG8_WAIT_L
#undef PG8_BAR
#undef PG8_SCHED
#undef PG8_GIDX
}
}
#define XB_TMO      128
#define XB_XCNT(j)  (256  + 64 * (j))
#define XB_XSUB(j)  (1280 + 64 * (j))
#define XB_XGEN(j)  (2304 + 64 * (j))
#define XB_TOP      3328
#define XB_TOPGEN   3392
#define XCD_BAR_WORDS 3456
#define XB_SPIN_CAP (1u << 18)
__device__ __forceinline__ unsigned xb_ld(unsigned* p)              { return __hip_atomic_load(p, __ATOMIC_RELAXED, __HIP_MEMORY_SCOPE_AGENT); }
__device__ __forceinline__ unsigned xb_add(unsigned* p, unsigned v) { return __hip_atomic_fetch_add(p, v, __ATOMIC_RELAXED, __HIP_MEMORY_SCOPE_AGENT); }
__device__ __forceinline__ unsigned xb_xcc_id() { return (unsigned)__builtin_amdgcn_s_getreg((3 << 11) | 20) & 0xFu; }
#define XB_SPIN(cond, bar) do { unsigned _sp = 0; while (cond) { __builtin_amdgcn_s_sleep(1); \
    if ((++_sp & 255u) == 0u) { if (xb_ld(&(bar)[XB_TMO])) break; if (_sp > XB_SPIN_CAP) { atomicAdd(&(bar)[XB_TMO], 1u); break; } } } } while (0)
struct XcdBarrier { unsigned* bar; unsigned x; volatile LAS unsigned* st; };
__device__ __forceinline__ XcdBarrier xcd_barrier_post(unsigned* bar, volatile LAS unsigned* st, bool leader) {
    XcdBarrier b; b.bar = bar; b.x = xb_xcc_id(); b.st = st;
    if (leader) (void)xb_add(&bar[XB_XCNT(b.x)], 1u);
    return b;
}
__device__ __forceinline__ void xcd_barrier_complete(unsigned* bar, unsigned x, unsigned& nloc, unsigned& nx) {
    const unsigned G = gridDim.x * gridDim.y * gridDim.z;
    unsigned sum, cnt, mine, sp = 0u;
    for (;;) {
        sum = 0u; cnt = 0u; mine = 0u;
#pragma unroll
        for (unsigned j = 0; j < 16; ++j) { const unsigned c = xb_ld(&bar[XB_XCNT(j)]); sum += c; cnt += (c > 0u) ? 1u : 0u; mine = (j == x) ? c : mine; }
        if (sum == G) break;
        __builtin_amdgcn_s_sleep(1);
        if ((++sp & 255u) == 0u) { if (xb_ld(&bar[XB_TMO])) break; if (sp > XB_SPIN_CAP) { atomicAdd(&bar[XB_TMO], 1u); break; } }
    }
    nloc = mine > 0u ? mine : 1u; nx = cnt > 0u ? cnt : 1u;
}
__device__ __forceinline__ void xcd_barrier(const XcdBarrier& b, bool leader) {
    asm volatile("s_waitcnt vmcnt(0)" ::: "memory");
    __syncthreads();
    if (leader) {
        unsigned* bar = b.bar;
        __builtin_amdgcn_s_waitcnt(0);
        unsigned nloc = b.st[0], nx = b.st[1];
        if (nloc == 0u) { xcd_barrier_complete(bar, b.x, nloc, nx); b.st[0] = nloc; b.st[1] = nx; }
        const unsigned old = xb_add(&bar[XB_XSUB(b.x)], 1u);
        const unsigned gen = old / nloc;
        if (old + 1u == (gen + 1u) * nloc) {
            __builtin_amdgcn_fence(__ATOMIC_RELEASE, "agent");
            asm volatile("s_waitcnt vmcnt(0)" ::: "memory");
            const unsigned og = xb_add(&bar[XB_TOP], 1u);
            const unsigned tg = og / nx;
            if (og + 1u == (tg + 1u) * nx) xb_add(&bar[XB_TOPGEN], 1u);
            else XB_SPIN(xb_ld(&bar[XB_TOPGEN]) == tg, bar);
            __builtin_amdgcn_fence(__ATOMIC_ACQUIRE, "agent");
            xb_add(&bar[XB_XGEN(b.x)], 1u);
            asm volatile("s_waitcnt vmcnt(0)" ::: "memory");
        } else {
            XB_SPIN(xb_ld(&bar[XB_XGEN(b.x)]) == gen, bar);
            __builtin_amdgcn_fence(__ATOMIC_ACQUIRE, "agent");
            asm volatile("s_waitcnt vmcnt(0)" ::: "memory");
        }
    }
    __syncthreads();
}

struct Args {
    const float* x_in; const float* rel_bias; const float* norm_mix_g; const float* norm_ffn_g; const float* final_g;
    const float* ev_w_in; const float* ev_sink; const float* ev_w_out;
    const float* od_w_in; const float* od_conv_w; const float* od_pool_w; const float* od_pool_scale; const float* od_w_out;
    const float* moe_w_router; const float* moe_w_gate; const float* moe_w_up; const float* moe_w_down;
    float* X; unsigned char* ws; int ph_lo, ph_hi;
};
struct Ctx { LAS unsigned char* lds; int tid, lane, wave, vcu, G; };

__device__ __forceinline__ int t5_bucket(int rel) {
    const int n = rel < 0 ? -rel : rel; int b;
    if (n < 8) b = n; else if (n < 12) b = 8; else if (n < 16) b = 9; else if (n < 23) b = 10; else if (n < 32) b = 11;
    else if (n < 46) b = 12; else if (n < 64) b = 13; else if (n < 91) b = 14; else b = 15;
    return b + (rel > 0 ? 16 : 0);
}

__device__ __forceinline__ void cvt_item(const float* W, int ldw, int k0, int n0, bf16_t* WT, int ldd, int drow, const float* nscale, LAS float* scr, int lane) {
    const int lr = lane >> 4, lc = (lane & 15) * 4;
    f32x4 v[16];
    const float* src = W + (size_t)(k0 + lr) * ldw + n0 + lc;
#pragma unroll
    for (int i = 0; i < 16; ++i) v[i] = __builtin_nontemporal_load((const GAS f32x4*)(src + (size_t)(4 * i) * ldw));
#pragma unroll
    for (int i = 0; i < 16; ++i) { const int row = 4 * i + lr; *(LAS f32x4*)(scr + row * 64 + (lc ^ (4 * ((row >> 3) & 7)))) = v[i]; }
    LDS_WAIT(); asm volatile("" ::: "memory");
    const int c = lane & 7;
#pragma unroll
    for (int j = 0; j < 8; ++j) { const int n = (lane >> 3) + 8 * j; const LAS float* sp = scr + (8 * c) * 64 + (n ^ (4 * c)); const float sc = nscale ? nscale[n0 + n] : 1.0f;
        u32x4 o; o.x = pk2(sp[0 * 64] * sc, sp[1 * 64] * sc); o.y = pk2(sp[2 * 64] * sc, sp[3 * 64] * sc); o.z = pk2(sp[4 * 64] * sc, sp[5 * 64] * sc); o.w = pk2(sp[6 * 64] * sc, sp[7 * 64] * sc);
        __builtin_nontemporal_store(o, (GAS u32x4*)(WT + (size_t)(drow + n) * ldd + k0 + 8 * c)); }
    LDS_WAIT(); asm volatile("" ::: "memory");
}
__device__ __forceinline__ void norm_store_bf16(const f32x4 (&v)[8], const float* g, bf16_t* orow, int lane) {
    float ss = 0.f;
#pragma unroll
    for (int j = 0; j < 8; ++j) ss += (v[j].x * v[j].x + v[j].y * v[j].y) + (v[j].z * v[j].z + v[j].w * v[j].w);
    const float r = rsqrtf(wave_sum(ss, lane) * (1.0f / D) + EPS);
    GAS u32x2* o8 = (GAS u32x2*)orow + lane; const GAS f32x4* g4 = (const GAS f32x4*)g + lane;
#pragma unroll
    for (int j = 0; j < 8; ++j) { const f32x4 w = g4[64 * j]; u32x2 o; o.x = pk2(v[j].x * r * w.x, v[j].y * r * w.y); o.y = pk2(v[j].z * r * w.z, v[j].w * r * w.w); o8[64 * j] = o; }
}

#ifndef MK_ODDMIX2
#define MK_ODDMIX2 1
#endif
#ifndef MK_PV3
#define MK_PV3 1
#endif
#ifndef MK_UPHOST
#define MK_UPHOST 1
#endif
#ifndef MK_JITCVT
#define MK_JITCVT 1
#endif
__device__ __forceinline__ void moe_cvt(const Args& a, const Ctx& c, int l, int part, int rank0 = -1, int nrank = 0, int it_lo = 0, int it_hi = NE * 16 * 32) {
    LAS float* scr = (LAS float*)(c.lds + c.wave * 16384);
    int gw = (rank0 >= 0 ? rank0 : c.vcu) * NWAVES + c.wave; asm volatile("" : "+s"(gw));
    const int NGW = (rank0 >= 0 ? nrank : c.G) * NWAVES;
    unsigned char* ws = a.ws;
    const float* wsrc = (const float*)(((const unsigned long long*)((const float*)(ws + WS_PAR) + PAR_PTRS))[part]);
    if (part < 2) {
        for (int it = it_lo + gw; it < it_hi; it += NGW) { const int le = l * NE + it / 512, r2 = it % 512, kb = r2 / 16, nb = r2 % 16;
            const float* src = wsrc + (size_t)le * D * EH; const int n0 = nb * 64;
            cvt_item(src, EH, kb * 64, n0, (bf16_t*)(ws + WS_GU) + (size_t)le * 2048 * D, D, (n0 >> 7) * 256 + part * 128 + (n0 & 127), nullptr, scr, c.lane); }
    } else {
        for (int it = it_lo + gw; it < it_hi; it += NGW) { const int le = l * NE + it / 512, r = it % 512, kb = r / 32, nb = r % 32;
            cvt_item(wsrc + (size_t)le * EH * D, D, kb * 64, nb * 64, (bf16_t*)(ws + WS_DN) + (size_t)le * D * EH, EH, nb * 64, nullptr, scr, c.lane); }
    }
}

__device__ __forceinline__ u32x4 fftc_bfrag(const LAS float* c128, int w, int ks, int t, int fr, int fq) {
#if MK_FFTFUSE
    const int pq = t, k2 = 16 * w + fr; unsigned wv[4];
#else
    const int pq = w >> 2, k2 = 32 * (w & 3) + 16 * t + fr; unsigned wv[4];
#endif
#pragma unroll
    for (int jj = 0; jj < 4; ++jj) { float v[2];
#pragma unroll
        for (int e = 0; e < 2; ++e) { const int j = 2 * jj + e; const int ss = 32 * ks + 16 * (j >> 2) + 4 * fq + (j & 3); const int ri = ss >> 7, s2 = ss & 127; const int m = (s2 * k2) & 127;
            const float cs = c128[m], sn = c128[(m - 32) & 127];
            v[e] = (pq == 0) ? (ri == 0 ? cs : sn) : (ri == 0 ? -sn : cs); }
        wv[jj] = pk2(v[0], v[1]); }
    u32x4 ww; ww.x = wv[0]; ww.y = wv[1]; ww.z = wv[2]; ww.w = wv[3]; return ww;
}
__device__ __forceinline__ u32x4 fftc_cfrag(const LAS float* c128, int lt, int kap, int plane, int fr, int fq) {
    const int l = 16 * lt + fr; unsigned wv[4];
#pragma unroll
    for (int jj = 0; jj < 4; ++jj) { float v[2];
#pragma unroll
        for (int e = 0; e < 2; ++e) { const int j = 2 * jj + e; const int cch = 32 * kap + 16 * (j >> 2) + 4 * fq + (j & 3); const int m = (l * cch) & 127;
            v[e] = (plane == 0 ? c128[m] : c128[(m - 32) & 127]) * (1.0f / 1024.0f); }
        wv[jj] = pk2(v[0], v[1]); }
    u32x4 ww; ww.x = wv[0]; ww.y = wv[1]; ww.z = wv[2]; ww.w = wv[3]; return ww;
}
__device__ __forceinline__ void ffta_bfrag(const LAS float* c128, int jp, int ks, int fr, int fq, u32x4& wr_, u32x4& wi_) {
    unsigned re[4], im[4];
#pragma unroll
    for (int jj = 0; jj < 4; ++jj) { float cr[2], ci[2];
#pragma unroll
        for (int e = 0; e < 2; ++e) { const int j = 2 * jj + e; const int s1 = 32 * ks + 16 * (j >> 2) + 4 * fq + (j & 3); const int m = (s1 * (16 * jp + fr)) & 63; cr[e] = c128[2 * m]; ci[e] = -c128[2 * ((m - 16) & 63)]; }
        re[jj] = pk2(cr[0], cr[1]); im[jj] = pk2(ci[0], ci[1]); }
    wr_.x = re[0]; wr_.y = re[1]; wr_.z = re[2]; wr_.w = re[3]; wi_.x = im[0]; wi_.y = im[1]; wi_.z = im[2]; wi_.w = im[3];
}

__device__ __forceinline__ void p0_prologue(const Args& a, const Ctx& c) {
    LAS float* scr = (LAS float*)(c.lds + c.wave * 16384);
    const int gw = c.vcu * NWAVES + c.wave, NGW = c.G * NWAVES;
    unsigned char* ws = a.ws;
    LAS float* ctab = (LAS float*)(c.lds + RING_BYTES + 1024);
    __syncthreads();
    if (c.tid < 128) { float sn, cs; sincospif((float)c.tid * (1.0f / 64.0f), &sn, &cs); ctab[c.tid] = cs; }
    __syncthreads();
    if (c.vcu < 8) { const int ks = c.vcu;
#pragma unroll
        for (int t = 0; t < 2; ++t) ((GAS u32x4*)(ws + WS_FTC))[((c.wave * 8 + ks) * 2 + t) * 64 + c.lane] = fftc_bfrag(ctab, c.wave, ks, t, c.lane & 15, c.lane >> 4);
    } else if (c.vcu == 8) { u32x4 wr_, wi_; ffta_bfrag(ctab, c.wave >> 1, c.wave & 1, c.lane & 15, c.lane >> 4, wr_, wi_);
        ((GAS u32x4*)(ws + WS_FTA))[(c.wave * 2 + 0) * 64 + c.lane] = wr_; ((GAS u32x4*)(ws + WS_FTA))[(c.wave * 2 + 1) * 64 + c.lane] = wi_; }
#if MK_FFTFUSE
    else if (c.vcu == 9) {
#pragma unroll
        for (int q = 0; q < 8; ++q) ((GAS u32x4*)(ws + WS_FCO))[((c.wave * 4 + (q >> 1)) * 2 + (q & 1)) * 64 + c.lane] = fftc_cfrag(ctab, c.wave, q >> 1, q & 1, c.lane & 15, c.lane >> 4); }
#endif
#pragma unroll 1
    for (int pass = 0; pass < 2; ++pass) {
#if !MK_FFTFUSE
    if ((pass == 0) == (c.wave < 4)) {
        LAS float* sw = (LAS float*)(c.lds + c.wave * 16384);
        for (int it = gw; it < (NL / 2) * 4 * 64 * 4; it += NGW) {
            const int i = it / 1024, r = it % 1024, g = r / 256, nb = (r % 256) / 4, jq = r % 4;
            const float* wsrc = a.ev_w_out + (size_t)i * D * D + (size_t)(QDIM + 128 * g) * D + nb * 32;
            const int n = c.lane & 31, jb = jq * 64 + (c.lane >> 5) * 32;
            float accv[32];
#pragma unroll
            for (int q = 0; q < 32; ++q) accv[q] = 0.f;
            for (int lp = 0; lp < 2; ++lp) {
#pragma unroll 8
                for (int q = 0; q < 32; ++q) { const int ll = 2 * q + (c.lane >> 5); sw[ll * 32 + n] = wsrc[(size_t)(lp * 64 + ll) * D + n]; }
                LDS_WAIT(); asm volatile("" ::: "memory");
                for (int ll = 0; ll < 64; ++ll) { const float wv = sw[ll * 32 + n]; const int l = lp * 64 + ll;
#pragma unroll
                    for (int q = 0; q < 32; ++q) { const int j = jb + q; const int m = ((j & 127) * l) & 127; const float cf = (j < 128) ? ctab[m] : ctab[(m - 32) & 127]; accv[q] = fmaf(cf, wv, accv[q]); } }
                LDS_WAIT(); asm volatile("" ::: "memory");
            }
            bf16_t* dst = (bf16_t*)(ws + WS_EVOUT + i * SZ_EVOUT) + (size_t)(nb * 32 + n) * MIX_LD_EV + QDIM + g * 256 + jb;
#pragma unroll
            for (int q = 0; q < 4; ++q) { u32x4 o; o.x = pk2(accv[8 * q] * (1.f / 1024.f), accv[8 * q + 1] * (1.f / 1024.f)); o.y = pk2(accv[8 * q + 2] * (1.f / 1024.f), accv[8 * q + 3] * (1.f / 1024.f));
                o.z = pk2(accv[8 * q + 4] * (1.f / 1024.f), accv[8 * q + 5] * (1.f / 1024.f)); o.w = pk2(accv[8 * q + 6] * (1.f / 1024.f), accv[8 * q + 7] * (1.f / 1024.f)); *(GAS u32x4*)(dst + 8 * q) = o; }
        }
    }
#endif
    if (pass == 0) {
    for (int it = gw; it < (NL / 2) * 32 * 48; it += NGW) { const int i = it / (32 * 48), r = it % (32 * 48), kb = r / 48, nb = r % 48;
        const int n0 = nb * 64; const int drow = n0 < 2048 ? n0 : (n0 < 2560 ? n0 + 512 : n0 - 512);
        cvt_item(a.ev_w_in + (size_t)i * D * EV_IN, EV_IN, kb * 64, n0, (bf16_t*)(ws + WS_EVIN + i * SZ_EVIN), D, drow, nullptr, scr, c.lane); }
    constexpr int EVO_KB = MK_FFTFUSE ? 32 : 24;
    for (int it = gw; it < (NL / 2) * EVO_KB * 32; it += NGW) { const int i = it / (EVO_KB * 32), r = it % (EVO_KB * 32), kb = r / 32, nb = r % 32;
        cvt_item(a.ev_w_out + (size_t)i * D * D, D, kb * 64, nb * 64, (bf16_t*)(ws + WS_EVOUT + i * SZ_EVOUT), MIX_LD_EV, nb * 64, nullptr, scr, c.lane); }
    for (int it = gw; it < (NL / 2) * 32 * 64; it += NGW) { const int i = it / (32 * 64), r = it % (32 * 64), kb = r / 64, nb = r % 64;
        cvt_item(a.od_w_in + (size_t)i * D * OD_IN, OD_IN, kb * 64, nb * 64, (bf16_t*)(ws + WS_ODIN + i * SZ_ODIN), D, nb * 64, nullptr, scr, c.lane); }
    for (int it = gw; it < (NL / 2) * 32 * 32; it += NGW) { const int i = it / (32 * 32), r = it % (32 * 32), kb = r / 32, nb = r % 32;
        cvt_item(a.od_w_out + (size_t)i * D * D, D, kb * 64, nb * 64, (bf16_t*)(ws + WS_ODOUT + i * SZ_ODOUT), D, nb * 64, nullptr, scr, c.lane); }
    for (int it = gw; it < (NL / 2) * 4 * 4 * 4; it += NGW) { const int ig = it / 16, i = ig / 4, g = ig % 4, r = it % 16, kb = r / 4, nb = r % 4;
        cvt_item(a.od_pool_w + ((size_t)i * 4 + g) * 65536, 256, kb * 64, nb * 64, (bf16_t*)(ws + WS_POOLW + i * SZ_POOL) + g * 65536, 256, nb * 64, a.od_pool_scale + i * POOLD + g * 256, scr, c.lane); }
    }
    }
    __syncthreads();
    {
        float* par = (float*)(ws + WS_PAR); const int gt = c.vcu * NTHREADS + c.tid, NGT = c.G * NTHREADS;
        if (gt == 0) { unsigned long long* pp = (unsigned long long*)(par + PAR_PTRS); pp[0] = (unsigned long long)a.moe_w_gate; pp[1] = (unsigned long long)a.moe_w_up; pp[2] = (unsigned long long)a.moe_w_down; }
        for (int i = gt; i < 384; i += NGT) par[PAR_RELB + i] = a.rel_bias[i];
        for (int i = gt; i < (NL / 2) * NQ; i += NGT) par[PAR_SINK + i] = a.ev_sink[i];
        for (int i = gt; i < NL * D; i += NGT) { par[PAR_GMIX + i] = a.norm_mix_g[i]; par[PAR_GFFN + i] = a.norm_ffn_g[i]; }
        for (int i = gt; i < D; i += NGT) par[PAR_GFIN + i] = a.final_g[i];
        for (int i = gt; i < (NL / 2) * 3 * CONVD; i += NGT) par[PAR_CONV + i] = a.od_conv_w[i];
        for (int i = gt; i < NL * D * NE; i += NGT) { const int l = i / (D * NE), r = i % (D * NE), e = r / D, d = r % D; par[PAR_ROUTER + i] = a.moe_w_router[(size_t)l * D * NE + d * NE + e]; }
    }
    for (int m = gw; m < S; m += 2 * NGW) { const int m1 = (m + NGW) < S ? m + NGW : m;
        const GAS f32x4* xa = (const GAS f32x4*)(a.x_in + (size_t)m * D) + c.lane; const GAS f32x4* xb = (const GAS f32x4*)(a.x_in + (size_t)m1 * D) + c.lane; f32x4 va[8], vb[8];
#pragma unroll
        for (int j = 0; j < 8; ++j) { va[j] = xa[64 * j]; vb[j] = xb[64 * j]; }
        norm_store_bf16(va, a.norm_mix_g, (bf16_t*)(ws + WS_H) + (size_t)m * D, c.lane);
        if (m1 != m) norm_store_bf16(vb, a.norm_mix_g, (bf16_t*)(ws + WS_H) + (size_t)m1 * D, c.lane); }
}

__device__ __forceinline__ void attn_unit(const Args& a, const Ctx& c, int layer_i, int blk, int kvh) {
    const bf16_t* QKF = (const bf16_t*)(a.ws + WS_Z); const bf16_t* VT = (const bf16_t*)(a.ws + WS_VT); bf16_t* MIX = (bf16_t*)(a.ws + WS_MIX);
    LAS unsigned char* band = c.lds;
    LAS float* bt = (LAS float*)(c.lds + 98304);
    const float* par = (const float*)(a.ws + WS_PAR);
    const int kb0 = 128 * (blk - 1);
    bf16x8 qfa[3][4];
    { const int fr_ = c.lane & 15, fq_ = c.lane >> 4; unsigned qoff = (unsigned)(((blk * 8 + c.wave) * 16 + fr_) * QKF_LD + kvh * 3 * HD + 8 * fq_) * 2u; asm volatile("" : "+v"(qoff));
#pragma unroll
      for (int hh = 0; hh < 3; ++hh)
#pragma unroll
          for (int ks = 0; ks < 4; ++ks) qfa[hh][ks] = *(const GAS bf16x8*)((const GAS char*)QKF + (size_t)qoff + hh * HD * 2 + 64 * ks); }
    __syncthreads();
    u32x4 kreg[12];
#pragma unroll
    for (int p = 0; p < 12; ++p) { const int id = c.tid + NTHREADS * p, row = id >> 4, ch = id & 15, key = kb0 + row; const int kc = key < 0 ? 0 : (key > S - 1 ? S - 1 : key);
        kreg[p] = *(const GAS u32x4*)(QKF + (size_t)kc * QKF_LD + QDIM + kvh * HD + ch * 8); }
    for (int i = c.tid; i < 3 * 257; i += NTHREADS) { const int hh = i / 257, r = i % 257; bt[hh * 260 + r] = par[PAR_RELB + t5_bucket(r - 128) * NQ + kvh * 3 + hh] * 1.4426950408889634f; }
#pragma unroll
    for (int p = 0; p < 12; ++p) { const int id = c.tid + NTHREADS * p, row = id >> 4, ch = id & 15, key = kb0 + row;
        if (key >= 0 && key < S) *(LAS u32x4*)(band + row * 256 + ((ch ^ (row & 15)) << 4)) = kreg[p]; }
    __syncthreads();
    const int fr = c.lane & 15, fq = c.lane >> 4, w = c.wave;
    const int q0 = (blk * 8 + w) * 16;
    unsigned pw[3][9][4]; float inv[3];
#pragma unroll
    for (int hh = 0; hh < 3; ++hh) {
        const int h = kvh * 3 + hh; const float snk = par[PAR_SINK + layer_i * NQ + h] * 1.4426950408889634f;
        bf16x8 qf[4];
#pragma unroll
        for (int ks = 0; ks < 4; ++ks) qf[ks] = qfa[hh][ks];
        f32x4 s[17];
#pragma unroll
        for (int kt = 0; kt < 17; ++kt) {
            const int key0 = q0 - WIN + 16 * kt;
            f32x4 acc = (f32x4){0.f, 0.f, 0.f, 0.f};
            if (key0 >= 0 && key0 < S) {
                const LAS unsigned char* kp = band + (16 * (w + kt) + fr) * 256;
#pragma unroll
                for (int ks = 0; ks < 4; ++ks) { const bf16x8 kf = *(const LAS bf16x8*)(kp + (((4 * ks + fq) ^ fr) << 4)); acc = __builtin_amdgcn_mfma_f32_16x16x32_bf16(kf, qf[ks], acc, 0, 0, 0); }
#pragma unroll
                for (int r = 0; r < 4; ++r) { const int rel = 16 * kt - WIN + 4 * fq + r - fr;
                    if (kt == 0 || kt == 16) { const bool ok = (rel >= -WIN) && (rel <= WIN); acc[r] = ok ? acc[r] * 0.12751743082459664f + bt[hh * 260 + (ok ? rel + WIN : 0)] : -1e30f; }
                    else acc[r] = acc[r] * 0.12751743082459664f + bt[hh * 260 + rel + WIN]; }
            } else { acc = (f32x4){-1e30f, -1e30f, -1e30f, -1e30f}; }
            s[kt] = acc;
        }
        float mx = -3.0e38f;
#pragma unroll
        for (int kt = 0; kt < 17; ++kt) mx = fmaxf(mx, fmaxf(fmaxf(s[kt][0], s[kt][1]), fmaxf(s[kt][2], s[kt][3])));
        mx = fmaxf(mx, shx(mx, 16, c.lane)); mx = fmaxf(mx, shx(mx, 32, c.lane)); mx = fmaxf(mx, snk);
        float sum = 0.f;
#pragma unroll
        for (int kt = 0; kt < 17; ++kt)
#pragma unroll
            for (int r = 0; r < 4; ++r) { const float pv = __builtin_amdgcn_exp2f(s[kt][r] - mx); s[kt][r] = pv; sum += pv; }
        sum += shx(sum, 16, c.lane); sum += shx(sum, 32, c.lane);
        inv[hh] = 1.0f / (sum + __builtin_amdgcn_exp2f(snk - mx));
        if (w & 1) {
#pragma unroll
            for (int kp = 0; kp < 9; ++kp) { pw[hh][kp][0] = (kp > 0) ? cvt_pk_bf16_v(s[kp > 0 ? 2 * kp - 1 : 0][0], s[kp > 0 ? 2 * kp - 1 : 0][1]) : 0u; pw[hh][kp][1] = (kp > 0) ? cvt_pk_bf16_v(s[kp > 0 ? 2 * kp - 1 : 0][2], s[kp > 0 ? 2 * kp - 1 : 0][3]) : 0u;
                pw[hh][kp][2] = cvt_pk_bf16_v(s[2 * kp][0], s[2 * kp][1]); pw[hh][kp][3] = cvt_pk_bf16_v(s[2 * kp][2], s[2 * kp][3]); }
        } else {
#pragma unroll
            for (int kp = 0; kp < 9; ++kp) { pw[hh][kp][0] = cvt_pk_bf16_v(s[2 * kp][0], s[2 * kp][1]); pw[hh][kp][1] = cvt_pk_bf16_v(s[2 * kp][2], s[2 * kp][3]);
                pw[hh][kp][2] = (kp < 8) ? cvt_pk_bf16_v(s[kp < 8 ? 2 * kp + 1 : 16][0], s[kp < 8 ? 2 * kp + 1 : 16][1]) : 0u; pw[hh][kp][3] = (kp < 8) ? cvt_pk_bf16_v(s[kp < 8 ? 2 * kp + 1 : 16][2], s[kp < 8 ? 2 * kp + 1 : 16][3]) : 0u; }
        }
        __builtin_amdgcn_sched_barrier(0);
    }
    __syncthreads();
#pragma unroll
    for (int p = 0; p < 12; ++p) { const int id = c.tid + NTHREADS * p, d = id / 48, pc = id % 48, b = pc >> 2, m = pc & 3, key = kb0 + 32 * b + 8 * m;
        u32x4 v = (u32x4){0u, 0u, 0u, 0u};
        if (key >= 0 && key < S) v = *(const GAS u32x4*)(VT + (size_t)(kvh * HD + d) * S + key);
        const int c0 = 4 * b + 2 * (m & 1), t = m >> 1; LAS unsigned char* rowp = band + d * 768;
        u32x2 lo; lo.x = v.x; lo.y = v.y; u32x2 hi; hi.x = v.z; hi.y = v.w;
        *(LAS u32x2*)(rowp + ((((c0 >> 4) << 4) + ((c0 & 15) ^ (d & 15))) << 4) + 8 * t) = lo;
        *(LAS u32x2*)(rowp + (((((c0 + 1) >> 4) << 4) + (((c0 + 1) & 15) ^ (d & 15))) << 4) + 8 * t) = hi; }
    __syncthreads();
#if MK_PV3
    {
        f32x4 o[3][8];
#pragma unroll
        for (int hh = 0; hh < 3; ++hh)
#pragma unroll
            for (int dt = 0; dt < 8; ++dt) o[hh][dt] = (f32x4){0.f, 0.f, 0.f, 0.f};
#pragma unroll
        for (int kp = 0; kp < 9; ++kp) {
            bf16x8 pf[3];
#pragma unroll
            for (int hh = 0; hh < 3; ++hh) { u32x4 pq; pq.x = pw[hh][kp][0]; pq.y = pw[hh][kp][1]; pq.z = pw[hh][kp][2]; pq.w = pw[hh][kp][3]; pf[hh] = __builtin_bit_cast(bf16x8, pq); }
            const int cc = 4 * ((w >> 1) + kp) + fq;
            const int poff = (((cc >> 4) << 4) + ((cc & 15) ^ fr)) << 4;
#pragma unroll
            for (int dt = 0; dt < 8; ++dt) { const bf16x8 vf = *(const LAS bf16x8*)(band + (16 * dt + fr) * 768 + poff);
#pragma unroll
                for (int hh = 0; hh < 3; ++hh) o[hh][dt] = __builtin_amdgcn_mfma_f32_16x16x32_bf16(vf, pf[hh], o[hh][dt], 0, 0, 0); }
        }
#pragma unroll
        for (int hh = 0; hh < 3; ++hh) { const int h = kvh * 3 + hh;
            unsigned ooff = (unsigned)((q0 + fr) * MIX_LD_EV + h * HD + 4 * fq) * 2u; asm volatile("" : "+v"(ooff));
            const float iv = inv[hh];
#pragma unroll
            for (int dt = 0; dt < 8; ++dt) { u32x2 wv; wv.x = cvt_pk_bf16(o[hh][dt][0] * iv, o[hh][dt][1] * iv); wv.y = cvt_pk_bf16(o[hh][dt][2] * iv, o[hh][dt][3] * iv); *(GAS u32x2*)((GAS char*)MIX + (size_t)ooff + 32 * dt) = wv; } }
    }
#else
#pragma unroll
    for (int hh = 0; hh < 3; ++hh) {
        const int h = kvh * 3 + hh;
        f32x4 o[8];
#pragma unroll
        for (int dt = 0; dt < 8; ++dt) o[dt] = (f32x4){0.f, 0.f, 0.f, 0.f};
#pragma unroll
        for (int kp = 0; kp < 9; ++kp) {
            u32x4 pq; pq.x = pw[hh][kp][0]; pq.y = pw[hh][kp][1]; pq.z = pw[hh][kp][2]; pq.w = pw[hh][kp][3];
            const bf16x8 pf = __builtin_bit_cast(bf16x8, pq);
            const int cc = 4 * ((w >> 1) + kp) + fq;
            const int poff = (((cc >> 4) << 4) + ((cc & 15) ^ fr)) << 4;
#pragma unroll
            for (int dt = 0; dt < 8; ++dt) { const bf16x8 vf = *(const LAS bf16x8*)(band + (16 * dt + fr) * 768 + poff);
                o[dt] = __builtin_amdgcn_mfma_f32_16x16x32_bf16(vf, pf, o[dt], 0, 0, 0); }
        }
        unsigned ooff = (unsigned)((q0 + fr) * MIX_LD_EV + h * HD + 4 * fq) * 2u; asm volatile("" : "+v"(ooff));
        const float iv = inv[hh];
#pragma unroll
        for (int dt = 0; dt < 8; ++dt) { u32x2 wv; wv.x = cvt_pk_bf16(o[dt][0] * iv, o[dt][1] * iv); wv.y = cvt_pk_bf16(o[dt][2] * iv, o[dt][3] * iv); *(GAS u32x2*)((GAS char*)MIX + (size_t)ooff + 32 * dt) = wv; }
    }
#endif
}

typedef short v4i16_t __attribute__((ext_vector_type(4)));
__device__ __forceinline__ s16x4 tr_read(const LAS unsigned char* p) { return __builtin_bit_cast(s16x4, __builtin_amdgcn_ds_read_tr16_b64_v4i16((LAS v4i16_t*)p)); }

constexpr int XS = 544;
__device__ __forceinline__ void ffta_unit(const Args& a, const Ctx& c, int g, int sb) {
    const bf16_t* F = (const bf16_t*)(a.ws + WS_Z) + QDIM + KVDIM + g * 128;
    bf16_t* TB = (bf16_t*)(a.ws + WS_TB);
    LAS unsigned char* X = c.lds;
    __syncthreads();
#pragma unroll
    for (int p = 0; p < 4; ++p) { const int id = c.tid + NTHREADS * p, s1 = id >> 5, ch = id & 31, ds2 = ch >> 4, c8 = (ch & 15) * 8;
        const u32x4 v = *(const GAS u32x4*)(F + (size_t)(128 * s1 + 2 * sb + ds2) * QKF_LD + c8);
        *(LAS u32x4*)(X + s1 * XS + (ds2 * 128 + c8) * 2) = v; }
    __syncthreads();
    const int fr = c.lane & 15, fq = c.lane >> 4, w = c.wave;
    bf16x8 af[2][2];
#pragma unroll
    for (int mt = 0; mt < 2; ++mt)
#pragma unroll
        for (int ks = 0; ks < 2; ++ks) {
            const LAS unsigned char* ap = X + (32 * ks + 4 * fq + (fr >> 2)) * XS + (32 * w + 16 * mt + 4 * (fr & 3)) * 2;
            const s16x4 t0 = tr_read(ap), t1 = tr_read(ap + 16 * XS);
            bf16x8 f; f[0] = t0[0]; f[1] = t0[1]; f[2] = t0[2]; f[3] = t0[3]; f[4] = t1[0]; f[5] = t1[1]; f[6] = t1[2]; f[7] = t1[3]; af[mt][ks] = f; }
    f32x4 acc[2][4][2];
#pragma unroll
    for (int jp = 0; jp < 4; ++jp) {
        bf16x8 bfr[2][2];
#pragma unroll
        for (int ks = 0; ks < 2; ++ks) { const GAS u32x4* ft = (const GAS u32x4*)(a.ws + WS_FTA) + ((jp * 2 + ks) * 2) * 64 + c.lane;
            bfr[0][ks] = __builtin_bit_cast(bf16x8, ft[0]); bfr[1][ks] = __builtin_bit_cast(bf16x8, ft[64]); }
#pragma unroll
        for (int mt = 0; mt < 2; ++mt) { f32x4 ar = (f32x4){0.f, 0.f, 0.f, 0.f}, ai = (f32x4){0.f, 0.f, 0.f, 0.f};
#pragma unroll
            for (int ks = 0; ks < 2; ++ks) { ar = __builtin_amdgcn_mfma_f32_16x16x32_bf16(af[mt][ks], bfr[0][ks], ar, 0, 0, 0); ai = __builtin_amdgcn_mfma_f32_16x16x32_bf16(af[mt][ks], bfr[1][ks], ai, 0, 0, 0); }
            acc[mt][jp][0] = ar; acc[mt][jp][1] = ai; }
        __builtin_amdgcn_sched_barrier(0);
    }
    const int s2 = 2 * sb + (w >> 2);
#pragma unroll
    for (int jp = 0; jp < 4; ++jp) { const int k1 = 16 * jp + fr; float sn, cs; sincospif((float)(s2 * k1) * (1.0f / 4096.0f), &sn, &cs);
#pragma unroll
        for (int mt = 0; mt < 2; ++mt) { const f32x4 re = acc[mt][jp][0], im = acc[mt][jp][1]; const int cc = 32 * (w & 3) + 16 * mt + 4 * fq;
            u32x2 tr, ti; tr.x = cvt_pk_bf16(re[0] * cs + im[0] * sn, re[1] * cs + im[1] * sn); tr.y = cvt_pk_bf16(re[2] * cs + im[2] * sn, re[3] * cs + im[3] * sn);
            ti.x = cvt_pk_bf16(im[0] * cs - re[0] * sn, im[1] * cs - re[1] * sn); ti.y = cvt_pk_bf16(im[2] * cs - re[2] * sn, im[3] * cs - re[3] * sn);
            bf16_t* tp = TB + ((size_t)((k1 * 4 + g) * 2) * 128 + s2) * 128 + cc;
            *(GAS u32x2*)tp = tr; *(GAS u32x2*)(tp + 128 * 128) = ti; } }
}

constexpr int TS = 288;
#if MK_FFTFUSE
__device__ __forceinline__ void fftc_unit(const Args& a, const Ctx& c, int k1, int g) {
    const bf16_t* T = (const bf16_t*)(a.ws + WS_TB) + (size_t)((k1 * 4 + g) * 2) * 128 * 128; bf16_t* MIX = (bf16_t*)(a.ws + WS_MIX);
    LAS unsigned char* X = c.lds;
    constexpr int CO_LO = 256 * 288, CO_HI = RING_BYTES + 1024 + 8192;
    __syncthreads();
    u32x4 bft[8][2];
    { const GAS u32x4* ft = (const GAS u32x4*)(a.ws + WS_FTC) + (size_t)(c.wave * 16) * 64 + c.lane;
#pragma unroll
      for (int q = 0; q < 16; ++q) bft[q >> 1][q & 1] = ft[q * 64]; }
#pragma unroll
    for (int p = 0; p < 8; ++p) { const int id = c.tid + NTHREADS * p, row = id >> 4, ch = id & 15; *(LAS u32x4*)(X + row * TS + ch * 16) = *(const GAS u32x4*)(T + (size_t)row * 128 + ch * 8); }
#pragma unroll
    for (int p = 0; p < 8; ++p) { const int f = (c.tid >> 6) + 8 * p; const u32x4 v = ((const GAS u32x4*)(a.ws + WS_FCO))[f * 64 + (c.tid & 63)];
        *(LAS u32x4*)(c.lds + (p < 7 ? CO_LO + f * 1024 : CO_HI + (f - 56) * 1024) + (c.tid & 63) * 16) = v; }
    __syncthreads();
    const int fr = c.lane & 15, fq = c.lane >> 4, w = c.wave;
    f32x4 acc[8][2];
#pragma unroll
    for (int mt = 0; mt < 8; ++mt) { acc[mt][0] = (f32x4){0.f, 0.f, 0.f, 0.f}; acc[mt][1] = (f32x4){0.f, 0.f, 0.f, 0.f}; }
#pragma unroll
    for (int ks = 0; ks < 8; ++ks) {
        bf16x8 bf[2]; bf[0] = __builtin_bit_cast(bf16x8, bft[ks][0]); bf[1] = __builtin_bit_cast(bf16x8, bft[ks][1]);
#pragma unroll
        for (int mt = 0; mt < 8; ++mt) {
            const LAS unsigned char* ap = X + (32 * ks + 4 * fq + (fr >> 2)) * TS + (16 * mt + 4 * (fr & 3)) * 2;
            const s16x4 t0 = tr_read(ap), t1 = tr_read(ap + 16 * TS);
            bf16x8 af; af[0] = t0[0]; af[1] = t0[1]; af[2] = t0[2]; af[3] = t0[3]; af[4] = t1[0]; af[5] = t1[1]; af[6] = t1[2]; af[7] = t1[3];
            acc[mt][0] = __builtin_amdgcn_mfma_f32_16x16x32_bf16(af, bf[0], acc[mt][0], 0, 0, 0);
            acc[mt][1] = __builtin_amdgcn_mfma_f32_16x16x32_bf16(af, bf[1], acc[mt][1], 0, 0, 0);
        }
        __builtin_amdgcn_sched_barrier(0);
    }
    bf16x8 pb[4][2];
#pragma unroll
    for (int kap = 0; kap < 4; ++kap)
#pragma unroll
        for (int pl = 0; pl < 2; ++pl) { u32x4 q; q.x = cvt_pk_bf16(acc[2 * kap][pl][0], acc[2 * kap][pl][1]); q.y = cvt_pk_bf16(acc[2 * kap][pl][2], acc[2 * kap][pl][3]);
            q.z = cvt_pk_bf16(acc[2 * kap + 1][pl][0], acc[2 * kap + 1][pl][1]); q.w = cvt_pk_bf16(acc[2 * kap + 1][pl][2], acc[2 * kap + 1][pl][3]); pb[kap][pl] = __builtin_bit_cast(bf16x8, q); }
    bf16_t* op = MIX + (size_t)(k1 + 64 * (16 * w + fr)) * MIX_LD_EV + QDIM + g * 128 + 4 * fq;
#pragma unroll
    for (int lt = 0; lt < 8; ++lt) { f32x4 o = (f32x4){0.f, 0.f, 0.f, 0.f};
#pragma unroll
        for (int kap = 0; kap < 4; ++kap)
#pragma unroll
            for (int pl = 0; pl < 2; ++pl) { const int f = (lt * 4 + kap) * 2 + pl; const bf16x8 cf = *(const LAS bf16x8*)(c.lds + (f < 56 ? CO_LO + f * 1024 : CO_HI + (f - 56) * 1024) + c.lane * 16);
                o = __builtin_amdgcn_mfma_f32_16x16x32_bf16(cf, pb[kap][pl], o, 0, 0, 0); }
        u32x2 ov; ov.x = cvt_pk_bf16(o[0], o[1]); ov.y = cvt_pk_bf16(o[2], o[3]); *(GAS u32x2*)(op + 16 * lt) = ov; }
}
#else
__device__ __forceinline__ void fftc_unit(const Args& a, const Ctx& c, int k1, int g) {
    const bf16_t* T = (const bf16_t*)(a.ws + WS_TB) + (size_t)((k1 * 4 + g) * 2) * 128 * 128; bf16_t* MIX = (bf16_t*)(a.ws + WS_MIX);
    LAS unsigned char* X = c.lds;
    __syncthreads();
    u32x4 bft[8][2];
    { const GAS u32x4* ft = (const GAS u32x4*)(a.ws + WS_FTC) + (size_t)(c.wave * 16) * 64 + c.lane;
#pragma unroll
      for (int q = 0; q < 16; ++q) bft[q >> 1][q & 1] = ft[q * 64]; }
#pragma unroll
    for (int p = 0; p < 8; ++p) { const int id = c.tid + NTHREADS * p, row = id >> 4, ch = id & 15; *(LAS u32x4*)(X + row * TS + ch * 16) = *(const GAS u32x4*)(T + (size_t)row * 128 + ch * 8); }
    __syncthreads();
    const int fr = c.lane & 15, fq = c.lane >> 4, w = c.wave, pq = w >> 2;
    f32x4 acc[8][2];
#pragma unroll
    for (int mt = 0; mt < 8; ++mt) { acc[mt][0] = (f32x4){0.f, 0.f, 0.f, 0.f}; acc[mt][1] = (f32x4){0.f, 0.f, 0.f, 0.f}; }
#pragma unroll
    for (int ks = 0; ks < 8; ++ks) {
        bf16x8 bf[2]; bf[0] = __builtin_bit_cast(bf16x8, bft[ks][0]); bf[1] = __builtin_bit_cast(bf16x8, bft[ks][1]);
#pragma unroll
        for (int mt = 0; mt < 8; ++mt) {
            const LAS unsigned char* ap = X + (32 * ks + 4 * fq + (fr >> 2)) * TS + (16 * mt + 4 * (fr & 3)) * 2;
            const s16x4 t0 = tr_read(ap), t1 = tr_read(ap + 16 * TS);
            bf16x8 af; af[0] = t0[0]; af[1] = t0[1]; af[2] = t0[2]; af[3] = t0[3]; af[4] = t1[0]; af[5] = t1[1]; af[6] = t1[2]; af[7] = t1[3];
            acc[mt][0] = __builtin_amdgcn_mfma_f32_16x16x32_bf16(af, bf[0], acc[mt][0], 0, 0, 0);
            acc[mt][1] = __builtin_amdgcn_mfma_f32_16x16x32_bf16(af, bf[1], acc[mt][1], 0, 0, 0);
        }
        __builtin_amdgcn_sched_barrier(0);
    }
#pragma unroll
    for (int t = 0; t < 2; ++t) { const int k2 = 32 * (w & 3) + 16 * t + fr; bf16_t* op = MIX + (size_t)(k1 + 64 * k2) * MIX_LD_EV + QDIM + g * 256 + pq * 128 + 4 * fq;
#pragma unroll
        for (int mt = 0; mt < 8; ++mt) { u32x2 o; o.x = cvt_pk_bf16(acc[mt][t][0], acc[mt][t][1]); o.y = cvt_pk_bf16(acc[mt][t][2], acc[mt][t][3]); *(GAS u32x2*)(op + 16 * mt) = o; } }
}
#endif

__device__ __forceinline__ void bf8_to_f32(const u32x4 w, float (&f)[8]) { f[0] = bf_lo(w.x); f[1] = bf_hi(w.x); f[2] = bf_lo(w.y); f[3] = bf_hi(w.y); f[4] = bf_lo(w.z); f[5] = bf_hi(w.z); f[6] = bf_lo(w.w); f[7] = bf_hi(w.w); }
__device__ __forceinline__ void oddmix_unit(const Args& a, const Ctx& c, int layer_i, int unit) {
    const bf16_t* Z = (const bf16_t*)(a.ws + WS_Z); bf16_t* MIX = (bf16_t*)(a.ws + WS_MIX); bf16_t* PO = (bf16_t*)(a.ws + WS_POOLED);
    if (c.wave < 4) {
        const int t0 = unit * 32 + (c.wave >> 1) * 16, ch = ((c.wave & 1) * 64 + c.lane) * 8;
        const float* cw = (const float*)(a.ws + WS_PAR) + PAR_CONV + layer_i * 3 * CONVD + ch;
        float w0[8], w1[8], w2[8];
#pragma unroll
        for (int q = 0; q < 8; ++q) { w0[q] = cw[q]; w1[q] = cw[CONVD + q]; w2[q] = cw[2 * CONVD + q]; }
        float pm[8], pc[8], pn[8], fa[8], fb[8];
#pragma unroll
        for (int q = 0; q < 8; ++q) pm[q] = 0.f;
        if (t0 > 0) { bf8_to_f32(*(const GAS u32x4*)(Z + (size_t)(t0 - 1) * OD_IN + CONVD + ch), fa); bf8_to_f32(*(const GAS u32x4*)(Z + (size_t)(t0 - 1) * OD_IN + 2 * CONVD + ch), fb);
#pragma unroll
            for (int q = 0; q < 8; ++q) pm[q] = fa[q] * fb[q]; }
        bf8_to_f32(*(const GAS u32x4*)(Z + (size_t)t0 * OD_IN + CONVD + ch), fa); bf8_to_f32(*(const GAS u32x4*)(Z + (size_t)t0 * OD_IN + 2 * CONVD + ch), fb);
#pragma unroll
        for (int q = 0; q < 8; ++q) pc[q] = fa[q] * fb[q];
#pragma unroll 4
        for (int t = t0; t < t0 + 16; ++t) {
#pragma unroll
            for (int q = 0; q < 8; ++q) pn[q] = 0.f;
            if (t + 1 < S) { bf8_to_f32(*(const GAS u32x4*)(Z + (size_t)(t + 1) * OD_IN + CONVD + ch), fa); bf8_to_f32(*(const GAS u32x4*)(Z + (size_t)(t + 1) * OD_IN + 2 * CONVD + ch), fb);
#pragma unroll
                for (int q = 0; q < 8; ++q) pn[q] = fa[q] * fb[q]; }
            bf8_to_f32(*(const GAS u32x4*)(Z + (size_t)t * OD_IN + ch), fa);
            float o[8];
#pragma unroll
            for (int q = 0; q < 8; ++q) { o[q] = fa[q] * (w0[q] * pm[q] + w1[q] * pc[q] + w2[q] * pn[q]); pm[q] = pc[q]; pc[q] = pn[q]; }
            u32x4 ov; ov.x = pk2(o[0], o[1]); ov.y = pk2(o[2], o[3]); ov.z = pk2(o[4], o[5]); ov.w = pk2(o[6], o[7]);
            *(GAS u32x4*)(MIX + (size_t)t * D + ch) = ov;
        }
    } else {
        const int g = c.wave - 4, lo = 1 << g, hi = lo - 1;
        const int t0 = unit * 32 + (c.lane >> 5) * 16, ch = g * 256 + (c.lane & 31) * 8;
        const bf16_t* zp = Z + 3 * CONVD + ch;
        float sm[8], fa[8];
#pragma unroll
        for (int q = 0; q < 8; ++q) sm[q] = 0.f;
        for (int tt = t0 - lo; tt <= t0 + hi; ++tt) if (tt >= 0 && tt < S) { bf8_to_f32(*(const GAS u32x4*)(zp + (size_t)tt * OD_IN), fa);
#pragma unroll
            for (int q = 0; q < 8; ++q) sm[q] += fa[q]; }
#pragma unroll 2
        for (int t = t0; t < t0 + 16; ++t) {
            const int aa = t - lo < 0 ? 0 : t - lo, bb = t + hi > S - 1 ? S - 1 : t + hi; const float rc = 1.0f / (float)(bb - aa + 1);
            bf8_to_f32(*(const GAS u32x4*)(zp + (size_t)t * OD_IN), fa);
            u32x4 ov; ov.x = pk2(sm[0] * rc - fa[0], sm[1] * rc - fa[1]); ov.y = pk2(sm[2] * rc - fa[2], sm[3] * rc - fa[3]); ov.z = pk2(sm[4] * rc - fa[4], sm[5] * rc - fa[5]); ov.w = pk2(sm[6] * rc - fa[6], sm[7] * rc - fa[7]);
            { const int tok = t - unit * 32; *(LAS u32x4*)(c.lds + tok * 2048 + ((((ch >> 3) & ~15) | (((ch >> 3) & 15) ^ (tok & 15))) << 4)) = ov; }
            if (t + 1 + hi < S) { bf8_to_f32(*(const GAS u32x4*)(zp + (size_t)(t + 1 + hi) * OD_IN), fa);
#pragma unroll
                for (int q = 0; q < 8; ++q) sm[q] += fa[q]; }
            if (t - lo >= 0) { bf8_to_f32(*(const GAS u32x4*)(zp + (size_t)(t - lo) * OD_IN), fa);
#pragma unroll
                for (int q = 0; q < 8; ++q) sm[q] -= fa[q]; }
        }
    }
    __syncthreads();
    {
        const int fr = c.lane & 15, fq = c.lane >> 4, g = c.wave >> 1, mt0 = 8 * (c.wave & 1);
        const bf16_t* Wp = (const bf16_t*)(a.ws + WS_POOLW + layer_i * SZ_POOL) + (size_t)g * 65536;
        bf16x8 bfr[2][8];
#pragma unroll
        for (int nt = 0; nt < 2; ++nt)
#pragma unroll
            for (int ks = 0; ks < 8; ++ks) { const int tok = 16 * nt + fr, c16 = g * 32 + 4 * ks + fq; bfr[nt][ks] = *(const LAS bf16x8*)(c.lds + tok * 2048 + (((c16 & ~15) | ((c16 & 15) ^ fr)) << 4)); }
        unsigned woff = (unsigned)((16 * mt0 + fr) * 256 + 8 * fq) * 2u; asm volatile("" : "+v"(woff));
        bf16x8 af[8], an[8];
#pragma unroll
        for (int ks = 0; ks < 8; ++ks) af[ks] = *(const GAS bf16x8*)((const GAS char*)Wp + (size_t)woff + 64 * ks);
#pragma unroll 1
        for (int mi = 0; mi < 8; ++mi) {
            if (mi + 1 < 8) {
#pragma unroll
                for (int ks = 0; ks < 8; ++ks) an[ks] = *(const GAS bf16x8*)((const GAS char*)Wp + (size_t)woff + (size_t)(mi + 1) * (16 * 256 * 2) + 64 * ks); }
            f32x4 acc0 = (f32x4){0.f, 0.f, 0.f, 0.f}, acc1 = (f32x4){0.f, 0.f, 0.f, 0.f};
#pragma unroll
            for (int ks = 0; ks < 8; ++ks) { acc0 = __builtin_amdgcn_mfma_f32_16x16x32_bf16(af[ks], bfr[0][ks], acc0, 0, 0, 0); acc1 = __builtin_amdgcn_mfma_f32_16x16x32_bf16(af[ks], bfr[1][ks], acc1, 0, 0, 0); }
            const int dcol = CONVD + g * 256 + 16 * (mt0 + mi) + 4 * fq;
            u32x2 o0; o0.x = cvt_pk_bf16(acc0[0], acc0[1]); o0.y = cvt_pk_bf16(acc0[2], acc0[3]); *(GAS u32x2*)(MIX + (size_t)(unit * 32 + fr) * D + dcol) = o0;
            u32x2 o1; o1.x = cvt_pk_bf16(acc1[0], acc1[1]); o1.y = cvt_pk_bf16(acc1[2], acc1[3]); *(GAS u32x2*)(MIX + (size_t)(unit * 32 + 16 + fr) * D + dcol) = o1;
#pragma unroll
            for (int ks = 0; ks < 8; ++ks) af[ks] = an[ks];
        }
    }
    __syncthreads();
}

template <int G>
__device__ __forceinline__ void oddmix_pool(const bf16_t* zp, int t0, int ltok, int cl, LAS unsigned char* lds) {
    constexpr int LO = 1 << G, HI = LO - 1, W = 2 * LO, NR = 8 + W - 1;
    u32x4 rw[NR];
    const bf16_t* zb = zp + (size_t)t0 * OD_IN;
#pragma unroll
    for (int r = 0; r < NR; ++r) { const int tt = t0 - LO + r; const int d = (tt >= 0 && tt < S) ? (r - LO) * OD_IN : 0; rw[r] = *(const GAS u32x4*)(zb + d); }
    float sm[8], fa[8];
#pragma unroll
    for (int q = 0; q < 8; ++q) sm[q] = 0.f;
#pragma unroll
    for (int r = 0; r < W; ++r) { const int tt = t0 - LO + r; if (tt >= 0 && tt < S) { bf8_to_f32(rw[r], fa);
#pragma unroll
        for (int q = 0; q < 8; ++q) sm[q] += fa[q]; } }
#pragma unroll
    for (int i = 0; i < 8; ++i) { const int t = t0 + i;
        const int aa = t - LO < 0 ? 0 : t - LO, bb = t + HI > S - 1 ? S - 1 : t + HI; const float rc = 1.0f / (float)(bb - aa + 1);
        bf8_to_f32(rw[i + LO], fa);
        u32x4 ov; ov.x = pk2(sm[0] * rc - fa[0], sm[1] * rc - fa[1]); ov.y = pk2(sm[2] * rc - fa[2], sm[3] * rc - fa[3]); ov.z = pk2(sm[4] * rc - fa[4], sm[5] * rc - fa[5]); ov.w = pk2(sm[6] * rc - fa[6], sm[7] * rc - fa[7]);
        { const int tok = ltok + i; *(LAS u32x4*)(lds + tok * 512 + (((cl & ~15) | ((cl & 15) ^ (tok & 15))) << 4)) = ov; }
        if (i < 7) {
            if (t + 1 + HI < S) { bf8_to_f32(rw[i + W], fa);
#pragma unroll
                for (int q = 0; q < 8; ++q) sm[q] += fa[q]; }
            if (t - LO >= 0) { bf8_to_f32(rw[i], fa);
#pragma unroll
                for (int q = 0; q < 8; ++q) sm[q] -= fa[q]; } }
    }
}
__device__ __forceinline__ void oddmix_unit2(const Args& a, const Ctx& c, int layer_i, int unit) {
    const bf16_t* Z = (const bf16_t*)(a.ws + WS_Z); bf16_t* MIX = (bf16_t*)(a.ws + WS_MIX);
    const int tb = unit >> 2, g = unit & 3;
    const int tg = c.tid >> 5, cl = c.tid & 31;
    const int t0 = tb * 128 + tg * 8, ch = g * 256 + cl * 8;
    {
        u32x4 ra[10], rb[10], rg[8];
        const bf16_t* zb = Z + (size_t)t0 * OD_IN + ch;
#pragma unroll
        for (int r = 0; r < 10; ++r) { const int tt = t0 - 1 + r; const int d = (tt >= 0 && tt < S) ? (r - 1) * OD_IN : 0;
            ra[r] = *(const GAS u32x4*)(zb + d + CONVD); rb[r] = *(const GAS u32x4*)(zb + d + 2 * CONVD); }
#pragma unroll
        for (int r = 0; r < 8; ++r) rg[r] = *(const GAS u32x4*)(zb + r * OD_IN);
        const float* cw = (const float*)(a.ws + WS_PAR) + PAR_CONV + layer_i * 3 * CONVD + ch;
        float w0[8], w1[8], w2[8];
#pragma unroll
        for (int q = 0; q < 8; ++q) { w0[q] = cw[q]; w1[q] = cw[CONVD + q]; w2[q] = cw[2 * CONVD + q]; }
        float pm[8], pc[8], pn[8], fa[8], fb[8];
        { bf8_to_f32(ra[0], fa); bf8_to_f32(rb[0], fb); const float v = (t0 - 1 >= 0) ? 1.f : 0.f;
#pragma unroll
          for (int q = 0; q < 8; ++q) pm[q] = fa[q] * fb[q] * v; }
        { bf8_to_f32(ra[1], fa); bf8_to_f32(rb[1], fb);
#pragma unroll
          for (int q = 0; q < 8; ++q) pc[q] = fa[q] * fb[q]; }
#pragma unroll
        for (int i = 0; i < 8; ++i) { const int t = t0 + i;
            bf8_to_f32(ra[i + 2], fa); bf8_to_f32(rb[i + 2], fb); const float v = (t + 1 < S) ? 1.f : 0.f;
#pragma unroll
            for (int q = 0; q < 8; ++q) pn[q] = fa[q] * fb[q] * v;
            bf8_to_f32(rg[i], fa);
            float o[8];
#pragma unroll
            for (int q = 0; q < 8; ++q) { o[q] = fa[q] * (w0[q] * pm[q] + w1[q] * pc[q] + w2[q] * pn[q]); pm[q] = pc[q]; pc[q] = pn[q]; }
            u32x4 ov; ov.x = pk2(o[0], o[1]); ov.y = pk2(o[2], o[3]); ov.z = pk2(o[4], o[5]); ov.w = pk2(o[6], o[7]);
            *(GAS u32x4*)(MIX + (size_t)t * D + ch) = ov; }
    }
    const int fr = c.lane & 15, fq = c.lane >> 4;
    const bf16_t* Wp = (const bf16_t*)(a.ws + WS_POOLW + layer_i * SZ_POOL) + (size_t)g * 65536 + (size_t)(32 * c.wave + fr) * 256 + 8 * fq;
    bf16x8 wf[2][8];
#pragma unroll
    for (int mt = 0; mt < 2; ++mt)
#pragma unroll
        for (int ks = 0; ks < 8; ++ks) wf[mt][ks] = *(const GAS bf16x8*)(Wp + mt * 16 * 256 + 32 * ks);
    { int t0p = t0; asm volatile("" : "+v"(t0p)); const bf16_t* zp = Z + 3 * CONVD + ch;
      if (g == 0) oddmix_pool<0>(zp, t0p, tg * 8, cl, c.lds); else if (g == 1) oddmix_pool<1>(zp, t0p, tg * 8, cl, c.lds); else if (g == 2) oddmix_pool<2>(zp, t0p, tg * 8, cl, c.lds); else oddmix_pool<3>(zp, t0p, tg * 8, cl, c.lds); }
    __syncthreads();
#pragma unroll
    for (int nt = 0; nt < 8; ++nt) {
        bf16x8 bfr[8];
#pragma unroll
        for (int ks = 0; ks < 8; ++ks) { const int tok = 16 * nt + fr, c16 = 4 * ks + fq; bfr[ks] = *(const LAS bf16x8*)(c.lds + tok * 512 + (((c16 & ~15) | ((c16 & 15) ^ fr)) << 4)); }
        f32x4 acc0 = (f32x4){0.f, 0.f, 0.f, 0.f}, acc1 = (f32x4){0.f, 0.f, 0.f, 0.f};
#pragma unroll
        for (int ks = 0; ks < 8; ++ks) { acc0 = __builtin_amdgcn_mfma_f32_16x16x32_bf16(wf[0][ks], bfr[ks], acc0, 0, 0, 0); acc1 = __builtin_amdgcn_mfma_f32_16x16x32_bf16(wf[1][ks], bfr[ks], acc1, 0, 0, 0); }
        bf16_t* op = MIX + (size_t)(tb * 128 + 16 * nt + fr) * D + CONVD + g * 256 + 32 * c.wave + 4 * fq;
        u32x2 o0; o0.x = cvt_pk_bf16(acc0[0], acc0[1]); o0.y = cvt_pk_bf16(acc0[2], acc0[3]); *(GAS u32x2*)op = o0;
        u32x2 o1; o1.x = cvt_pk_bf16(acc1[0], acc1[1]); o1.y = cvt_pk_bf16(acc1[2], acc1[3]); *(GAS u32x2*)(op + 16) = o1;
    }
    __syncthreads();
}

__device__ __forceinline__ void norm_router_stage(const Args& a, const Ctx& c, int layer) {
    LAS float* wT = (LAS float*)c.lds; const float* par = (const float*)(a.ws + WS_PAR); const float* wr = par + PAR_ROUTER + (size_t)layer * D * NE;
    __syncthreads();
    for (int i = c.tid; i < D * NE / 4; i += NTHREADS) ((LAS f32x4*)wT)[i] = ((const GAS f32x4*)wr)[i];
    LAS f32x4* gl = (LAS f32x4*)(c.lds + RING_BYTES + 1024);
    c.tid < D / 4 ? (void)(gl[c.tid] = ((const GAS f32x4*)(par + PAR_GFFN + (size_t)layer * D))[c.tid]) : (void)0;
    __syncthreads();
}
__device__ __forceinline__ void norm_router_phase(const Args& a, const Ctx& c, int layer, bool staged = false) {
    LAS float* wT = (LAS float*)c.lds;
    const float* par = (const float*)(a.ws + WS_PAR); const float* wr = par + PAR_ROUTER + (size_t)layer * D * NE;
    int gw = c.vcu * NWAVES + c.wave; asm volatile("" : "+s"(gw));
    const int NGW = c.G * NWAVES, lane = c.lane;
    float* AFF = (float*)(a.ws + WS_AFF); bf16_t* H = (bf16_t*)(a.ws + WS_H);
    f32x4 n0[8], n1[8];
    { const int mb = (gw + NGW) < S ? gw + NGW : gw;
#pragma unroll
        for (int j = 0; j < 8; ++j) { n0[j] = ((const GAS f32x4*)(a.X + (size_t)gw * D))[lane + 64 * j]; n1[j] = ((const GAS f32x4*)(a.X + (size_t)mb * D))[lane + 64 * j]; } }
    LAS f32x4* gl = (LAS f32x4*)(c.lds + RING_BYTES + 1024);
    if (!staged) {
    __syncthreads();
    for (int i = c.tid; i < D * NE / 4; i += NTHREADS) ((LAS f32x4*)wT)[i] = ((const GAS f32x4*)wr)[i];
    c.tid < D / 4 ? (void)(gl[c.tid] = ((const GAS f32x4*)(par + PAR_GFFN + (size_t)layer * D))[c.tid]) : (void)0;
    }
    __syncthreads();
    for (int m = gw; m < S; m += 2 * NGW) {
        const bool two = (m + NGW) < S; const int m1 = two ? m + NGW : m;
        f32x4 v0[8], v1[8]; float ss0 = 0.f, ss1 = 0.f;
#pragma unroll
        for (int j = 0; j < 8; ++j) { v0[j] = n0[j]; v1[j] = n1[j]; }
        if (m + 2 * NGW < S) { const int ma = m + 2 * NGW, mb = (ma + NGW) < S ? ma + NGW : ma;
#pragma unroll
            for (int j = 0; j < 8; ++j) { n0[j] = ((const GAS f32x4*)(a.X + (size_t)ma * D))[lane + 64 * j]; n1[j] = ((const GAS f32x4*)(a.X + (size_t)mb * D))[lane + 64 * j]; } }
#pragma unroll
        for (int j = 0; j < 8; ++j) { ss0 += (v0[j].x * v0[j].x + v0[j].y * v0[j].y) + (v0[j].z * v0[j].z + v0[j].w * v0[j].w); ss1 += (v1[j].x * v1[j].x + v1[j].y * v1[j].y) + (v1[j].z * v1[j].z + v1[j].w * v1[j].w); }
#pragma unroll
        for (int o = 1; o < 64; o <<= 1) { ss0 += shx(ss0, o, lane); ss1 += shx(ss1, o, lane); }
        const float r0 = rsqrtf(ss0 * (1.0f / D) + EPS), r1 = rsqrtf(ss1 * (1.0f / D) + EPS);
        GAS u32x2* o0 = (GAS u32x2*)(H + (size_t)m * D) + lane; GAS u32x2* o1 = (GAS u32x2*)(H + (size_t)m1 * D) + lane;
#pragma unroll
        for (int j = 0; j < 8; ++j) { const f32x4 w = gl[lane + 64 * j]; v0[j] = v0[j] * r0 * w; v1[j] = v1[j] * r1 * w;
            u32x2 p0; p0.x = cvt_pk_bf16(v0[j].x, v0[j].y); p0.y = cvt_pk_bf16(v0[j].z, v0[j].w); o0[64 * j] = p0;
            u32x2 p1; p1.x = cvt_pk_bf16(v1[j].x, v1[j].y); p1.y = cvt_pk_bf16(v1[j].z, v1[j].w); if (two) o1[64 * j] = p1; }
        float lg0[NE], lg1[NE];
#pragma unroll
        for (int e = 0; e < NE; ++e) { f32x2 a0 = (f32x2){0.f, 0.f}, a1 = (f32x2){0.f, 0.f};
#pragma unroll
            for (int j = 0; j < 8; ++j) { const f32x4 w = *(const LAS f32x4*)(wT + e * D + 4 * lane + 256 * j); const f32x2 wl = (f32x2){w.x, w.y}, wh = (f32x2){w.z, w.w};
                a0 = __builtin_elementwise_fma((f32x2){v0[j].x, v0[j].y}, wl, a0); a0 = __builtin_elementwise_fma((f32x2){v0[j].z, v0[j].w}, wh, a0);
                a1 = __builtin_elementwise_fma((f32x2){v1[j].x, v1[j].y}, wl, a1); a1 = __builtin_elementwise_fma((f32x2){v1[j].z, v1[j].w}, wh, a1); }
            lg0[e] = a0.x + a0.y; lg1[e] = a1.x + a1.y; if (e & 1) __builtin_amdgcn_sched_barrier(0); }
#pragma unroll
        for (int st = 0; st < 4; ++st) { const int o = 32 >> st, n = 8 >> st; const bool up = (lane & o) != 0;
#pragma unroll
            for (int i = 0; i < 8; ++i) if (i < n) { const float s0 = up ? lg0[i] : lg0[i + n], k0 = up ? lg0[i + n] : lg0[i]; const float s1 = up ? lg1[i] : lg1[i + n], k1 = up ? lg1[i + n] : lg1[i];
                lg0[i] = k0 + shx(s0, o, lane); lg1[i] = k1 + shx(s1, o, lane); } }
        float l0 = lg0[0], l1 = lg1[0]; l0 += shx(l0, 2, lane); l1 += shx(l1, 2, lane); l0 += shx(l0, 1, lane); l1 += shx(l1, 1, lane);
        float mx0 = l0, mx1 = l1;
#pragma unroll
        for (int o = 4; o < 64; o <<= 1) { mx0 = fmaxf(mx0, shx(mx0, o, lane)); mx1 = fmaxf(mx1, shx(mx1, o, lane)); }
        const float e0 = expf(l0 - mx0), e1 = expf(l1 - mx1); float sm0 = e0, sm1 = e1;
#pragma unroll
        for (int o = 4; o < 64; o <<= 1) { sm0 += shx(sm0, o, lane); sm1 += shx(sm1, o, lane); }
        const int e = ((lane >> 5) & 1) * 8 + ((lane >> 4) & 1) * 4 + ((lane >> 3) & 1) * 2 + ((lane >> 2) & 1);
        if ((lane & 3) == 0) { AFF[(size_t)e * S + m] = e0 / sm0; if (two) AFF[(size_t)e * S + m1] = e1 / sm1; }
    }
    __syncthreads();
}

__device__ __forceinline__ void select_phase(const Args& a, const Ctx& c, int e) {
    const float* AFF = (const float*)(a.ws + WS_AFF) + (size_t)e * S; int* INV = (int*)(a.ws + WS_INV) + (size_t)e * S; int* IDX = (int*)(a.ws + WS_IDX); float* GATE = (float*)(a.ws + WS_GATE);
    LAS int* red = (LAS int*)c.lds;
    unsigned v[16];
#pragma unroll
    for (int q = 0; q < 4; ++q) { const u32x4 t4 = *(const GAS u32x4*)(AFF + c.tid * 16 + 4 * q); v[4 * q] = t4.x; v[4 * q + 1] = t4.y; v[4 * q + 2] = t4.z; v[4 * q + 3] = t4.w; }
    __syncthreads();
    unsigned prefix = 0; int it = 0;
    for (int sh = 30; sh >= 0; sh -= 2, ++it) {
        const int nb = (sh == 30) ? 1 : 2; const int shift = (sh == 30) ? 30 : sh - 1;
        int cnt[3];
#pragma unroll
        for (int j = 1; j <= 3; ++j) { const unsigned cand = prefix | ((unsigned)j << shift); int cj = 0;
#pragma unroll
            for (int i = 0; i < 16; ++i) cj += (v[i] >= cand) ? 1 : 0;
            cnt[j - 1] = wave_sum_dpp(cj); }
        LAS int* rb = red + (it & 1) * 32;
        if (c.lane == 0) { rb[c.wave * 4 + 0] = cnt[0]; rb[c.wave * 4 + 1] = cnt[1]; rb[c.wave * 4 + 2] = cnt[2]; }
        __syncthreads();
        int t1 = 0, t2 = 0, t3 = 0;
#pragma unroll
        for (int w = 0; w < NWAVES; ++w) { t1 += rb[w * 4 + 0]; t2 += rb[w * 4 + 1]; t3 += rb[w * 4 + 2]; }
        int jsel = 0;
        if (nb == 1) { jsel = (t1 >= CAP) ? 1 : 0; } else { jsel = (t3 >= CAP) ? 3 : ((t2 >= CAP) ? 2 : ((t1 >= CAP) ? 1 : 0)); }
        prefix |= (unsigned)jsel << shift;
        if (sh == 30) sh = 31;
    }
    const unsigned T = prefix;
    int cg = 0, ce = 0;
#pragma unroll
    for (int i = 0; i < 16; ++i) { cg += (v[i] > T) ? 1 : 0; ce += (v[i] == T) ? 1 : 0; }
    int pg = cg, pe = ce;
#pragma unroll
    for (int o = 1; o < 64; o <<= 1) { const int src = (c.lane >= o ? c.lane - o : c.lane) << 2; const int tg = __builtin_amdgcn_ds_bpermute(src, pg), te = __builtin_amdgcn_ds_bpermute(src, pe); if (c.lane >= o) { pg += tg; pe += te; } }
    __syncthreads();
    if (c.lane == 63) { red[64 + c.wave] = pg; red[80 + c.wave] = pe; }
    __syncthreads();
    int bg = 0, be = 0, ng = 0;
#pragma unroll
    for (int w = 0; w < NWAVES; ++w) { const int xg = red[64 + w], xe = red[80 + w]; if (w < c.wave) { bg += xg; be += xe; } ng += xg; }
    pg = pg - cg + bg; pe = pe - ce + be;
    const int need = CAP - ng;
    int slots[16];
#pragma unroll
    for (int i = 0; i < 16; ++i) {
        const int t = c.tid * 16 + i; int slot = -1;
        if (v[i] > T) { slot = pg++; } else if (v[i] == T) { if (pe < need) slot = ng + pe; pe++; }
        slots[i] = slot;
        if (slot >= 0) { IDX[e * CAP + slot] = t; GATE[e * CAP + slot] = __builtin_bit_cast(float, v[i]); }
    }
#pragma unroll
    for (int q = 0; q < 4; ++q) { u32x4 o; o.x = (unsigned)slots[4 * q]; o.y = (unsigned)slots[4 * q + 1]; o.z = (unsigned)slots[4 * q + 2]; o.w = (unsigned)slots[4 * q + 3]; *(GAS u32x4*)(INV + c.tid * 16 + 4 * q) = o; }
}

__device__ __forceinline__ void combine_stage(const Args& a, const Ctx& c, int layer) {
    LAS f32x4* gl = (LAS f32x4*)c.lds; const bool lastl = (layer == NL - 1);
    __syncthreads();
    if (c.tid < D / 4) gl[c.tid] = ((const GAS f32x4*)((const float*)(a.ws + WS_PAR) + (lastl ? PAR_GFIN : PAR_GMIX + (layer + 1) * D)))[c.tid];
    __syncthreads();
}
__device__ __forceinline__ void combine_phase(const Args& a, const Ctx& c, int layer, bool staged = false) {
    int gw = c.vcu * NWAVES + c.wave; asm volatile("" : "+s"(gw));
    const int NGW = c.G * NWAVES, lane = c.lane;
    const bf16_t* Y = (const bf16_t*)(a.ws + WS_Y); const int* INV = (const int*)(a.ws + WS_INV); bf16_t* H = (bf16_t*)(a.ws + WS_H);
    const bool lastl = (layer == NL - 1);
    LAS f32x4* gl = (LAS f32x4*)c.lds;
    f32x4 nv[8]; int ninv = -1;
    { ninv = INV[(size_t)(lane & 15) * S + gw];
#pragma unroll
        for (int j = 0; j < 8; ++j) nv[j] = ((const GAS f32x4*)(a.X + (size_t)gw * D))[lane + 64 * j]; }
    if (!staged) {
    __syncthreads();
    if (c.tid < D / 4) gl[c.tid] = ((const GAS f32x4*)((const float*)(a.ws + WS_PAR) + (lastl ? PAR_GFIN : PAR_GMIX + (layer + 1) * D)))[c.tid];
    __syncthreads();
    }
    for (int m = gw; m < S; m += NGW) {
        GAS f32x4* xr = (GAS f32x4*)(a.X + (size_t)m * D) + lane; f32x4 v[8];
#pragma unroll
        for (int j = 0; j < 8; ++j) v[j] = nv[j];
        const int myinv = ninv;
        if (m + NGW < S) { ninv = INV[(size_t)(lane & 15) * S + m + NGW];
#pragma unroll
            for (int j = 0; j < 8; ++j) nv[j] = ((const GAS f32x4*)(a.X + (size_t)(m + NGW) * D))[lane + 64 * j]; }
        unsigned mask = (unsigned)(__builtin_amdgcn_ballot_w64(myinv >= 0) & 0xFFFFull);
        while (mask) {
            const int e1 = __builtin_ctz(mask); mask &= mask - 1u; const bool two = mask != 0u; const int e2 = two ? __builtin_ctz(mask) : e1; if (two) mask &= mask - 1u;
            const int s1 = __builtin_amdgcn_readlane(myinv, e1), s2 = __builtin_amdgcn_readlane(myinv, e2);
            const GAS u32x2* y1 = (const GAS u32x2*)(Y + ((size_t)e1 * CAP + s1) * D) + lane; const GAS u32x2* y2 = (const GAS u32x2*)(Y + ((size_t)e2 * CAP + s2) * D) + lane;
            u32x2 a1[8], a2[8];
#pragma unroll
            for (int j = 0; j < 8; ++j) { a1[j] = y1[64 * j]; a2[j] = y2[64 * j]; }
#pragma unroll
            for (int j = 0; j < 8; ++j) { v[j].x += bf_lo(a1[j].x); v[j].y += bf_hi(a1[j].x); v[j].z += bf_lo(a1[j].y); v[j].w += bf_hi(a1[j].y); }
            if (two) {
#pragma unroll
                for (int j = 0; j < 8; ++j) { v[j].x += bf_lo(a2[j].x); v[j].y += bf_hi(a2[j].x); v[j].z += bf_lo(a2[j].y); v[j].w += bf_hi(a2[j].y); } }
        }
        float ss = 0.f;
#pragma unroll
        for (int j = 0; j < 8; ++j) ss += (v[j].x * v[j].x + v[j].y * v[j].y) + (v[j].z * v[j].z + v[j].w * v[j].w);
        const float r = rsqrtf(wave_sum(ss, lane) * (1.0f / D) + EPS);
        if (!lastl) {
            GAS u32x2* o8 = (GAS u32x2*)(H + (size_t)m * D) + lane;
#pragma unroll
            for (int j = 0; j < 8; ++j) { xr[64 * j] = v[j]; const f32x4 w = gl[lane + 64 * j]; u32x2 o; o.x = cvt_pk_bf16(v[j].x * r * w.x, v[j].y * r * w.y); o.y = cvt_pk_bf16(v[j].z * r * w.z, v[j].w * r * w.w); o8[64 * j] = o; }
        } else {
#pragma unroll
            for (int j = 0; j < 8; ++j) { const f32x4 w = gl[lane + 64 * j]; f32x4 o; o.x = v[j].x * r * w.x; o.y = v[j].y * r * w.y; o.z = v[j].z * r * w.z; o.w = v[j].w * r * w.w; xr[64 * j] = o; }
        }
    }
    __syncthreads();
}
constexpr int NPH = 1 + 9 * NL;
__global__ void __launch_bounds__(NTHREADS, 2) mk_fwd(Args a) {
    extern __shared__ __attribute__((aligned(16))) unsigned char lds_raw[];
    Ctx c; c.lds = (LAS unsigned char*)lds_raw;
    c.wave = __builtin_amdgcn_readfirstlane((int)threadIdx.x >> 6);
    c.lane = lane_id(); c.tid = c.wave * 64 + c.lane;
    c.G = gridDim.x; { const int bx = blockIdx.x; c.vcu = (c.G % 8 == 0) ? (bx % 8) * (c.G / 8) + bx / 8 : bx; }
    volatile LAS unsigned* MISC = (volatile LAS unsigned*)(c.lds + MISC_OFF);
    for (int u = c.tid; u < (LDS_BYTES - LDSCTL_OFF) / 4; u += NTHREADS) ((LAS unsigned*)(c.lds + LDSCTL_OFF))[u] = 0u;
    const bool leader0 = false; (void)leader0;
    __syncthreads();
    const int lo = a.ph_lo, hi = a.ph_hi;
    unsigned* ctl = (unsigned*)(a.ws + WS_CTL);
    XcdBarrier bar; bar.bar = ctl + CW_BAR; bar.x = 0; bar.st = nullptr;
    if (hi - lo > 1) bar = xcd_barrier_post(ctl + CW_BAR, MISC + 8, c.tid == 0);
    unsigned char* ws = a.ws;
#define IN(k) (lo <= (k) && (k) < hi)
#ifndef MK_PHMASK
#define MK_PHMASK 0x3ff
#endif
#define EN(b) ((MK_PHMASK >> (b)) & 1)
#ifndef MK_REPMASK
#define MK_REPMASK 0
#endif
#ifndef MK_NRSTAGE
#define MK_NRSTAGE 1
#endif
#define REPS_ON(b) (((MK_REPMASK >> (b)) & 1) != 0)
#ifndef MK_REPN
#define MK_REPN 3
#endif
#define REPS(b) (((MK_REPMASK >> (b)) & 1) ? MK_REPN : 1)
#define SEAM(k) do { if (IN((k) + 1)) { const int _ln = lane_id(); xcd_barrier(bar, c.wave == 0 && _ln == 0); } } while (0)
#ifndef MK_SELCVT
#define MK_SELCVT 4400
#endif
#define par0b_() ({ int _b = (int)blockIdx.x; asm volatile("" : "+s"(_b)); _b; })
#define FRESH(cc) Ctx cc = c; cc.lane = lane_id(); cc.tid = cc.wave * 64 + cc.lane

    if (EN(0) && IN(0)) {
        { FRESH(cc); p0_prologue(a, cc); }
        SEAM(0); }

    for (int l = 0; l < NL; ++l) {
        const int pb = 1 + 9 * l, li = l >> 1; const bool odd = (l & 1) != 0;
        if (EN(1) && IN(pb + 0)) {
            pg8::Sched Sc{}; Sc.G = c.G; Sc.c = (int)blockIdx.x; Sc.A = (long)WS_H; Sc.tA = 256 * D * 2; Sc.sA = 0; Sc.sB = 0; Sc.tB = 256 * D * 2; Sc.nM = S / 256; Sc.nG = 1; Sc.gidx = nullptr;
            pg8::EpiBf16 E{}; E.O = (bf16_t*)(ws + WS_Z); E.gcol = 0; E.O2 = (bf16_t*)(ws + WS_VT); E.ldc2 = S;
            if (!odd) { Sc.B = (long)(WS_EVIN + li * SZ_EVIN); Sc.nN = QKF_LD / 256; E.ldc = QKF_LD;
                Sc.nExtra = 64; Sc.nFull = 384; }
            else { Sc.B = (long)(WS_ODIN + li * SZ_ODIN); Sc.nN = OD_IN / 256; E.ldc = OD_IN; Sc.nExtra = 0; Sc.nFull = (S / 256) * (OD_IN / 256); }
#if MK_JITCVT
            int par0 = (int)blockIdx.x; asm volatile("" : "+s"(par0)); par0 &= 1;
            const bool solo = !odd && c.G == 256;
            if (solo) { if (par0b_() >= 128) { FRESH(cc); moe_cvt(a, cc, l, 0, par0b_() - 128, 128); __syncthreads(); } }
            else if (par0 == 0) { FRESH(cc); moe_cvt(a, cc, l, 0); __syncthreads(); }
#endif
            pg8::gemm_phase<pg8::EpiBf16, false>(c.lds, c.wave, (const char*)ws, D, D, D, Sc, E);
#if MK_JITCVT
            int par0b = (int)blockIdx.x; asm volatile("" : "+s"(par0b));
            if (!(!odd && c.G == 256) && (par0b & 1) != 0) { FRESH(cc); moe_cvt(a, cc, l, 0); __syncthreads(); }
#endif
            SEAM(pb + 0);
        }
        if (EN(2) && IN(pb + 1)) {
#if MK_JITCVT && MK_UPHOST
            { int parm = (int)blockIdx.x; asm volatile("" : "+s"(parm)); if ((parm & 1) == 0) { FRESH(cc); moe_cvt(a, cc, l, 1); __syncthreads(); } }
#endif
            if (!odd) {
#ifndef MK_SUB
#define MK_SUB 7
#endif
                _Pragma("unroll 1") for (int rep = 0; rep < REPS(10); ++rep) if (MK_SUB & 1) for (int u = c.vcu; u < 256; u += c.G) { FRESH(cc); attn_unit(a, cc, li, u >> 2, u & 3); }
                _Pragma("unroll 1") for (int rep = 0; rep < REPS(11); ++rep) if (MK_SUB & 2) for (int u = c.vcu; u < 256; u += c.G) { FRESH(cc); ffta_unit(a, cc, u >> 6, u & 63); }
            } else {
                _Pragma("unroll 1") for (int rep = 0; rep < REPS(13); ++rep) if (MK_SUB & 4) for (int u = c.vcu; u < 256; u += c.G) { FRESH(cc); if (MK_ODDMIX2) oddmix_unit2(a, cc, li, u); else oddmix_unit(a, cc, li, u); }
            }
#if MK_JITCVT && MK_UPHOST
            { int parm = (int)blockIdx.x; asm volatile("" : "+s"(parm)); if ((parm & 1) != 0) { __syncthreads(); FRESH(cc); moe_cvt(a, cc, l, 1); __syncthreads(); } }
#endif
            SEAM(pb + 1);
        }
        if (EN(3) && IN(pb + 2)) {
            if (!odd) {
                _Pragma("unroll 1") for (int rep = 0; rep < REPS(12); ++rep) if (MK_SUB & 1) for (int u = c.vcu; u < 256; u += c.G) { FRESH(cc); fftc_unit(a, cc, u >> 2, u & 3); }
                __syncthreads();
            }
            if (!odd)             SEAM(pb + 2);
        }
        if (EN(4) && IN(pb + 3)) {
            const int Kk = odd ? D : MIX_LD_EV;
            pg8::Sched Sc{}; Sc.G = c.G; Sc.c = (int)blockIdx.x; Sc.A = (long)WS_MIX; Sc.sA = 0; Sc.tA = 256 * Kk * 2;
            Sc.B = (long)(odd ? WS_ODOUT + li * SZ_ODOUT : WS_EVOUT + li * SZ_EVOUT); Sc.sB = 0; Sc.tB = 256 * Kk * 2;
            Sc.nM = S / 256; Sc.nN = D / 256; Sc.nG = 1; Sc.gidx = nullptr; Sc.nExtra = 0; Sc.nFull = 256;
            pg8::EpiResF32 E{}; E.R = (l == 0) ? a.x_in : a.X; E.X = a.X; E.ldc = D;
#if MK_JITCVT && !MK_UPHOST
            int par1 = (int)blockIdx.x; asm volatile("" : "+s"(par1)); par1 &= 1;
            if (par1 == 0) { FRESH(cc); moe_cvt(a, cc, l, 1); __syncthreads(); }
#endif
            pg8::gemm_phase<pg8::EpiResF32, false>(c.lds, c.wave, (const char*)ws, Kk, Kk, Kk, Sc, E);
#if MK_JITCVT && !MK_UPHOST
            int par1b = (int)blockIdx.x; asm volatile("" : "+s"(par1b));
            if ((par1b & 1) != 0) { FRESH(cc); moe_cvt(a, cc, l, 1); __syncthreads(); }
#endif
#if MK_NRSTAGE
            if (IN(pb + 4) && EN(5) && !REPS_ON(14)) { FRESH(cc); norm_router_stage(a, cc, l); }
#endif
            SEAM(pb + 3);
        }
        if (EN(5) && IN(pb + 4)) { _Pragma("unroll 1") for (int rep = 0; rep < REPS(14); ++rep) { FRESH(cc); norm_router_phase(a, cc, l, MK_NRSTAGE && EN(4) && IN(pb + 3) && !REPS_ON(14)); } SEAM(pb + 4); }
        if (EN(6) && IN(pb + 5)) { _Pragma("unroll 1") for (int rep = 0; rep < REPS(6); ++rep) { FRESH(cc); int bx = (int)blockIdx.x; asm volatile("" : "+s"(bx));
              if (bx < NE) select_phase(a, cc, bx);
#if MK_JITCVT
              else if (c.G == 256) moe_cvt(a, cc, l, 2, bx - NE, 256 - NE, 0, MK_SELCVT);
#endif
#ifdef MK_SELSLEEP
              else { for (int q = 0; q < MK_SELSLEEP; ++q) __builtin_amdgcn_s_sleep(127); }
#endif
            } SEAM(pb + 5); }
        if (EN(7) && IN(pb + 6)) {
            pg8::Sched Sc{}; Sc.G = c.G; Sc.c = (int)blockIdx.x; Sc.A = (long)WS_H; Sc.sA = 0; Sc.tA = 0; Sc.B = (long)(WS_GU + l * SZ_GU); Sc.sB = (long)2048 * D * 2; Sc.tB = 256 * D * 2;
            Sc.nM = CAP / 256; Sc.nN = 2048 / 256; Sc.nG = NE; Sc.gidx = (const int*)(ws + WS_IDX); Sc.nExtra = 0; Sc.nFull = 512;
            pg8::EpiGU E{}; E.HID = (bf16_t*)(ws + WS_HID);
#if MK_JITCVT
            int par2 = (int)blockIdx.x; asm volatile("" : "+s"(par2)); par2 &= 1;
            if (par2 == 0) { FRESH(cc); moe_cvt(a, cc, l, 2, -1, 0, (c.G == 256) ? MK_SELCVT : 0); __syncthreads(); }
#endif
            pg8::gemm_phase<pg8::EpiGU, true>(c.lds, c.wave, (const char*)ws, D, D, D, Sc, E);
#if MK_JITCVT
            int par2b = (int)blockIdx.x; asm volatile("" : "+s"(par2b));
            if ((par2b & 1) != 0) { FRESH(cc); moe_cvt(a, cc, l, 2, -1, 0, (c.G == 256) ? MK_SELCVT : 0); __syncthreads(); }
#endif
            SEAM(pb + 6);
        }
        if (EN(8) && IN(pb + 7)) {
            pg8::Sched Sc{}; Sc.G = c.G; Sc.c = (int)blockIdx.x; Sc.A = (long)WS_HID; Sc.sA = (long)CAP * EH * 2; Sc.tA = 256 * EH * 2; Sc.B = (long)(WS_DN + l * SZ_DN); Sc.sB = (long)D * EH * 2; Sc.tB = 256 * EH * 2;
            Sc.nM = CAP / 256; Sc.nN = D / 256; Sc.nG = NE; Sc.gidx = nullptr; Sc.nExtra = 0; Sc.nFull = 512;
            pg8::EpiDown E{}; E.Y = (bf16_t*)(ws + WS_Y); E.gate = (const float*)(ws + WS_GATE);
            pg8::gemm_phase<pg8::EpiDown, false>(c.lds, c.wave, (const char*)ws, EH, EH, EH, Sc, E);
#if MK_NRSTAGE
            if (IN(pb + 8) && EN(9)) { FRESH(cc); combine_stage(a, cc, l); }
#endif
            SEAM(pb + 7);
        }
        if (EN(9) && IN(pb + 8)) { FRESH(cc); combine_phase(a, cc, l, MK_NRSTAGE && EN(8) && IN(pb + 7)); SEAM(pb + 8); }
    }
#undef IN
#undef SEAM
}
}


extern "C" void kernel_launch(void* const* d_in, const int* in_sizes, int n_in, void* d_out, int out_size, void* d_ws, size_t ws_size, hipStream_t stream) {
    using namespace mk;
    static int grid = 0;
    if (grid == 0) {
        int dev = 0, cus = 0, per_cu = 0;
        if (hipGetDevice(&dev) != hipSuccess || hipDeviceGetAttribute(&cus, hipDeviceAttributeMultiprocessorCount, dev) != hipSuccess) { fprintf(stderr, "kernel_launch: device query failed\n"); grid = -1; return; }
        if (hipFuncSetAttribute((const void*)mk_fwd, hipFuncAttributeMaxDynamicSharedMemorySize, LDS_BYTES) != hipSuccess) { fprintf(stderr, "kernel_launch: hipFuncSetAttribute failed\n"); grid = -1; return; }
        if (hipOccupancyMaxActiveBlocksPerMultiprocessor(&per_cu, (const void*)mk_fwd, NTHREADS, LDS_BYTES) != hipSuccess || per_cu < 1) fprintf(stderr, "kernel_launch: occupancy query reports %d blocks per CU\n", per_cu);
        (void)hipGetLastError();
        grid = cus;
        if (ws_size < WS_END) { fprintf(stderr, "kernel_launch: workspace too small: %zu < %zu\n", ws_size, (size_t)WS_END); grid = -1; return; }
    }
    if (grid < 0) return;
    (void)hipMemsetAsync((char*)d_ws + WS_CTL, 0, CTL_ZERO_BYTES, stream);
    Args a{};
    a.x_in = (const float*)d_in[0]; a.rel_bias = (const float*)d_in[1]; a.norm_mix_g = (const float*)d_in[2]; a.norm_ffn_g = (const float*)d_in[3]; a.final_g = (const float*)d_in[4];
    a.ev_w_in = (const float*)d_in[5]; a.ev_sink = (const float*)d_in[6]; a.ev_w_out = (const float*)d_in[7];
    a.od_w_in = (const float*)d_in[8]; a.od_conv_w = (const float*)d_in[9]; a.od_pool_w = (const float*)d_in[10]; a.od_pool_scale = (const float*)d_in[11]; a.od_w_out = (const float*)d_in[12];
    a.moe_w_router = (const float*)d_in[13]; a.moe_w_gate = (const float*)d_in[14]; a.moe_w_up = (const float*)d_in[15]; a.moe_w_down = (const float*)d_in[16];
    a.X = (float*)d_out; a.ws = (unsigned char*)d_ws;
#if MK_DEBUG
    mkref::debug_run(a, grid, d_in, d_out, d_ws, ws_size, stream);
#else
#if MK_NLAUNCH == 1
    a.ph_lo = 0; a.ph_hi = NPH;
    hipLaunchKernelGGL(mk_fwd, dim3(grid), dim3(NTHREADS), LDS_BYTES, stream, a);
#else
    for (int p = 0; p < NPH; ++p) { const int type = p == 0 ? 0 : ((p - 1) % 9) + 1; const int layer = p == 0 ? 0 : (p - 1) / 9; (void)layer;
        int reps = 1;
#if defined(MK_HREPMASK)
        if (((MK_HREPMASK >> type) & 1) && ((MK_HREPLAYERS >> layer) & 1)) reps = MK_HREPN;
#endif
        for (int r = 0; r < reps; ++r) { a.ph_lo = p; a.ph_hi = p + 1; hipLaunchKernelGGL(mk_fwd, dim3(grid), dim3(NTHREADS), LDS_BYTES, stream, a); } }
#if defined(MK_HREP_EMPTY)
    for (int r = 0; r < MK_HREP_EMPTY; ++r) { a.ph_lo = NPH; a.ph_hi = NPH; hipLaunchKernelGGL(mk_fwd, dim3(grid), dim3(NTHREADS), LDS_BYTES, stream, a); }
#endif
#endif
    if (hipPeekAtLastError() != hipSuccess) fprintf(stderr, "kernel_launch: launch failed\n");
#endif
}
```

```cpp
#include <hip/hip_runtime.h>
#include <cstdio>
#include <cstdint>

#ifndef MK_DEBUG
#define MK_DEBUG 0
#endif
#ifndef MK_NLAUNCH
#define MK_NLAUNCH 1
#endif

namespace mk {
constexpr int S = 8192, D = 2048;
constexpr int NL = MK_DEBUG ? 2 : 4;
constexpr int HD = 128, NQ = 12, NKV = 4, WIN = 128;
#ifndef MK_FFTFUSE
#define MK_FFTFUSE 1
#endif
constexpr int QDIM = 1536, KVDIM = 512, FDIM = 512, EV_IN = 3072, QKF_LD = 2560, MIX_LD_EV = MK_FFTFUSE ? 2048 : 2560;
constexpr int CONVD = 1024, POOLD = 1024, OD_IN = 4096;
constexpr int NE = 16, EH = 1024, CAP = 1024;
constexpr float EPS = 1e-6f;
constexpr int NWAVES = 8, NTHREADS = 512;

typedef unsigned short bf16_t;
typedef short bf16x8 __attribute__((ext_vector_type(8)));
typedef short s16x4 __attribute__((ext_vector_type(4)));
typedef float f32x4 __attribute__((ext_vector_type(4)));
typedef float f32x2 __attribute__((ext_vector_type(2)));
typedef unsigned u32x4 __attribute__((ext_vector_type(4)));
typedef unsigned u32x2 __attribute__((ext_vector_type(2)));
#define LAS __attribute__((address_space(3)))
#define GAS __attribute__((address_space(1)))
#define LDS_WAIT() asm volatile("s_waitcnt lgkmcnt(0)" ::: "memory")
#define VM_WAIT() asm volatile("s_waitcnt vmcnt(0)" ::: "memory")

constexpr size_t MiB = 1u << 20;
constexpr size_t WS_CTL = 0, CTL_ZERO_BYTES = 1 * MiB;
constexpr size_t WS_AFF = 1 * MiB;
constexpr size_t WS_INV = WS_AFF + 512 * 1024;
constexpr size_t WS_IDX = 2 * MiB;
constexpr size_t WS_GATE = WS_IDX + 64 * 1024;
constexpr size_t WS_PAR = 3 * MiB;
constexpr int PAR_RELB = 0, PAR_SINK = 384, PAR_GMIX = 512, PAR_GFFN = PAR_GMIX + 4 * 2048, PAR_GFIN = PAR_GFFN + 4 * 2048, PAR_CONV = PAR_GFIN + 2048, PAR_ROUTER = 32768, PAR_PTRS = 32000;
constexpr size_t WS_FTC = WS_PAR + 768 * 1024;
constexpr size_t WS_FTA = WS_PAR + 896 * 1024;
constexpr size_t WS_FCO = WS_PAR + 912 * 1024;
constexpr size_t WS_H = 4 * MiB;
constexpr size_t WS_Z = 36 * MiB;
constexpr size_t WS_VT = 100 * MiB;
constexpr size_t WS_MIX = 108 * MiB;
constexpr size_t WS_TB = 148 * MiB;
constexpr size_t WS_POOLED = 164 * MiB;
constexpr size_t WS_HID = 180 * MiB;
constexpr size_t WS_Y = 212 * MiB;
constexpr size_t WS_W = 276 * MiB;
constexpr size_t SZ_EVIN = (size_t)EV_IN * D * 2, SZ_EVOUT = (size_t)D * MIX_LD_EV * 2, SZ_ODIN = (size_t)OD_IN * D * 2, SZ_ODOUT = (size_t)D * D * 2, SZ_POOL = (size_t)4 * 256 * 256 * 2;
constexpr size_t SZ_GU = (size_t)NE * 2048 * D * 2, SZ_DN = (size_t)NE * D * EH * 2;
constexpr size_t WS_EVIN = WS_W, WS_EVOUT = WS_EVIN + (NL / 2) * SZ_EVIN, WS_ODIN = WS_EVOUT + (NL / 2) * SZ_EVOUT, WS_ODOUT = WS_ODIN + (NL / 2) * SZ_ODIN,
                 WS_POOLW = WS_ODOUT + (NL / 2) * SZ_ODOUT, WS_GU = WS_POOLW + (NL / 2) * SZ_POOL, WS_DN = WS_GU + NL * SZ_GU, WS_END = WS_DN + NL * SZ_DN;
constexpr int CW_TMO = 0, CW_CODE = 1, CW_BAR = 4096;

constexpr int RING_BYTES = 131072;
constexpr int LDSCTL_OFF = RING_BYTES, MISC_OFF = LDSCTL_OFF + 320;
constexpr int LDS_BYTES = 163840;

__device__ __forceinline__ unsigned f2bf(float f) { unsigned u = __builtin_bit_cast(unsigned, f); return (u + 0x7fffu + ((u >> 16) & 1u)) >> 16; }
typedef __bf16 bf16x2_t __attribute__((ext_vector_type(2)));
__device__ __forceinline__ unsigned cvt_pk_bf16(float lo, float hi) { const f32x2 v = {lo, hi}; return __builtin_bit_cast(unsigned, __builtin_convertvector(v, bf16x2_t)); }
#ifndef MK_PK2HW
#define MK_PK2HW 1
#endif
__device__ __forceinline__ unsigned pk2(float lo, float hi) { return MK_PK2HW ? cvt_pk_bf16(lo, hi) : (f2bf(lo) | (f2bf(hi) << 16)); }
__device__ __forceinline__ unsigned cvt_pk_bf16_v(float lo, float hi) { unsigned r; asm volatile("v_cvt_pk_bf16_f32 %0, %1, %2" : "=v"(r) : "v"(lo), "v"(hi)); return r; }
__device__ __forceinline__ float bf_lo(unsigned w) { return __builtin_bit_cast(float, w << 16); }
__device__ __forceinline__ float bf_hi(unsigned w) { return __builtin_bit_cast(float, w & 0xffff0000u); }
__device__ __forceinline__ int lane_id() { int l; asm volatile("v_mbcnt_lo_u32_b32 %0, -1, 0\n\tv_mbcnt_hi_u32_b32 %0, -1, %0" : "=v"(l)); return l; }
__device__ __forceinline__ float shx(float v, int o, int lane) { return __builtin_bit_cast(float, __builtin_amdgcn_ds_bpermute((lane ^ o) << 2, __builtin_bit_cast(int, v))); }
__device__ __forceinline__ int shxi(int v, int o, int lane) { return __builtin_amdgcn_ds_bpermute((lane ^ o) << 2, v); }
__device__ __forceinline__ float wave_sum(float v, int lane) {
#pragma unroll
    for (int o = 1; o < 64; o <<= 1) v += shx(v, o, lane);
    return v;
}
__device__ __forceinline__ int wave_sum_dpp(int v) {
    int t = v + __builtin_amdgcn_update_dpp(0, v, 0x111, 0xf, 0xf, true);
    t += __builtin_amdgcn_update_dpp(0, v, 0x112, 0xf, 0xf, true);
    t += __builtin_amdgcn_update_dpp(0, v, 0x113, 0xf, 0xf, true);
    t += __builtin_amdgcn_update_dpp(0, t, 0x114, 0xf, 0xe, true);
    t += __builtin_amdgcn_update_dpp(0, t, 0x118, 0xf, 0xc, true);
    t += __builtin_amdgcn_update_dpp(0, t, 0x142, 0xa, 0xf, true);
    t += __builtin_amdgcn_update_dpp(0, t, 0x143, 0xc, 0xf, true);
    return __builtin_amdgcn_readlane(t, 63);
}
__device__ __forceinline__ int wave_sum_i(int v, int lane) {
#pragma unroll
    for (int o = 1; o < 64; o <<= 1) v += shxi(v, o, lane);
    return v;
}

namespace pg8 {
constexpr int BM = 256, BK = 64, HALF = 128, HTB = HALF * BK * 2, STAGE_BYTES = 8 * HTB, NXCD = 8, WGM = 8;
__host__ __device__ __forceinline__ int lds_byte(int r, int c) { const int st = (r >> 4) * 2 + (c >> 5), rr = r & 15, cc = c & 31, ob = rr * 64 + cc * 2; return st * 1024 + (ob ^ (((ob >> 9) & 1) << 5)); }
__host__ __device__ __forceinline__ void stage_rc(int b, int& R, int& C) { const int st = b / 1024, sb = b % 1024, swz = sb ^ (((sb >> 9) & 1) << 5); R = (st >> 1) * 16 + swz / 64; C = (st & 1) * 32 + (swz % 64) / 2; }
__host__ __device__ __forceinline__ int perm32(int rho) { const int n = rho >> 4, i = rho & 15; return 8 * (i >> 2) + 4 * n + (i & 3); }

struct Unit { long offA, offB; int gio, pm, pn, grp, kind, half, hsel; };

struct Sched {
    long A, B, sA, sB;
    int tA, tB; int nM, nN, nG, G, c; const int* gidx;
    int nExtra;
    int nFull;
    __device__ __forceinline__ bool next(int i, Unit& u) const {
        const int nreg = nM * nN * nG, ntot = nreg + nExtra; const int L0 = i * G + c;
        if (L0 >= nFull + 2 * (ntot - nFull)) return false;
        const bool hf = L0 >= nFull; const int L = hf ? nFull + ((L0 - nFull) >> 1) : L0; const int hs = hf ? ((L0 - nFull) & 1) : 0;
        const bool ex = L >= nreg;
        int wgid = ex ? 0 : L; { const int q = nreg / NXCD, r = nreg % NXCD, xcd = wgid % NXCD, off = wgid / NXCD; wgid = (xcd < r ? xcd * (q + 1) : r * (q + 1) + (xcd - r) * q) + off; }
        int pm, pn, grp;
        if (nG == 1) {
            const int nig = WGM * nN, gid = wgid / nig, fm = gid * WGM, gsz = (nM - fm) < WGM ? (nM - fm) : WGM;
            pm = fm + ((wgid % nig) % gsz); pn = (wgid % nig) / gsz; grp = 0;
        } else { const int per = nM * nN; grp = wgid / per; const int r = wgid % per; pm = r % nM; pn = r / nM; }
        const int j = L - nreg;
        u.pm = ex ? (j & 1) : pm; u.pn = ex ? (j >> 1) : pn; u.grp = ex ? 0 : grp; u.kind = ex ? 1 : 0; u.half = hf ? 1 : 0; u.hsel = hs;
        u.gio = grp * (nM * BM) + pm * BM;
        const long ra = A + grp * sA + (gidx ? 0 : (long)pm * tA), rb = B + grp * sB + (long)pn * tB;
        u.offA = (ex ? B + (long)(nN + (j & 1)) * tB : ra) + (long)hs * ((ex ? tB : tA) >> 1); u.offB = ex ? A + (long)(j >> 1) * tA : rb;
        return true;
    }
};

struct EpiBf16 {
    static constexpr bool PERM = true, INIT_ACC = false, HALVES = true;
    bf16_t* O; int ldc; int gcol; bf16_t* O2; int ldc2;
    __device__ __forceinline__ void operator()(const f32x4 (&acc)[2][2][4][2], const Unit& u, int wr, int wc, int fr, int fq) const {
        bf16_t* base; int ld;
        if (u.kind) { base = O2 + (size_t)(u.pm * BM) * ldc2 + u.pn * BM; ld = ldc2; } else { base = O + (size_t)(u.pm * BM) * ldc + u.pn * BM + u.grp * gcol; ld = ldc; }
        bf16_t* rowp = base + (unsigned)((wr * 64 + fr + u.hsel * HALF) * ld + wc * 32 + 8 * fq);
#pragma unroll
        for (int ai = 0; ai < 2; ++ai) {
            if (ai == 1 && u.half) break;
#pragma unroll
            for (int m = 0; m < 4; ++m) {
#pragma unroll
                for (int bj = 0; bj < 2; ++bj) { const f32x4 v0 = acc[ai][bj][m][0], v1 = acc[ai][bj][m][1];
                    u32x4 w; w.x = cvt_pk_bf16(v0[0], v0[1]); w.y = cvt_pk_bf16(v0[2], v0[3]); w.z = cvt_pk_bf16(v1[0], v1[1]); w.w = cvt_pk_bf16(v1[2], v1[3]);
                    *(u32x4*)(rowp + bj * HALF) = w; }
                rowp += 16 * ld; asm volatile("" : "+v"(rowp)); }
            rowp += (HALF - 64) * ld; }
    }
};
struct EpiResF32 {
    static constexpr bool PERM = false, INIT_ACC = true, HALVES = false;
    const float* R; float* X; int ldc;
    __device__ __forceinline__ void init(f32x4 (&acc)[2][2][4][2], const Unit& u, int wr, int wc, int fr, int fq) const {
        const size_t off0 = (size_t)(u.pm * BM + wr * 64 + fr) * ldc + u.pn * BM + wc * 32 + 4 * fq;
#pragma unroll
        for (int ai = 0; ai < 2; ++ai)
#pragma unroll
            for (int m = 0; m < 4; ++m) { const size_t off = off0 + (size_t)(ai * HALF + m * 16) * ldc;
#pragma unroll
                for (int bj = 0; bj < 2; ++bj)
#pragma unroll
                    for (int n = 0; n < 2; ++n) acc[ai][bj][m][n] = *(const f32x4*)(R + off + bj * HALF + n * 16); }
    }
    __device__ __forceinline__ void operator()(const f32x4 (&acc)[2][2][4][2], const Unit& u, int wr, int wc, int fr, int fq) const {
        const size_t off0 = (size_t)(u.pm * BM + wr * 64 + fr) * ldc + u.pn * BM + wc * 32 + 4 * fq;
#pragma unroll
        for (int ai = 0; ai < 2; ++ai)
#pragma unroll
            for (int m = 0; m < 4; ++m) { const size_t off = off0 + (size_t)(ai * HALF + m * 16) * ldc;
#pragma unroll
                for (int bj = 0; bj < 2; ++bj)
#pragma unroll
                    for (int n = 0; n < 2; ++n) *(f32x4*)(X + off + bj * HALF + n * 16) = acc[ai][bj][m][n]; }
    }
};
__device__ __forceinline__ float silu_mul(float g, float u) { return g * u * __builtin_amdgcn_rcpf(1.0f + __expf(-g)); }
struct EpiGU {
    static constexpr bool PERM = true, INIT_ACC = false, HALVES = false;
    bf16_t* HID;
    __device__ __forceinline__ void operator()(const f32x4 (&acc)[2][2][4][2], const Unit& u, int wr, int wc, int fr, int fq) const {
        bf16_t* base = HID + ((size_t)u.grp * CAP + u.pm * BM + wr * 64 + fr) * EH + u.pn * HALF + wc * 32 + 8 * fq;
#pragma unroll
        for (int ai = 0; ai < 2; ++ai)
#pragma unroll
            for (int m = 0; m < 4; ++m) { const f32x4 g0 = acc[ai][0][m][0], g1 = acc[ai][0][m][1], u0 = acc[ai][1][m][0], u1 = acc[ai][1][m][1];
                u32x4 w; w.x = cvt_pk_bf16(silu_mul(g0[0], u0[0]), silu_mul(g0[1], u0[1])); w.y = cvt_pk_bf16(silu_mul(g0[2], u0[2]), silu_mul(g0[3], u0[3]));
                w.z = cvt_pk_bf16(silu_mul(g1[0], u1[0]), silu_mul(g1[1], u1[1])); w.w = cvt_pk_bf16(silu_mul(g1[2], u1[2]), silu_mul(g1[3], u1[3]));
                *(u32x4*)(base + (size_t)(ai * HALF + m * 16) * EH) = w; }
    }
};
struct EpiDown {
    static constexpr bool PERM = true, INIT_ACC = false, HALVES = false;
    bf16_t* Y; const float* gate;
    __device__ __forceinline__ void operator()(const f32x4 (&acc)[2][2][4][2], const Unit& u, int wr, int wc, int fr, int fq) const {
        const int row0 = u.grp * CAP + u.pm * BM + wr * 64 + fr;
        bf16_t* base = Y + (size_t)row0 * D + u.pn * BM + wc * 32 + 8 * fq;
#pragma unroll
        for (int ai = 0; ai < 2; ++ai)
#pragma unroll
            for (int m = 0; m < 4; ++m) { const float gt = gate[row0 + ai * HALF + m * 16]; bf16_t* rowp = base + (size_t)(ai * HALF + m * 16) * D;
#pragma unroll
                for (int bj = 0; bj < 2; ++bj) { const f32x4 v0 = acc[ai][bj][m][0] * gt, v1 = acc[ai][bj][m][1] * gt;
                    u32x4 w; w.x = cvt_pk_bf16(v0[0], v0[1]); w.y = cvt_pk_bf16(v0[2], v0[3]); w.z = cvt_pk_bf16(v1[0], v1[1]); w.w = cvt_pk_bf16(v1[2], v1[3]);
                    *(u32x4*)(rowp + bj * HALF) = w; } }
    }
};

template <class Epi, bool GATHER>
__device__ __forceinline__ void gemm_phase(LAS unsigned char* lds, const int wid_in, const char* wsb, const int K, const int lda, const int ldb, const Sched& S, const Epi& E) {
    int wid = wid_in; asm volatile("" : "+s"(wid));
    const int lane = lane_id();
    const int tid = wid * 64 + lane, wr = wid >> 2, wc = wid & 3, fr = lane & 15, fq = lane >> 4;
    const int nt = K / BK;
    unsigned voffA[2][2], voffB[2];
#pragma unroll
    for (int i = 0; i < 2; ++i) { int R, C; stage_rc(tid * 16 + i * 8192, R, C); const int Rb = Epi::PERM ? ((R & ~31) + perm32(R & 31)) : R;
        voffA[0][i] = (unsigned)(R * lda + C) * 2u; voffA[1][i] = voffA[0][i]; voffB[i] = (unsigned)(Rb * ldb + C) * 2u; }
    const size_t hstepA = GATHER ? (size_t)0 : (size_t)HALF * lda * 2;
    const size_t kstep = (size_t)(BK * 2);
    const size_t hstepB = (size_t)HALF * ldb * 2;
    const unsigned ldsw = (unsigned)wid * 1024u;
    const int aoff = lds_byte(wr * 64 + fr, fq * 8), boff = lds_byte(wc * 32 + fr, fq * 8);
#define PG8_SA(b, h) (((b) * 2 + (h)) * HTB)
#define PG8_SB(b, h) ((4 + (b) * 2 + (h)) * HTB)
#define PG8_STAGEA(bufoff, gbase, h) do { _Pragma("unroll") for (int _i = 0; _i < 2; ++_i) \
        __builtin_amdgcn_global_load_lds((const unsigned*)((const char*)(gbase) + (h) * hstepA + voffA[GATHER ? (h) : 0][_i]), (LAS unsigned*)(lds + (bufoff) + ldsw + _i * 8192), 16, 0, 0); } while (0)
#define PG8_STAGEB(bufoff, gbase) do { _Pragma("unroll") for (int _i = 0; _i < 2; ++_i) \
        __builtin_amdgcn_global_load_lds((const unsigned*)((const char*)(gbase) + voffB[_i]), (LAS unsigned*)(lds + (bufoff) + ldsw + _i * 8192), 16, 0, 0); } while (0)
#define PG8_LDA(dst, b, h) do { _Pragma("unroll") for (int m = 0; m < 4; ++m) _Pragma("unroll") for (int k = 0; k < 2; ++k) dst[m][k] = *(const LAS bf16x8*)(lds + PG8_SA(b, h) + aoff + m * 2048 + k * 1024); } while (0)
#define PG8_LDB(dst, b, h) do { _Pragma("unroll") for (int n = 0; n < 2; ++n) _Pragma("unroll") for (int k = 0; k < 2; ++k) dst[n][k] = *(const LAS bf16x8*)(lds + PG8_SB(b, h) + boff + n * 2048 + k * 1024); } while (0)
#define PG8_MMA(ai, bj, At, Bt) do { __builtin_amdgcn_s_setprio(1); _Pragma("unroll") for (int m = 0; m < 4; ++m) _Pragma("unroll") for (int n = 0; n < 2; ++n) _Pragma("unroll") for (int k = 0; k < 2; ++k) \
        acc[ai][bj][m][n] = __builtin_amdgcn_mfma_f32_16x16x32_bf16(Bt[n][k], At[m][k], acc[ai][bj][m][n], 0, 0, 0); __builtin_amdgcn_s_setprio(0); } while (0)
#define PG8_WAIT_V(n) asm volatile("s_waitcnt vmcnt(" #n ")" ::: "memory")
#define PG8_WAIT_L(n) asm volatile("s_waitcnt lgkmcnt(" #n ")" ::: "memory")
#define PG8_BAR __builtin_amdgcn_s_barrier()
#define PG8_SCHED __builtin_amdgcn_sched_barrier(0)
#define PG8_GIDX(dst, uu) do { _Pragma("unroll") for (int _i = 0; _i < 2; ++_i) { int _R, _C; stage_rc(tid * 16 + _i * 8192, _R, _C); _Pragma("unroll") for (int _h = 0; _h < 2; ++_h) \
        dst[_h][_i] = (unsigned)(S.gidx[(uu).gio + _R + _h * HALF] * lda + _C) * 2u; } } while (0)
    Unit cur, nxt; int ui = 0;
    if (!S.next(0, cur)) return;
    f32x4 acc[2][2][4][2];
    if constexpr (Epi::INIT_ACC) { E.init(acc, cur, wr, wc, fr, fq); } else {
#pragma unroll
    for (int a = 0; a < 2; ++a)
#pragma unroll
        for (int b = 0; b < 2; ++b)
#pragma unroll
            for (int m = 0; m < 4; ++m)
#pragma unroll
                for (int n = 0; n < 2; ++n) acc[a][b][m][n] = (f32x4){0.f, 0.f, 0.f, 0.f};
    }
    bf16x8 At[4][2], B0[2][2], B1[2][2];
    const char* cA = wsb + cur.offA; const char* cB = wsb + cur.offB;
    if constexpr (GATHER) { PG8_GIDX(voffA, cur); }
    PG8_STAGEB(PG8_SB(0, 0), cB); PG8_STAGEB(PG8_SB(0, 1), cB + hstepB); PG8_STAGEA(PG8_SA(0, 0), cA, 0); PG8_STAGEA(PG8_SA(0, 1), cA, 1);
    if (wr == 1) PG8_BAR;
    PG8_WAIT_V(2); PG8_BAR;
    PG8_STAGEB(PG8_SB(1, 0), cB + kstep); PG8_STAGEA(PG8_SA(1, 0), cA + kstep, 0); PG8_STAGEB(PG8_SB(1, 1), cB + hstepB + kstep);
    PG8_WAIT_V(6); PG8_BAR;
    for (;;) {
        const bool has_next = S.next(ui + 1, nxt);
        const char* nA = has_next ? wsb + nxt.offA : cA; const char* nB = has_next ? wsb + nxt.offB : cB;
        for (int t = 0; t < nt; t += 2) {
            const bool last = (t == nt - 2);
            const char* a1 = cA + (size_t)(t + 1) * kstep;
            const char* a2 = last ? nA : cA + (size_t)(t + 2) * kstep; const char* b2 = last ? nB : cB + (size_t)(t + 2) * kstep;
            const char* a3 = a2 + kstep; const char* b3 = b2 + kstep;
            unsigned nv[2][2];
            if constexpr (GATHER) { if (last && has_next) { PG8_GIDX(nv, nxt); } }
            PG8_LDB(B0, 0, 0); PG8_LDB(B1, 0, 1); PG8_SCHED; PG8_LDA(At, 0, 0); PG8_STAGEA(PG8_SA(1, 1), a1, 1);
            if constexpr (GATHER) { if (last && has_next) {
#pragma unroll
                for (int _h = 0; _h < 2; ++_h)
#pragma unroll
                    for (int _i = 0; _i < 2; ++_i) voffA[_h][_i] = nv[_h][_i]; } }
            PG8_WAIT_V(8); PG8_WAIT_L(0); PG8_BAR; PG8_MMA(0, 0, At, B0); PG8_MMA(0, 1, At, B1); PG8_BAR; PG8_SCHED;
            PG8_LDA(At, 0, 1); PG8_STAGEB(PG8_SB(0, 0), b2); PG8_STAGEB(PG8_SB(0, 1), b2 + hstepB); PG8_STAGEA(PG8_SA(0, 0), a2, 0);
            PG8_WAIT_V(8); PG8_WAIT_L(0); PG8_BAR; if (!(Epi::HALVES && cur.half)) { PG8_MMA(1, 0, At, B0); PG8_MMA(1, 1, At, B1); } PG8_BAR; PG8_SCHED;
            PG8_LDB(B0, 1, 0); PG8_LDB(B1, 1, 1); PG8_SCHED; PG8_LDA(At, 1, 0); PG8_STAGEA(PG8_SA(0, 1), a2, 1);
            PG8_WAIT_V(8); PG8_WAIT_L(0); PG8_BAR; PG8_MMA(0, 0, At, B0); PG8_MMA(0, 1, At, B1); PG8_BAR; PG8_SCHED;
            PG8_LDA(At, 1, 1); PG8_STAGEB(PG8_SB(1, 0), b3); PG8_STAGEB(PG8_SB(1, 1), b3 + hstepB); PG8_STAGEA(PG8_SA(1, 0), a3, 0);
            PG8_WAIT_V(8); PG8_WAIT_L(0); PG8_BAR; if (!(Epi::HALVES && cur.half)) { PG8_MMA(1, 0, At, B0); PG8_MMA(1, 1, At, B1); } PG8_BAR; PG8_SCHED;
        }
        if (wr == 0) PG8_BAR;
        { const int le = lane_id(); E(acc, cur, wr, wc, le & 15, le >> 4); }
        if (!has_next) break;
        if constexpr (Epi::INIT_ACC) { E.init(acc, nxt, wr, wc, fr, fq); } else {
#pragma unroll
        for (int a = 0; a < 2; ++a)
#pragma unroll
            for (int b = 0; b < 2; ++b)
#pragma unroll
                for (int m = 0; m < 4; ++m)
#pragma unroll
                    for (int n = 0; n < 2; ++n) acc[a][b][m][n] = (f32x4){0.f, 0.f, 0.f, 0.f};
        }
        cur = nxt; cA = nA; cB = nB; ++ui;
        if (wr == 1) PG8_BAR;
    }
    PG8_WAIT_V(0);
    PG8_BAR;
#undef PG8_SA
#undef PG8_SB
#undef PG8_STAGEA
#undef PG8_STAGEB
#undef PG8_LDA
#undef PG8_LDB
#undef PG8_MMA
#undef PG8_WAIT_V
#undef PG8_WAIT_L
#undef PG8_BAR
#undef PG8_SCHED
#undef PG8_GIDX
}
}
#define XB_TMO      128
#define XB_XCNT(j)  (256  + 64 * (j))
#define XB_XSUB(j)  (1280 + 64 * (j))
#define XB_XGEN(j)  (2304 + 64 * (j))
#define XB_TOP      3328
#define XB_TOPGEN   3392
#define XCD_BAR_WORDS 3456
#define XB_SPIN_CAP (1u << 18)
__device__ __forceinline__ unsigned xb_ld(unsigned* p)              { return __hip_atomic_load(p, __ATOMIC_RELAXED, __HIP_MEMORY_SCOPE_AGENT); }
__device__ __forceinline__ unsigned xb_add(unsigned* p, unsigned v) { return __hip_atomic_fetch_add(p, v, __ATOMIC_RELAXED, __HIP_MEMORY_SCOPE_AGENT); }
__device__ __forceinline__ unsigned xb_xcc_id() { return (unsigned)__builtin_amdgcn_s_getreg((3 << 11) | 20) & 0xFu; }
#define XB_SPIN(cond, bar) do { unsigned _sp = 0; while (cond) { __builtin_amdgcn_s_sleep(1); \
    if ((++_sp & 255u) == 0u) { if (xb_ld(&(bar)[XB_TMO])) break; if (_sp > XB_SPIN_CAP) { atomicAdd(&(bar)[XB_TMO], 1u); break; } } } } while (0)
struct XcdBarrier { unsigned* bar; unsigned x; volatile LAS unsigned* st; };
__device__ __forceinline__ XcdBarrier xcd_barrier_post(unsigned* bar, volatile LAS unsigned* st, bool leader) {
    XcdBarrier b; b.bar = bar; b.x = xb_xcc_id(); b.st = st;
    if (leader) (void)xb_add(&bar[XB_XCNT(b.x)], 1u);
    return b;
}
__device__ __forceinline__ void xcd_barrier_complete(unsigned* bar, unsigned x, unsigned& nloc, unsigned& nx) {
    const unsigned G = gridDim.x * gridDim.y * gridDim.z;
    unsigned sum, cnt, mine, sp = 0u;
    for (;;) {
        sum = 0u; cnt = 0u; mine = 0u;
#pragma unroll
        for (unsigned j = 0; j < 16; ++j) { const unsigned c = xb_ld(&bar[XB_XCNT(j)]); sum += c; cnt += (c > 0u) ? 1u : 0u; mine = (j == x) ? c : mine; }
        if (sum == G) break;
        __builtin_amdgcn_s_sleep(1);
        if ((++sp & 255u) == 0u) { if (xb_ld(&bar[XB_TMO])) break; if (sp > XB_SPIN_CAP) { atomicAdd(&bar[XB_TMO], 1u); break; } }
    }
    nloc = mine > 0u ? mine : 1u; nx = cnt > 0u ? cnt : 1u;
}
__device__ __forceinline__ void xcd_barrier(const XcdBarrier& b, bool leader) {
    asm volatile("s_waitcnt vmcnt(0)" ::: "memory");
    __syncthreads();
    if (leader) {
        unsigned* bar = b.bar;
        __builtin_amdgcn_s_waitcnt(0);
        unsigned nloc = b.st[0], nx = b.st[1];
        if (nloc == 0u) { xcd_barrier_complete(bar, b.x, nloc, nx); b.st[0] = nloc; b.st[1] = nx; }
        const unsigned old = xb_add(&bar[XB_XSUB(b.x)], 1u);
        const unsigned gen = old / nloc;
        if (old + 1u == (gen + 1u) * nloc) {
            __builtin_amdgcn_fence(__ATOMIC_RELEASE, "agent");
            asm volatile("s_waitcnt vmcnt(0)" ::: "memory");
            const unsigned og = xb_add(&bar[XB_TOP], 1u);
            const unsigned tg = og / nx;
            if (og + 1u == (tg + 1u) * nx) xb_add(&bar[XB_TOPGEN], 1u);
            else XB_SPIN(xb_ld(&bar[XB_TOPGEN]) == tg, bar);
            __builtin_amdgcn_fence(__ATOMIC_ACQUIRE, "agent");
            xb_add(&bar[XB_XGEN(b.x)], 1u);
            asm volatile("s_waitcnt vmcnt(0)" ::: "memory");
        } else {
            XB_SPIN(xb_ld(&bar[XB_XGEN(b.x)]) == gen, bar);
            __builtin_amdgcn_fence(__ATOMIC_ACQUIRE, "agent");
            asm volatile("s_waitcnt vmcnt(0)" ::: "memory");
        }
    }
    __syncthreads();
}

struct Args {
    const float* x_in; const float* rel_bias; const float* norm_mix_g; const float* norm_ffn_g; const float* final_g;
    const float* ev_w_in; const float* ev_sink; const float* ev_w_out;
    const float* od_w_in; const float* od_conv_w; const float* od_pool_w; const float* od_pool_scale; const float* od_w_out;
    const float* moe_w_router; const float* moe_w_gate; const float* moe_w_up; const float* moe_w_down;
    float* X; unsigned char* ws; int ph_lo, ph_hi;
};
struct Ctx { LAS unsigned char* lds; int tid, lane, wave, vcu, G; };

__device__ __forceinline__ int t5_bucket(int rel) {
    const int n = rel < 0 ? -rel : rel; int b;
    if (n < 8) b = n; else if (n < 12) b = 8; else if (n < 16) b = 9; else if (n < 23) b = 10; else if (n < 32) b = 11;
    else if (n < 46) b = 12; else if (n < 64) b = 13; else if (n < 91) b = 14; else b = 15;
    return b + (rel > 0 ? 16 : 0);
}

__device__ __forceinline__ void cvt_item(const float* W, int ldw, int k0, int n0, bf16_t* WT, int ldd, int drow, const float* nscale, LAS float* scr, int lane) {
    const int lr = lane >> 4, lc = (lane & 15) * 4;
    f32x4 v[16];
    const float* src = W + (size_t)(k0 + lr) * ldw + n0 + lc;
#pragma unroll
    for (int i = 0; i < 16; ++i) v[i] = __builtin_nontemporal_load((const GAS f32x4*)(src + (size_t)(4 * i) * ldw));
#pragma unroll
    for (int i = 0; i < 16; ++i) { const int row = 4 * i + lr; *(LAS f32x4*)(scr + row * 64 + (lc ^ (4 * ((row >> 3) & 7)))) = v[i]; }
    LDS_WAIT(); asm volatile("" ::: "memory");
    const int c = lane & 7;
#pragma unroll
    for (int j = 0; j < 8; ++j) { const int n = (lane >> 3) + 8 * j; const LAS float* sp = scr + (8 * c) * 64 + (n ^ (4 * c)); const float sc = nscale ? nscale[n0 + n] : 1.0f;
        u32x4 o; o.x = pk2(sp[0 * 64] * sc, sp[1 * 64] * sc); o.y = pk2(sp[2 * 64] * sc, sp[3 * 64] * sc); o.z = pk2(sp[4 * 64] * sc, sp[5 * 64] * sc); o.w = pk2(sp[6 * 64] * sc, sp[7 * 64] * sc);
        __builtin_nontemporal_store(o, (GAS u32x4*)(WT + (size_t)(drow + n) * ldd + k0 + 8 * c)); }
    LDS_WAIT(); asm volatile("" ::: "memory");
}
__device__ __forceinline__ void norm_store_bf16(const f32x4 (&v)[8], const float* g, bf16_t* orow, int lane) {
    float ss = 0.f;
#pragma unroll
    for (int j = 0; j < 8; ++j) ss += (v[j].x * v[j].x + v[j].y * v[j].y) + (v[j].z * v[j].z + v[j].w * v[j].w);
    const float r = rsqrtf(wave_sum(ss, lane) * (1.0f / D) + EPS);
    GAS u32x2* o8 = (GAS u32x2*)orow + lane; const GAS f32x4* g4 = (const GAS f32x4*)g + lane;
#pragma unroll
    for (int j = 0; j < 8; ++j) { const f32x4 w = g4[64 * j]; u32x2 o; o.x = pk2(v[j].x * r * w.x, v[j].y * r * w.y); o.y = pk2(v[j].z * r * w.z, v[j].w * r * w.w); o8[64 * j] = o; }
}

#ifndef MK_ODDMIX2
#define MK_ODDMIX2 1
#endif
#ifndef MK_PV3
#define MK_PV3 1
#endif
#ifndef MK_UPHOST
#define MK_UPHOST 1
#endif
#ifndef MK_JITCVT
#define MK_JITCVT 1
#endif
__device__ __forceinline__ void moe_cvt(const Args& a, const Ctx& c, int l, int part, int rank0 = -1, int nrank = 0, int it_lo = 0, int it_hi = NE * 16 * 32) {
    LAS float* scr = (LAS float*)(c.lds + c.wave * 16384);
    int gw = (rank0 >= 0 ? rank0 : c.vcu) * NWAVES + c.wave; asm volatile("" : "+s"(gw));
    const int NGW = (rank0 >= 0 ? nrank : c.G) * NWAVES;
    unsigned char* ws = a.ws;
    const float* wsrc = (const float*)(((const unsigned long long*)((const float*)(ws + WS_PAR) + PAR_PTRS))[part]);
    if (part < 2) {
        for (int it = it_lo + gw; it < it_hi; it += NGW) { const int le = l * NE + it / 512, r2 = it % 512, kb = r2 / 16, nb = r2 % 16;
            const float* src = wsrc + (size_t)le * D * EH; const int n0 = nb * 64;
            cvt_item(src, EH, kb * 64, n0, (bf16_t*)(ws + WS_GU) + (size_t)le * 2048 * D, D, (n0 >> 7) * 256 + part * 128 + (n0 & 127), nullptr, scr, c.lane); }
    } else {
        for (int it = it_lo + gw; it < it_hi; it += NGW) { const int le = l * NE + it / 512, r = it % 512, kb = r / 32, nb = r % 32;
            cvt_item(wsrc + (size_t)le * EH * D, D, kb * 64, nb * 64, (bf16_t*)(ws + WS_DN) + (size_t)le * D * EH, EH, nb * 64, nullptr, scr, c.lane); }
    }
}

__device__ __forceinline__ u32x4 fftc_bfrag(const LAS float* c128, int w, int ks, int t, int fr, int fq) {
#if MK_FFTFUSE
    const int pq = t, k2 = 16 * w + fr; unsigned wv[4];
#else
    const int pq = w >> 2, k2 = 32 * (w & 3) + 16 * t + fr; unsigned wv[4];
#endif
#pragma unroll
    for (int jj = 0; jj < 4; ++jj) { float v[2];
#pragma unroll
        for (int e = 0; e < 2; ++e) { const int j = 2 * jj + e; const int ss = 32 * ks + 16 * (j >> 2) + 4 * fq + (j & 3); const int ri = ss >> 7, s2 = ss & 127; const int m = (s2 * k2) & 127;
            const float cs = c128[m], sn = c128[(m - 32) & 127];
            v[e] = (pq == 0) ? (ri == 0 ? cs : sn) : (ri == 0 ? -sn : cs); }
        wv[jj] = pk2(v[0], v[1]); }
    u32x4 ww; ww.x = wv[0]; ww.y = wv[1]; ww.z = wv[2]; ww.w = wv[3]; return ww;
}
__device__ __forceinline__ u32x4 fftc_cfrag(const LAS float* c128, int lt, int kap, int plane, int fr, int fq) {
    const int l = 16 * lt + fr; unsigned wv[4];
#pragma unroll
    for (int jj = 0; jj < 4; ++jj) { float v[2];
#pragma unroll
        for (int e = 0; e < 2; ++e) { const int j = 2 * jj + e; const int cch = 32 * kap + 16 * (j >> 2) + 4 * fq + (j & 3); const int m = (l * cch) & 127;
            v[e] = (plane == 0 ? c128[m] : c128[(m - 32) & 127]) * (1.0f / 1024.0f); }
        wv[jj] = pk2(v[0], v[1]); }
    u32x4 ww; ww.x = wv[0]; ww.y = wv[1]; ww.z = wv[2]; ww.w = wv[3]; return ww;
}
__device__ __forceinline__ void ffta_bfrag(const LAS float* c128, int jp, int ks, int fr, int fq, u32x4& wr_, u32x4& wi_) {
    unsigned re[4], im[4];
#pragma unroll
    for (int jj = 0; jj < 4; ++jj) { float cr[2], ci[2];
#pragma unroll
        for (int e = 0; e < 2; ++e) { const int j = 2 * jj + e; const int s1 = 32 * ks + 16 * (j >> 2) + 4 * fq + (j & 3); const int m = (s1 * (16 * jp + fr)) & 63; cr[e] = c128[2 * m]; ci[e] = -c128[2 * ((m - 16) & 63)]; }
        re[jj] = pk2(cr[0], cr[1]); im[jj] = pk2(ci[0], ci[1]); }
    wr_.x = re[0]; wr_.y = re[1]; wr_.z = re[2]; wr_.w = re[3]; wi_.x = im[0]; wi_.y = im[1]; wi_.z = im[2]; wi_.w = im[3];
}

__device__ __forceinline__ void p0_prologue(const Args& a, const Ctx& c) {
    LAS float* scr = (LAS float*)(c.lds + c.wave * 16384);
    const int gw = c.vcu * NWAVES + c.wave, NGW = c.G * NWAVES;
    unsigned char* ws = a.ws;
    LAS float* ctab = (LAS float*)(c.lds + RING_BYTES + 1024);
    __syncthreads();
    if (c.tid < 128) { float sn, cs; sincospif((float)c.tid * (1.0f / 64.0f), &sn, &cs); ctab[c.tid] = cs; }
    __syncthreads();
    if (c.vcu < 8) { const int ks = c.vcu;
#pragma unroll
        for (int t = 0; t < 2; ++t) ((GAS u32x4*)(ws + WS_FTC))[((c.wave * 8 + ks) * 2 + t) * 64 + c.lane] = fftc_bfrag(ctab, c.wave, ks, t, c.lane & 15, c.lane >> 4);
    } else if (c.vcu == 8) { u32x4 wr_, wi_; ffta_bfrag(ctab, c.wave >> 1, c.wave & 1, c.lane & 15, c.lane >> 4, wr_, wi_);
        ((GAS u32x4*)(ws + WS_FTA))[(c.wave * 2 + 0) * 64 + c.lane] = wr_; ((GAS u32x4*)(ws + WS_FTA))[(c.wave * 2 + 1) * 64 + c.lane] = wi_; }
#if MK_FFTFUSE
    else if (c.vcu == 9) {
#pragma unroll
        for (int q = 0; q < 8; ++q) ((GAS u32x4*)(ws + WS_FCO))[((c.wave * 4 + (q >> 1)) * 2 + (q & 1)) * 64 + c.lane] = fftc_cfrag(ctab, c.wave, q >> 1, q & 1, c.lane & 15, c.lane >> 4); }
#endif
#pragma unroll 1
    for (int pass = 0; pass < 2; ++pass) {
#if !MK_FFTFUSE
    if ((pass == 0) == (c.wave < 4)) {
        LAS float* sw = (LAS float*)(c.lds + c.wave * 16384);
        for (int it = gw; it < (NL / 2) * 4 * 64 * 4; it += NGW) {
            const int i = it / 1024, r = it % 1024, g = r / 256, nb = (r % 256) / 4, jq = r % 4;
            const float* wsrc = a.ev_w_out + (size_t)i * D * D + (size_t)(QDIM + 128 * g) * D + nb * 32;
            const int n = c.lane & 31, jb = jq * 64 + (c.lane >> 5) * 32;
            float accv[32];
#pragma unroll
            for (int q = 0; q < 32; ++q) accv[q] = 0.f;
            for (int lp = 0; lp < 2; ++lp) {
#pragma unroll 8
                for (int q = 0; q < 32; ++q) { const int ll = 2 * q + (c.lane >> 5); sw[ll * 32 + n] = wsrc[(size_t)(lp * 64 + ll) * D + n]; }
                LDS_WAIT(); asm volatile("" ::: "memory");
                for (int ll = 0; ll < 64; ++ll) { const float wv = sw[ll * 32 + n]; const int l = lp * 64 + ll;
#pragma unroll
                    for (int q = 0; q < 32; ++q) { const int j = jb + q; const int m = ((j & 127) * l) & 127; const float cf = (j < 128) ? ctab[m] : ctab[(m - 32) & 127]; accv[q] = fmaf(cf, wv, accv[q]); } }
                LDS_WAIT(); asm volatile("" ::: "memory");
            }
            bf16_t* dst = (bf16_t*)(ws + WS_EVOUT + i * SZ_EVOUT) + (size_t)(nb * 32 + n) * MIX_LD_EV + QDIM + g * 256 + jb;
#pragma unroll
            for (int q = 0; q < 4; ++q) { u32x4 o; o.x = pk2(accv[8 * q] * (1.f / 1024.f), accv[8 * q + 1] * (1.f / 1024.f)); o.y = pk2(accv[8 * q + 2] * (1.f / 1024.f), accv[8 * q + 3] * (1.f / 1024.f));
                o.z = pk2(accv[8 * q + 4] * (1.f / 1024.f), accv[8 * q + 5] * (1.f / 1024.f)); o.w = pk2(accv[8 * q + 6] * (1.f / 1024.f), accv[8 * q + 7] * (1.f / 1024.f)); *(GAS u32x4*)(dst + 8 * q) = o; }
        }
    }
#endif
    if (pass == 0) {
    for (int it = gw; it < (NL / 2) * 32 * 48; it += NGW) { const int i = it / (32 * 48), r = it % (32 * 48), kb = r / 48, nb = r % 48;
        const int n0 = nb * 64; const int drow = n0 < 2048 ? n0 : (n0 < 2560 ? n0 + 512 : n0 - 512);
        cvt_item(a.ev_w_in + (size_t)i * D * EV_IN, EV_IN, kb * 64, n0, (bf16_t*)(ws + WS_EVIN + i * SZ_EVIN), D, drow, nullptr, scr, c.lane); }
    constexpr int EVO_KB = MK_FFTFUSE ? 32 : 24;
    for (int it = gw; it < (NL / 2) * EVO_KB * 32; it += NGW) { const int i = it / (EVO_KB * 32), r = it % (EVO_KB * 32), kb = r / 32, nb = r % 32;
        cvt_item(a.ev_w_out + (size_t)i * D * D, D, kb * 64, nb * 64, (bf16_t*)(ws + WS_EVOUT + i * SZ_EVOUT), MIX_LD_EV, nb * 64, nullptr, scr, c.lane); }
    for (int it = gw; it < (NL / 2) * 32 * 64; it += NGW) { const int i = it / (32 * 64), r = it % (32 * 64), kb = r / 64, nb = r % 64;
        cvt_item(a.od_w_in + (size_t)i * D * OD_IN, OD_IN, kb * 64, nb * 64, (bf16_t*)(ws + WS_ODIN + i * SZ_ODIN), D, nb * 64, nullptr, scr, c.lane); }
    for (int it = gw; it < (NL / 2) * 32 * 32; it += NGW) { const int i = it / (32 * 32), r = it % (32 * 32), kb = r / 32, nb = r % 32;
        cvt_item(a.od_w_out + (size_t)i * D * D, D, kb * 64, nb * 64, (bf16_t*)(ws + WS_ODOUT + i * SZ_ODOUT), D, nb * 64, nullptr, scr, c.lane); }
    for (int it = (gw + NGW / 2) % NGW; it < (NL / 2) * 4 * 4 * 4; it += NGW) { const int ig = it / 16, i = ig / 4, g = ig % 4, r = it % 16, kb = r / 4, nb = r % 4;
        cvt_item(a.od_pool_w + ((size_t)i * 4 + g) * 65536, 256, kb * 64, nb * 64, (bf16_t*)(ws + WS_POOLW + i * SZ_POOL) + g * 65536, 256, nb * 64, a.od_pool_scale + i * POOLD + g * 256, scr, c.lane); }
    }
    }
    __syncthreads();
    {
        float* par = (float*)(ws + WS_PAR); const int gt = c.vcu * NTHREADS + c.tid, NGT = c.G * NTHREADS;
        if (gt == 0) { unsigned long long* pp = (unsigned long long*)(par + PAR_PTRS); pp[0] = (unsigned long long)a.moe_w_gate; pp[1] = (unsigned long long)a.moe_w_up; pp[2] = (unsigned long long)a.moe_w_down; }
        for (int i = gt; i < 384; i += NGT) par[PAR_RELB + i] = a.rel_bias[i];
        for (int i = gt; i < (NL / 2) * NQ; i += NGT) par[PAR_SINK + i] = a.ev_sink[i];
        for (int i = gt; i < NL * D; i += NGT) { par[PAR_GMIX + i] = a.norm_mix_g[i]; par[PAR_GFFN + i] = a.norm_ffn_g[i]; }
        for (int i = gt; i < D; i += NGT) par[PAR_GFIN + i] = a.final_g[i];
        for (int i = gt; i < (NL / 2) * 3 * CONVD; i += NGT) par[PAR_CONV + i] = a.od_conv_w[i];
        for (int i = gt; i < NL * D * NE; i += NGT) { const int l = i / (D * NE), r = i % (D * NE), e = r / D, d = r % D; par[PAR_ROUTER + i] = a.moe_w_router[(size_t)l * D * NE + d * NE + e]; }
    }
    for (int m = gw; m < S; m += 2 * NGW) { const int m1 = (m + NGW) < S ? m + NGW : m;
        const GAS f32x4* xa = (const GAS f32x4*)(a.x_in + (size_t)m * D) + c.lane; const GAS f32x4* xb = (const GAS f32x4*)(a.x_in + (size_t)m1 * D) + c.lane; f32x4 va[8], vb[8];
#pragma unroll
        for (int j = 0; j < 8; ++j) { va[j] = xa[64 * j]; vb[j] = xb[64 * j]; }
        norm_store_bf16(va, a.norm_mix_g, (bf16_t*)(ws + WS_H) + (size_t)m * D, c.lane);
        if (m1 != m) norm_store_bf16(vb, a.norm_mix_g, (bf16_t*)(ws + WS_H) + (size_t)m1 * D, c.lane); }
}

__device__ __forceinline__ void attn_unit(const Args& a, const Ctx& c, int layer_i, int blk, int kvh) {
    const bf16_t* QKF = (const bf16_t*)(a.ws + WS_Z); const bf16_t* VT = (const bf16_t*)(a.ws + WS_VT); bf16_t* MIX = (bf16_t*)(a.ws + WS_MIX);
    LAS unsigned char* band = c.lds;
    LAS float* bt = (LAS float*)(c.lds + 98304);
    const float* par = (const float*)(a.ws + WS_PAR);
    const int kb0 = 128 * (blk - 1);
    bf16x8 qfa[3][4];
    { const int fr_ = c.lane & 15, fq_ = c.lane >> 4; unsigned qoff = (unsigned)(((blk * 8 + c.wave) * 16 + fr_) * QKF_LD + kvh * 3 * HD + 8 * fq_) * 2u; asm volatile("" : "+v"(qoff));
#pragma unroll
      for (int hh = 0; hh < 3; ++hh)
#pragma unroll
          for (int ks = 0; ks < 4; ++ks) qfa[hh][ks] = *(const GAS bf16x8*)((const GAS char*)QKF + (size_t)qoff + hh * HD * 2 + 64 * ks); }
    __syncthreads();
    u32x4 kreg[12];
#pragma unroll
    for (int p = 0; p < 12; ++p) { const int id = c.tid + NTHREADS * p, row = id >> 4, ch = id & 15, key = kb0 + row; const int kc = key < 0 ? 0 : (key > S - 1 ? S - 1 : key);
        kreg[p] = *(const GAS u32x4*)(QKF + (size_t)kc * QKF_LD + QDIM + kvh * HD + ch * 8); }
    for (int i = c.tid; i < 3 * 257; i += NTHREADS) { const int hh = i / 257, r = i % 257; bt[hh * 260 + r] = par[PAR_RELB + t5_bucket(r - 128) * NQ + kvh * 3 + hh] * 1.4426950408889634f; }
#pragma unroll
    for (int p = 0; p < 12; ++p) { const int id = c.tid + NTHREADS * p, row = id >> 4, ch = id & 15, key = kb0 + row;
        if (key >= 0 && key < S) *(LAS u32x4*)(band + row * 256 + ((ch ^ (row & 15)) << 4)) = kreg[p]; }
    __syncthreads();
    const int fr = c.lane & 15, fq = c.lane >> 4, w = c.wave;
    const int q0 = (blk * 8 + w) * 16;
    unsigned pw[3][9][4]; float inv[3];
#pragma unroll
    for (int hh = 0; hh < 3; ++hh) {
        const int h = kvh * 3 + hh; const float snk = par[PAR_SINK + layer_i * NQ + h] * 1.4426950408889634f;
        bf16x8 qf[4];
#pragma unroll
        for (int ks = 0; ks < 4; ++ks) qf[ks] = qfa[hh][ks];
        f32x4 s[17];
#pragma unroll
        for (int kt = 0; kt < 17; ++kt) {
            const int key0 = q0 - WIN + 16 * kt;
            f32x4 acc = (f32x4){0.f, 0.f, 0.f, 0.f};
            if (key0 >= 0 && key0 < S) {
                const LAS unsigned char* kp = band + (16 * (w + kt) + fr) * 256;
#pragma unroll
                for (int ks = 0; ks < 4; ++ks) { const bf16x8 kf = *(const LAS bf16x8*)(kp + (((4 * ks + fq) ^ fr) << 4)); acc = __builtin_amdgcn_mfma_f32_16x16x32_bf16(kf, qf[ks], acc, 0, 0, 0); }
#pragma unroll
                for (int r = 0; r < 4; ++r) { const int rel = 16 * kt - WIN + 4 * fq + r - fr;
                    if (kt == 0 || kt == 16) { const bool ok = (rel >= -WIN) && (rel <= WIN); acc[r] = ok ? acc[r] * 0.12751743082459664f + bt[hh * 260 + (ok ? rel + WIN : 0)] : -1e30f; }
                    else acc[r] = acc[r] * 0.12751743082459664f + bt[hh * 260 + rel + WIN]; }
            } else { acc = (f32x4){-1e30f, -1e30f, -1e30f, -1e30f}; }
            s[kt] = acc;
        }
        float mx = -3.0e38f;
#pragma unroll
        for (int kt = 0; kt < 17; ++kt) mx = fmaxf(mx, fmaxf(fmaxf(s[kt][0], s[kt][1]), fmaxf(s[kt][2], s[kt][3])));
        mx = fmaxf(mx, shx(mx, 16, c.lane)); mx = fmaxf(mx, shx(mx, 32, c.lane)); mx = fmaxf(mx, snk);
        float sum = 0.f;
#pragma unroll
        for (int kt = 0; kt < 17; ++kt)
#pragma unroll
            for (int r = 0; r < 4; ++r) { const float pv = __builtin_amdgcn_exp2f(s[kt][r] - mx); s[kt][r] = pv; sum += pv; }
        sum += shx(sum, 16, c.lane); sum += shx(sum, 32, c.lane);
        inv[hh] = 1.0f / (sum + __builtin_amdgcn_exp2f(snk - mx));
        if (w & 1) {
#pragma unroll
            for (int kp = 0; kp < 9; ++kp) { pw[hh][kp][0] = (kp > 0) ? cvt_pk_bf16_v(s[kp > 0 ? 2 * kp - 1 : 0][0], s[kp > 0 ? 2 * kp - 1 : 0][1]) : 0u; pw[hh][kp][1] = (kp > 0) ? cvt_pk_bf16_v(s[kp > 0 ? 2 * kp - 1 : 0][2], s[kp > 0 ? 2 * kp - 1 : 0][3]) : 0u;
                pw[hh][kp][2] = cvt_pk_bf16_v(s[2 * kp][0], s[2 * kp][1]); pw[hh][kp][3] = cvt_pk_bf16_v(s[2 * kp][2], s[2 * kp][3]); }
        } else {
#pragma unroll
            for (int kp = 0; kp < 9; ++kp) { pw[hh][kp][0] = cvt_pk_bf16_v(s[2 * kp][0], s[2 * kp][1]); pw[hh][kp][1] = cvt_pk_bf16_v(s[2 * kp][2], s[2 * kp][3]);
                pw[hh][kp][2] = (kp < 8) ? cvt_pk_bf16_v(s[kp < 8 ? 2 * kp + 1 : 16][0], s[kp < 8 ? 2 * kp + 1 : 16][1]) : 0u; pw[hh][kp][3] = (kp < 8) ? cvt_pk_bf16_v(s[kp < 8 ? 2 * kp + 1 : 16][2], s[kp < 8 ? 2 * kp + 1 : 16][3]) : 0u; }
        }
        __builtin_amdgcn_sched_barrier(0);
    }
    __syncthreads();
#pragma unroll
    for (int p = 0; p < 12; ++p) { const int id = c.tid + NTHREADS * p, d = id / 48, pc = id % 48, b = pc >> 2, m = pc & 3, key = kb0 + 32 * b + 8 * m;
        u32x4 v = (u32x4){0u, 0u, 0u, 0u};
        if (key >= 0 && key < S) v = *(const GAS u32x4*)(VT + (size_t)(kvh * HD + d) * S + key);
        const int c0 = 4 * b + 2 * (m & 1), t = m >> 1; LAS unsigned char* rowp = band + d * 768;
        u32x2 lo; lo.x = v.x; lo.y = v.y; u32x2 hi; hi.x = v.z; hi.y = v.w;
        *(LAS u32x2*)(rowp + ((((c0 >> 4) << 4) + ((c0 & 15) ^ (d & 15))) << 4) + 8 * t) = lo;
        *(LAS u32x2*)(rowp + (((((c0 + 1) >> 4) << 4) + (((c0 + 1) & 15) ^ (d & 15))) << 4) + 8 * t) = hi; }
    __syncthreads();
#if MK_PV3
    {
        f32x4 o[3][8];
#pragma unroll
        for (int hh = 0; hh < 3; ++hh)
#pragma unroll
            for (int dt = 0; dt < 8; ++dt) o[hh][dt] = (f32x4){0.f, 0.f, 0.f, 0.f};
#pragma unroll
        for (int kp = 0; kp < 9; ++kp) {
            bf16x8 pf[3];
#pragma unroll
            for (int hh = 0; hh < 3; ++hh) { u32x4 pq; pq.x = pw[hh][kp][0]; pq.y = pw[hh][kp][1]; pq.z = pw[hh][kp][2]; pq.w = pw[hh][kp][3]; pf[hh] = __builtin_bit_cast(bf16x8, pq); }
            const int cc = 4 * ((w >> 1) + kp) + fq;
            const int poff = (((cc >> 4) << 4) + ((cc & 15) ^ fr)) << 4;
#pragma unroll
            for (int dt = 0; dt < 8; ++dt) { const bf16x8 vf = *(const LAS bf16x8*)(band + (16 * dt + fr) * 768 + poff);
#pragma unroll
                for (int hh = 0; hh < 3; ++hh) o[hh][dt] = __builtin_amdgcn_mfma_f32_16x16x32_bf16(vf, pf[hh], o[hh][dt], 0, 0, 0); }
        }
#pragma unroll
        for (int hh = 0; hh < 3; ++hh) { const int h = kvh * 3 + hh;
            unsigned ooff = (unsigned)((q0 + fr) * MIX_LD_EV + h * HD + 4 * fq) * 2u; asm volatile("" : "+v"(ooff));
            const float iv = inv[hh];
#pragma unroll
            for (int dt = 0; dt < 8; ++dt) { u32x2 wv; wv.x = cvt_pk_bf16(o[hh][dt][0] * iv, o[hh][dt][1] * iv); wv.y = cvt_pk_bf16(o[hh][dt][2] * iv, o[hh][dt][3] * iv); *(GAS u32x2*)((GAS char*)MIX + (size_t)ooff + 32 * dt) = wv; } }
    }
#else
#pragma unroll
    for (int hh = 0; hh < 3; ++hh) {
        const int h = kvh * 3 + hh;
        f32x4 o[8];
#pragma unroll
        for (int dt = 0; dt < 8; ++dt) o[dt] = (f32x4){0.f, 0.f, 0.f, 0.f};
#pragma unroll
        for (int kp = 0; kp < 9; ++kp) {
            u32x4 pq; pq.x = pw[hh][kp][0]; pq.y = pw[hh][kp][1]; pq.z = pw[hh][kp][2]; pq.w = pw[hh][kp][3];
            const bf16x8 pf = __builtin_bit_cast(bf16x8, pq);
            const int cc = 4 * ((w >> 1) + kp) + fq;
            const int poff = (((cc >> 4) << 4) + ((cc & 15) ^ fr)) << 4;
#pragma unroll
            for (int dt = 0; dt < 8; ++dt) { const bf16x8 vf = *(const LAS bf16x8*)(band + (16 * dt + fr) * 768 + poff);
                o[dt] = __builtin_amdgcn_mfma_f32_16x16x32_bf16(vf, pf, o[dt], 0, 0, 0); }
        }
        unsigned ooff = (unsigned)((q0 + fr) * MIX_LD_EV + h * HD + 4 * fq) * 2u; asm volatile("" : "+v"(ooff));
        const float iv = inv[hh];
#pragma unroll
        for (int dt = 0; dt < 8; ++dt) { u32x2 wv; wv.x = cvt_pk_bf16(o[dt][0] * iv, o[dt][1] * iv); wv.y = cvt_pk_bf16(o[dt][2] * iv, o[dt][3] * iv); *(GAS u32x2*)((GAS char*)MIX + (size_t)ooff + 32 * dt) = wv; }
    }
#endif
}

typedef short v4i16_t __attribute__((ext_vector_type(4)));
__device__ __forceinline__ s16x4 tr_read(const LAS unsigned char* p) { return __builtin_bit_cast(s16x4, __builtin_amdgcn_ds_read_tr16_b64_v4i16((LAS v4i16_t*)p)); }

constexpr int XS = 544;
__device__ __forceinline__ void ffta_unit(const Args& a, const Ctx& c, int g, int sb) {
    const bf16_t* F = (const bf16_t*)(a.ws + WS_Z) + QDIM + KVDIM + g * 128;
    bf16_t* TB = (bf16_t*)(a.ws + WS_TB);
    LAS unsigned char* X = c.lds;
    __syncthreads();
#pragma unroll
    for (int p = 0; p < 4; ++p) { const int id = c.tid + NTHREADS * p, s1 = id >> 5, ch = id & 31, ds2 = ch >> 4, c8 = (ch & 15) * 8;
        const u32x4 v = *(const GAS u32x4*)(F + (size_t)(128 * s1 + 2 * sb + ds2) * QKF_LD + c8);
        *(LAS u32x4*)(X + s1 * XS + (ds2 * 128 + c8) * 2) = v; }
    __syncthreads();
    const int fr = c.lane & 15, fq = c.lane >> 4, w = c.wave;
    bf16x8 af[2][2];
#pragma unroll
    for (int mt = 0; mt < 2; ++mt)
#pragma unroll
        for (int ks = 0; ks < 2; ++ks) {
            const LAS unsigned char* ap = X + (32 * ks + 4 * fq + (fr >> 2)) * XS + (32 * w + 16 * mt + 4 * (fr & 3)) * 2;
            const s16x4 t0 = tr_read(ap), t1 = tr_read(ap + 16 * XS);
            bf16x8 f; f[0] = t0[0]; f[1] = t0[1]; f[2] = t0[2]; f[3] = t0[3]; f[4] = t1[0]; f[5] = t1[1]; f[6] = t1[2]; f[7] = t1[3]; af[mt][ks] = f; }
    f32x4 acc[2][4][2];
#pragma unroll
    for (int jp = 0; jp < 4; ++jp) {
        bf16x8 bfr[2][2];
#pragma unroll
        for (int ks = 0; ks < 2; ++ks) { const GAS u32x4* ft = (const GAS u32x4*)(a.ws + WS_FTA) + ((jp * 2 + ks) * 2) * 64 + c.lane;
            bfr[0][ks] = __builtin_bit_cast(bf16x8, ft[0]); bfr[1][ks] = __builtin_bit_cast(bf16x8, ft[64]); }
#pragma unroll
        for (int mt = 0; mt < 2; ++mt) { f32x4 ar = (f32x4){0.f, 0.f, 0.f, 0.f}, ai = (f32x4){0.f, 0.f, 0.f, 0.f};
#pragma unroll
            for (int ks = 0; ks < 2; ++ks) { ar = __builtin_amdgcn_mfma_f32_16x16x32_bf16(af[mt][ks], bfr[0][ks], ar, 0, 0, 0); ai = __builtin_amdgcn_mfma_f32_16x16x32_bf16(af[mt][ks], bfr[1][ks], ai, 0, 0, 0); }
            acc[mt][jp][0] = ar; acc[mt][jp][1] = ai; }
        __builtin_amdgcn_sched_barrier(0);
    }
    const int s2 = 2 * sb + (w >> 2);
#pragma unroll
    for (int jp = 0; jp < 4; ++jp) { const int k1 = 16 * jp + fr; float sn, cs; sincospif((float)(s2 * k1) * (1.0f / 4096.0f), &sn, &cs);
#pragma unroll
        for (int mt = 0; mt < 2; ++mt) { const f32x4 re = acc[mt][jp][0], im = acc[mt][jp][1]; const int cc = 32 * (w & 3) + 16 * mt + 4 * fq;
            u32x2 tr, ti; tr.x = cvt_pk_bf16(re[0] * cs + im[0] * sn, re[1] * cs + im[1] * sn); tr.y = cvt_pk_bf16(re[2] * cs + im[2] * sn, re[3] * cs + im[3] * sn);
            ti.x = cvt_pk_bf16(im[0] * cs - re[0] * sn, im[1] * cs - re[1] * sn); ti.y = cvt_pk_bf16(im[2] * cs - re[2] * sn, im[3] * cs - re[3] * sn);
            bf16_t* tp = TB + ((size_t)((k1 * 4 + g) * 2) * 128 + s2) * 128 + cc;
            *(GAS u32x2*)tp = tr; *(GAS u32x2*)(tp + 128 * 128) = ti; } }
}

constexpr int TS = 288;
#if MK_FFTFUSE
__device__ __forceinline__ void fftc_unit(const Args& a, const Ctx& c, int k1, int g) {
    const bf16_t* T = (const bf16_t*)(a.ws + WS_TB) + (size_t)((k1 * 4 + g) * 2) * 128 * 128; bf16_t* MIX = (bf16_t*)(a.ws + WS_MIX);
    LAS unsigned char* X = c.lds;
    constexpr int CO_LO = 256 * 288, CO_HI = RING_BYTES + 1024 + 8192;
    __syncthreads();
    u32x4 bft[8][2];
    { const GAS u32x4* ft = (const GAS u32x4*)(a.ws + WS_FTC) + (size_t)(c.wave * 16) * 64 + c.lane;
#pragma unroll
      for (int q = 0; q < 16; ++q) bft[q >> 1][q & 1] = ft[q * 64]; }
#pragma unroll
    for (int p = 0; p < 8; ++p) { const int id = c.tid + NTHREADS * p, row = id >> 4, ch = id & 15; *(LAS u32x4*)(X + row * TS + ch * 16) = *(const GAS u32x4*)(T + (size_t)row * 128 + ch * 8); }
#pragma unroll
    for (int p = 0; p < 8; ++p) { const int f = (c.tid >> 6) + 8 * p; const u32x4 v = ((const GAS u32x4*)(a.ws + WS_FCO))[f * 64 + (c.tid & 63)];
        *(LAS u32x4*)(c.lds + (p < 7 ? CO_LO + f * 1024 : CO_HI + (f - 56) * 1024) + (c.tid & 63) * 16) = v; }
    __syncthreads();
    const int fr = c.lane & 15, fq = c.lane >> 4, w = c.wave;
    f32x4 acc[8][2];
#pragma unroll
    for (int mt = 0; mt < 8; ++mt) { acc[mt][0] = (f32x4){0.f, 0.f, 0.f, 0.f}; acc[mt][1] = (f32x4){0.f, 0.f, 0.f, 0.f}; }
#pragma unroll
    for (int ks = 0; ks < 8; ++ks) {
        bf16x8 bf[2]; bf[0] = __builtin_bit_cast(bf16x8, bft[ks][0]); bf[1] = __builtin_bit_cast(bf16x8, bft[ks][1]);
#pragma unroll
        for (int mt = 0; mt < 8; ++mt) {
            const LAS unsigned char* ap = X + (32 * ks + 4 * fq + (fr >> 2)) * TS + (16 * mt + 4 * (fr & 3)) * 2;
            const s16x4 t0 = tr_read(ap), t1 = tr_read(ap + 16 * TS);
            bf16x8 af; af[0] = t0[0]; af[1] = t0[1]; af[2] = t0[2]; af[3] = t0[3]; af[4] = t1[0]; af[5] = t1[1]; af[6] = t1[2]; af[7] = t1[3];
            acc[mt][0] = __builtin_amdgcn_mfma_f32_16x16x32_bf16(af, bf[0], acc[mt][0], 0, 0, 0);
            acc[mt][1] = __builtin_amdgcn_mfma_f32_16x16x32_bf16(af, bf[1], acc[mt][1], 0, 0, 0);
        }
        __builtin_amdgcn_sched_barrier(0);
    }
    bf16x8 pb[4][2];
#pragma unroll
    for (int kap = 0; kap < 4; ++kap)
#pragma unroll
        for (int pl = 0; pl < 2; ++pl) { u32x4 q; q.x = cvt_pk_bf16(acc[2 * kap][pl][0], acc[2 * kap][pl][1]); q.y = cvt_pk_bf16(acc[2 * kap][pl][2], acc[2 * kap][pl][3]);
            q.z = cvt_pk_bf16(acc[2 * kap + 1][pl][0], acc[2 * kap + 1][pl][1]); q.w = cvt_pk_bf16(acc[2 * kap + 1][pl][2], acc[2 * kap + 1][pl][3]); pb[kap][pl] = __builtin_bit_cast(bf16x8, q); }
    bf16_t* op = MIX + (size_t)(k1 + 64 * (16 * w + fr)) * MIX_LD_EV + QDIM + g * 128 + 4 * fq;
#pragma unroll
    for (int lt = 0; lt < 8; ++lt) { f32x4 o = (f32x4){0.f, 0.f, 0.f, 0.f};
#pragma unroll
        for (int kap = 0; kap < 4; ++kap)
#pragma unroll
            for (int pl = 0; pl < 2; ++pl) { const int f = (lt * 4 + kap) * 2 + pl; const bf16x8 cf = *(const LAS bf16x8*)(c.lds + (f < 56 ? CO_LO + f * 1024 : CO_HI + (f - 56) * 1024) + c.lane * 16);
                o = __builtin_amdgcn_mfma_f32_16x16x32_bf16(cf, pb[kap][pl], o, 0, 0, 0); }
        u32x2 ov; ov.x = cvt_pk_bf16(o[0], o[1]); ov.y = cvt_pk_bf16(o[2], o[3]); *(GAS u32x2*)(op + 16 * lt) = ov; }
}
#else
__device__ __forceinline__ void fftc_unit(const Args& a, const Ctx& c, int k1, int g) {
    const bf16_t* T = (const bf16_t*)(a.ws + WS_TB) + (size_t)((k1 * 4 + g) * 2) * 128 * 128; bf16_t* MIX = (bf16_t*)(a.ws + WS_MIX);
    LAS unsigned char* X = c.lds;
    __syncthreads();
    u32x4 bft[8][2];
    { const GAS u32x4* ft = (const GAS u32x4*)(a.ws + WS_FTC) + (size_t)(c.wave * 16) * 64 + c.lane;
#pragma unroll
      for (int q = 0; q < 16; ++q) bft[q >> 1][q & 1] = ft[q * 64]; }
#pragma unroll
    for (int p = 0; p < 8; ++p) { const int id = c.tid + NTHREADS * p, row = id >> 4, ch = id & 15; *(LAS u32x4*)(X + row * TS + ch * 16) = *(const GAS u32x4*)(T + (size_t)row * 128 + ch * 8); }
    __syncthreads();
    const int fr = c.lane & 15, fq = c.lane >> 4, w = c.wave, pq = w >> 2;
    f32x4 acc[8][2];
#pragma unroll
    for (int mt = 0; mt < 8; ++mt) { acc[mt][0] = (f32x4){0.f, 0.f, 0.f, 0.f}; acc[mt][1] = (f32x4){0.f, 0.f, 0.f, 0.f}; }
#pragma unroll
    for (int ks = 0; ks < 8; ++ks) {
        bf16x8 bf[2]; bf[0] = __builtin_bit_cast(bf16x8, bft[ks][0]); bf[1] = __builtin_bit_cast(bf16x8, bft[ks][1]);
#pragma unroll
        for (int mt = 0; mt < 8; ++mt) {
            const LAS unsigned char* ap = X + (32 * ks + 4 * fq + (fr >> 2)) * TS + (16 * mt + 4 * (fr & 3)) * 2;
            const s16x4 t0 = tr_read(ap), t1 = tr_read(ap + 16 * TS);
            bf16x8 af; af[0] = t0[0]; af[1] = t0[1]; af[2] = t0[2]; af[3] = t0[3]; af[4] = t1[0]; af[5] = t1[1]; af[6] = t1[2]; af[7] = t1[3];
            acc[mt][0] = __builtin_amdgcn_mfma_f32_16x16x32_bf16(af, bf[0], acc[mt][0], 0, 0, 0);
            acc[mt][1] = __builtin_amdgcn_mfma_f32_16x16x32_bf16(af, bf[1], acc[mt][1], 0, 0, 0);
        }
        __builtin_amdgcn_sched_barrier(0);
    }
#pragma unroll
    for (int t = 0; t < 2; ++t) { const int k2 = 32 * (w & 3) + 16 * t + fr; bf16_t* op = MIX + (size_t)(k1 + 64 * k2) * MIX_LD_EV + QDIM + g * 256 + pq * 128 + 4 * fq;
#pragma unroll
        for (int mt = 0; mt < 8; ++mt) { u32x2 o; o.x = cvt_pk_bf16(acc[mt][t][0], acc[mt][t][1]); o.y = cvt_pk_bf16(acc[mt][t][2], acc[mt][t][3]); *(GAS u32x2*)(op + 16 * mt) = o; } }
}
#endif

__device__ __forceinline__ void bf8_to_f32(const u32x4 w, float (&f)[8]) { f[0] = bf_lo(w.x); f[1] = bf_hi(w.x); f[2] = bf_lo(w.y); f[3] = bf_hi(w.y); f[4] = bf_lo(w.z); f[5] = bf_hi(w.z); f[6] = bf_lo(w.w); f[7] = bf_hi(w.w); }
__device__ __forceinline__ void oddmix_unit(const Args& a, const Ctx& c, int layer_i, int unit) {
    const bf16_t* Z = (const bf16_t*)(a.ws + WS_Z); bf16_t* MIX = (bf16_t*)(a.ws + WS_MIX); bf16_t* PO = (bf16_t*)(a.ws + WS_POOLED);
    if (c.wave < 4) {
        const int t0 = unit * 32 + (c.wave >> 1) * 16, ch = ((c.wave & 1) * 64 + c.lane) * 8;
        const float* cw = (const float*)(a.ws + WS_PAR) + PAR_CONV + layer_i * 3 * CONVD + ch;
        float w0[8], w1[8], w2[8];
#pragma unroll
        for (int q = 0; q < 8; ++q) { w0[q] = cw[q]; w1[q] = cw[CONVD + q]; w2[q] = cw[2 * CONVD + q]; }
        float pm[8], pc[8], pn[8], fa[8], fb[8];
#pragma unroll
        for (int q = 0; q < 8; ++q) pm[q] = 0.f;
        if (t0 > 0) { bf8_to_f32(*(const GAS u32x4*)(Z + (size_t)(t0 - 1) * OD_IN + CONVD + ch), fa); bf8_to_f32(*(const GAS u32x4*)(Z + (size_t)(t0 - 1) * OD_IN + 2 * CONVD + ch), fb);
#pragma unroll
            for (int q = 0; q < 8; ++q) pm[q] = fa[q] * fb[q]; }
        bf8_to_f32(*(const GAS u32x4*)(Z + (size_t)t0 * OD_IN + CONVD + ch), fa); bf8_to_f32(*(const GAS u32x4*)(Z + (size_t)t0 * OD_IN + 2 * CONVD + ch), fb);
#pragma unroll
        for (int q = 0; q < 8; ++q) pc[q] = fa[q] * fb[q];
#pragma unroll 4
        for (int t = t0; t < t0 + 16; ++t) {
#pragma unroll
            for (int q = 0; q < 8; ++q) pn[q] = 0.f;
            if (t + 1 < S) { bf8_to_f32(*(const GAS u32x4*)(Z + (size_t)(t + 1) * OD_IN + CONVD + ch), fa); bf8_to_f32(*(const GAS u32x4*)(Z + (size_t)(t + 1) * OD_IN + 2 * CONVD + ch), fb);
#pragma unroll
                for (int q = 0; q < 8; ++q) pn[q] = fa[q] * fb[q]; }
            bf8_to_f32(*(const GAS u32x4*)(Z + (size_t)t * OD_IN + ch), fa);
            float o[8];
#pragma unroll
            for (int q = 0; q < 8; ++q) { o[q] = fa[q] * (w0[q] * pm[q] + w1[q] * pc[q] + w2[q] * pn[q]); pm[q] = pc[q]; pc[q] = pn[q]; }
            u32x4 ov; ov.x = pk2(o[0], o[1]); ov.y = pk2(o[2], o[3]); ov.z = pk2(o[4], o[5]); ov.w = pk2(o[6], o[7]);
            *(GAS u32x4*)(MIX + (size_t)t * D + ch) = ov;
        }
    } else {
        const int g = c.wave - 4, lo = 1 << g, hi = lo - 1;
        const int t0 = unit * 32 + (c.lane >> 5) * 16, ch = g * 256 + (c.lane & 31) * 8;
        const bf16_t* zp = Z + 3 * CONVD + ch;
        float sm[8], fa[8];
#pragma unroll
        for (int q = 0; q < 8; ++q) sm[q] = 0.f;
        for (int tt = t0 - lo; tt <= t0 + hi; ++tt) if (tt >= 0 && tt < S) { bf8_to_f32(*(const GAS u32x4*)(zp + (size_t)tt * OD_IN), fa);
#pragma unroll
            for (int q = 0; q < 8; ++q) sm[q] += fa[q]; }
#pragma unroll 2
        for (int t = t0; t < t0 + 16; ++t) {
            const int aa = t - lo < 0 ? 0 : t - lo, bb = t + hi > S - 1 ? S - 1 : t + hi; const float rc = 1.0f / (float)(bb - aa + 1);
            bf8_to_f32(*(const GAS u32x4*)(zp + (size_t)t * OD_IN), fa);
            u32x4 ov; ov.x = pk2(sm[0] * rc - fa[0], sm[1] * rc - fa[1]); ov.y = pk2(sm[2] * rc - fa[2], sm[3] * rc - fa[3]); ov.z = pk2(sm[4] * rc - fa[4], sm[5] * rc - fa[5]); ov.w = pk2(sm[6] * rc - fa[6], sm[7] * rc - fa[7]);
            { const int tok = t - unit * 32; *(LAS u32x4*)(c.lds + tok * 2048 + ((((ch >> 3) & ~15) | (((ch >> 3) & 15) ^ (tok & 15))) << 4)) = ov; }
            if (t + 1 + hi < S) { bf8_to_f32(*(const GAS u32x4*)(zp + (size_t)(t + 1 + hi) * OD_IN), fa);
#pragma unroll
                for (int q = 0; q < 8; ++q) sm[q] += fa[q]; }
            if (t - lo >= 0) { bf8_to_f32(*(const GAS u32x4*)(zp + (size_t)(t - lo) * OD_IN), fa);
#pragma unroll
                for (int q = 0; q < 8; ++q) sm[q] -= fa[q]; }
        }
    }
    __syncthreads();
    {
        const int fr = c.lane & 15, fq = c.lane >> 4, g = c.wave >> 1, mt0 = 8 * (c.wave & 1);
        const bf16_t* Wp = (const bf16_t*)(a.ws + WS_POOLW + layer_i * SZ_POOL) + (size_t)g * 65536;
        bf16x8 bfr[2][8];
#pragma unroll
        for (int nt = 0; nt < 2; ++nt)
#pragma unroll
            for (int ks = 0; ks < 8; ++ks) { const int tok = 16 * nt + fr, c16 = g * 32 + 4 * ks + fq; bfr[nt][ks] = *(const LAS bf16x8*)(c.lds + tok * 2048 + (((c16 & ~15) | ((c16 & 15) ^ fr)) << 4)); }
        unsigned woff = (unsigned)((16 * mt0 + fr) * 256 + 8 * fq) * 2u; asm volatile("" : "+v"(woff));
        bf16x8 af[8], an[8];
#pragma unroll
        for (int ks = 0; ks < 8; ++ks) af[ks] = *(const GAS bf16x8*)((const GAS char*)Wp + (size_t)woff + 64 * ks);
#pragma unroll 1
        for (int mi = 0; mi < 8; ++mi) {
            if (mi + 1 < 8) {
#pragma unroll
                for (int ks = 0; ks < 8; ++ks) an[ks] = *(const GAS bf16x8*)((const GAS char*)Wp + (size_t)woff + (size_t)(mi + 1) * (16 * 256 * 2) + 64 * ks); }
            f32x4 acc0 = (f32x4){0.f, 0.f, 0.f, 0.f}, acc1 = (f32x4){0.f, 0.f, 0.f, 0.f};
#pragma unroll
            for (int ks = 0; ks < 8; ++ks) { acc0 = __builtin_amdgcn_mfma_f32_16x16x32_bf16(af[ks], bfr[0][ks], acc0, 0, 0, 0); acc1 = __builtin_amdgcn_mfma_f32_16x16x32_bf16(af[ks], bfr[1][ks], acc1, 0, 0, 0); }
            const int dcol = CONVD + g * 256 + 16 * (mt0 + mi) + 4 * fq;
            u32x2 o0; o0.x = cvt_pk_bf16(acc0[0], acc0[1]); o0.y = cvt_pk_bf16(acc0[2], acc0[3]); *(GAS u32x2*)(MIX + (size_t)(unit * 32 + fr) * D + dcol) = o0;
            u32x2 o1; o1.x = cvt_pk_bf16(acc1[0], acc1[1]); o1.y = cvt_pk_bf16(acc1[2], acc1[3]); *(GAS u32x2*)(MIX + (size_t)(unit * 32 + 16 + fr) * D + dcol) = o1;
#pragma unroll
            for (int ks = 0; ks < 8; ++ks) af[ks] = an[ks];
        }
    }
    __syncthreads();
}

template <int G>
__device__ __forceinline__ void oddmix_pool(const bf16_t* zp, int t0, int ltok, int cl, LAS unsigned char* lds) {
    constexpr int LO = 1 << G, HI = LO - 1, W = 2 * LO, NR = 8 + W - 1;
    u32x4 rw[NR];
    const bf16_t* zb = zp + (size_t)t0 * OD_IN;
#pragma unroll
    for (int r = 0; r < NR; ++r) { const int tt = t0 - LO + r; const int d = (tt >= 0 && tt < S) ? (r - LO) * OD_IN : 0; rw[r] = *(const GAS u32x4*)(zb + d); }
    float sm[8], fa[8];
#pragma unroll
    for (int q = 0; q < 8; ++q) sm[q] = 0.f;
#pragma unroll
    for (int r = 0; r < W; ++r) { const int tt = t0 - LO + r; if (tt >= 0 && tt < S) { bf8_to_f32(rw[r], fa);
#pragma unroll
        for (int q = 0; q < 8; ++q) sm[q] += fa[q]; } }
#pragma unroll
    for (int i = 0; i < 8; ++i) { const int t = t0 + i;
        const int aa = t - LO < 0 ? 0 : t - LO, bb = t + HI > S - 1 ? S - 1 : t + HI; const float rc = 1.0f / (float)(bb - aa + 1);
        bf8_to_f32(rw[i + LO], fa);
        u32x4 ov; ov.x = pk2(sm[0] * rc - fa[0], sm[1] * rc - fa[1]); ov.y = pk2(sm[2] * rc - fa[2], sm[3] * rc - fa[3]); ov.z = pk2(sm[4] * rc - fa[4], sm[5] * rc - fa[5]); ov.w = pk2(sm[6] * rc - fa[6], sm[7] * rc - fa[7]);
        { const int tok = ltok + i; *(LAS u32x4*)(lds + tok * 512 + (((cl & ~15) | ((cl & 15) ^ (tok & 15))) << 4)) = ov; }
        if (i < 7) {
            if (t + 1 + HI < S) { bf8_to_f32(rw[i + W], fa);
#pragma unroll
                for (int q = 0; q < 8; ++q) sm[q] += fa[q]; }
            if (t - LO >= 0) { bf8_to_f32(rw[i], fa);
#pragma unroll
                for (int q = 0; q < 8; ++q) sm[q] -= fa[q]; } }
    }
}
__device__ __forceinline__ void oddmix_unit2(const Args& a, const Ctx& c, int layer_i, int unit) {
    const bf16_t* Z = (const bf16_t*)(a.ws + WS_Z); bf16_t* MIX = (bf16_t*)(a.ws + WS_MIX);
    const int tb = unit >> 2, g = unit & 3;
    const int tg = c.tid >> 5, cl = c.tid & 31;
    const int t0 = tb * 128 + tg * 8, ch = g * 256 + cl * 8;
    {
        u32x4 ra[10], rb[10], rg[8];
        const bf16_t* zb = Z + (size_t)t0 * OD_IN + ch;
#pragma unroll
        for (int r = 0; r < 10; ++r) { const int tt = t0 - 1 + r; const int d = (tt >= 0 && tt < S) ? (r - 1) * OD_IN : 0;
            ra[r] = *(const GAS u32x4*)(zb + d + CONVD); rb[r] = *(const GAS u32x4*)(zb + d + 2 * CONVD); }
#pragma unroll
        for (int r = 0; r < 8; ++r) rg[r] = *(const GAS u32x4*)(zb + r * OD_IN);
        const float* cw = (const float*)(a.ws + WS_PAR) + PAR_CONV + layer_i * 3 * CONVD + ch;
        float w0[8], w1[8], w2[8];
#pragma unroll
        for (int q = 0; q < 8; ++q) { w0[q] = cw[q]; w1[q] = cw[CONVD + q]; w2[q] = cw[2 * CONVD + q]; }
        float pm[8], pc[8], pn[8], fa[8], fb[8];
        { bf8_to_f32(ra[0], fa); bf8_to_f32(rb[0], fb); const float v = (t0 - 1 >= 0) ? 1.f : 0.f;
#pragma unroll
          for (int q = 0; q < 8; ++q) pm[q] = fa[q] * fb[q] * v; }
        { bf8_to_f32(ra[1], fa); bf8_to_f32(rb[1], fb);
#pragma unroll
          for (int q = 0; q < 8; ++q) pc[q] = fa[q] * fb[q]; }
#pragma unroll
        for (int i = 0; i < 8; ++i) { const int t = t0 + i;
            bf8_to_f32(ra[i + 2], fa); bf8_to_f32(rb[i + 2], fb); const float v = (t + 1 < S) ? 1.f : 0.f;
#pragma unroll
            for (int q = 0; q < 8; ++q) pn[q] = fa[q] * fb[q] * v;
            bf8_to_f32(rg[i], fa);
            float o[8];
#pragma unroll
            for (int q = 0; q < 8; ++q) { o[q] = fa[q] * (w0[q] * pm[q] + w1[q] * pc[q] + w2[q] * pn[q]); pm[q] = pc[q]; pc[q] = pn[q]; }
            u32x4 ov; ov.x = pk2(o[0], o[1]); ov.y = pk2(o[2], o[3]); ov.z = pk2(o[4], o[5]); ov.w = pk2(o[6], o[7]);
            *(GAS u32x4*)(MIX + (size_t)t * D + ch) = ov; }
    }
    const int fr = c.lane & 15, fq = c.lane >> 4;
    const bf16_t* Wp = (const bf16_t*)(a.ws + WS_POOLW + layer_i * SZ_POOL) + (size_t)g * 65536 + (size_t)(32 * c.wave + fr) * 256 + 8 * fq;
    bf16x8 wf[2][8];
#pragma unroll
    for (int mt = 0; mt < 2; ++mt)
#pragma unroll
        for (int ks = 0; ks < 8; ++ks) wf[mt][ks] = *(const GAS bf16x8*)(Wp + mt * 16 * 256 + 32 * ks);
    { int t0p = t0; asm volatile("" : "+v"(t0p)); const bf16_t* zp = Z + 3 * CONVD + ch;
      if (g == 0) oddmix_pool<0>(zp, t0p, tg * 8, cl, c.lds); else if (g == 1) oddmix_pool<1>(zp, t0p, tg * 8, cl, c.lds); else if (g == 2) oddmix_pool<2>(zp, t0p, tg * 8, cl, c.lds); else oddmix_pool<3>(zp, t0p, tg * 8, cl, c.lds); }
    __syncthreads();
#pragma unroll
    for (int nt = 0; nt < 8; ++nt) {
        bf16x8 bfr[8];
#pragma unroll
        for (int ks = 0; ks < 8; ++ks) { const int tok = 16 * nt + fr, c16 = 4 * ks + fq; bfr[ks] = *(const LAS bf16x8*)(c.lds + tok * 512 + (((c16 & ~15) | ((c16 & 15) ^ fr)) << 4)); }
        f32x4 acc0 = (f32x4){0.f, 0.f, 0.f, 0.f}, acc1 = (f32x4){0.f, 0.f, 0.f, 0.f};
#pragma unroll
        for (int ks = 0; ks < 8; ++ks) { acc0 = __builtin_amdgcn_mfma_f32_16x16x32_bf16(wf[0][ks], bfr[ks], acc0, 0, 0, 0); acc1 = __builtin_amdgcn_mfma_f32_16x16x32_bf16(wf[1][ks], bfr[ks], acc1, 0, 0, 0); }
        bf16_t* op = MIX + (size_t)(tb * 128 + 16 * nt + fr) * D + CONVD + g * 256 + 32 * c.wave + 4 * fq;
        u32x2 o0; o0.x = cvt_pk_bf16(acc0[0], acc0[1]); o0.y = cvt_pk_bf16(acc0[2], acc0[3]); *(GAS u32x2*)op = o0;
        u32x2 o1; o1.x = cvt_pk_bf16(acc1[0], acc1[1]); o1.y = cvt_pk_bf16(acc1[2], acc1[3]); *(GAS u32x2*)(op + 16) = o1;
    }
    __syncthreads();
}

__device__ __forceinline__ void norm_router_stage(const Args& a, const Ctx& c, int layer) {
    LAS float* wT = (LAS float*)c.lds; const float* par = (const float*)(a.ws + WS_PAR); const float* wr = par + PAR_ROUTER + (size_t)layer * D * NE;
    __syncthreads();
    for (int i = c.tid; i < D * NE / 4; i += NTHREADS) ((LAS f32x4*)wT)[i] = ((const GAS f32x4*)wr)[i];
    LAS f32x4* gl = (LAS f32x4*)(c.lds + RING_BYTES + 1024);
    c.tid < D / 4 ? (void)(gl[c.tid] = ((const GAS f32x4*)(par + PAR_GFFN + (size_t)layer * D))[c.tid]) : (void)0;
    __syncthreads();
}
__device__ __forceinline__ void norm_router_phase(const Args& a, const Ctx& c, int layer, bool staged = false) {
    LAS float* wT = (LAS float*)c.lds;
    const float* par = (const float*)(a.ws + WS_PAR); const float* wr = par + PAR_ROUTER + (size_t)layer * D * NE;
    int gw = c.vcu * NWAVES + c.wave; asm volatile("" : "+s"(gw));
    const int NGW = c.G * NWAVES, lane = c.lane;
    float* AFF = (float*)(a.ws + WS_AFF); bf16_t* H = (bf16_t*)(a.ws + WS_H);
    f32x4 n0[8], n1[8];
    { const int mb = (gw + NGW) < S ? gw + NGW : gw;
#pragma unroll
        for (int j = 0; j < 8; ++j) { n0[j] = ((const GAS f32x4*)(a.X + (size_t)gw * D))[lane + 64 * j]; n1[j] = ((const GAS f32x4*)(a.X + (size_t)mb * D))[lane + 64 * j]; } }
    LAS f32x4* gl = (LAS f32x4*)(c.lds + RING_BYTES + 1024);
    if (!staged) {
    __syncthreads();
    for (int i = c.tid; i < D * NE / 4; i += NTHREADS) ((LAS f32x4*)wT)[i] = ((const GAS f32x4*)wr)[i];
    c.tid < D / 4 ? (void)(gl[c.tid] = ((const GAS f32x4*)(par + PAR_GFFN + (size_t)layer * D))[c.tid]) : (void)0;
    }
    __syncthreads();
    for (int m = gw; m < S; m += 2 * NGW) {
        const bool two = (m + NGW) < S; const int m1 = two ? m + NGW : m;
        f32x4 v0[8], v1[8]; float ss0 = 0.f, ss1 = 0.f;
#pragma unroll
        for (int j = 0; j < 8; ++j) { v0[j] = n0[j]; v1[j] = n1[j]; }
        if (m + 2 * NGW < S) { const int ma = m + 2 * NGW, mb = (ma + NGW) < S ? ma + NGW : ma;
#pragma unroll
            for (int j = 0; j < 8; ++j) { n0[j] = ((const GAS f32x4*)(a.X + (size_t)ma * D))[lane + 64 * j]; n1[j] = ((const GAS f32x4*)(a.X + (size_t)mb * D))[lane + 64 * j]; } }
#pragma unroll
        for (int j = 0; j < 8; ++j) { ss0 += (v0[j].x * v0[j].x + v0[j].y * v0[j].y) + (v0[j].z * v0[j].z + v0[j].w * v0[j].w); ss1 += (v1[j].x * v1[j].x + v1[j].y * v1[j].y) + (v1[j].z * v1[j].z + v1[j].w * v1[j].w); }
#pragma unroll
        for (int o = 1; o < 64; o <<= 1) { ss0 += shx(ss0, o, lane); ss1 += shx(ss1, o, lane); }
        const float r0 = rsqrtf(ss0 * (1.0f / D) + EPS), r1 = rsqrtf(ss1 * (1.0f / D) + EPS);
        GAS u32x2* o0 = (GAS u32x2*)(H + (size_t)m * D) + lane; GAS u32x2* o1 = (GAS u32x2*)(H + (size_t)m1 * D) + lane;
#pragma unroll
        for (int j = 0; j < 8; ++j) { const f32x4 w = gl[lane + 64 * j]; v0[j] = v0[j] * r0 * w; v1[j] = v1[j] * r1 * w;
            u32x2 p0; p0.x = cvt_pk_bf16(v0[j].x, v0[j].y); p0.y = cvt_pk_bf16(v0[j].z, v0[j].w); o0[64 * j] = p0;
            u32x2 p1; p1.x = cvt_pk_bf16(v1[j].x, v1[j].y); p1.y = cvt_pk_bf16(v1[j].z, v1[j].w); if (two) o1[64 * j] = p1; }
        float lg0[NE], lg1[NE];
#pragma unroll
        for (int e = 0; e < NE; ++e) { f32x2 a0 = (f32x2){0.f, 0.f}, a1 = (f32x2){0.f, 0.f};
#pragma unroll
            for (int j = 0; j < 8; ++j) { const f32x4 w = *(const LAS f32x4*)(wT + e * D + 4 * lane + 256 * j); const f32x2 wl = (f32x2){w.x, w.y}, wh = (f32x2){w.z, w.w};
                a0 = __builtin_elementwise_fma((f32x2){v0[j].x, v0[j].y}, wl, a0); a0 = __builtin_elementwise_fma((f32x2){v0[j].z, v0[j].w}, wh, a0);
                a1 = __builtin_elementwise_fma((f32x2){v1[j].x, v1[j].y}, wl, a1); a1 = __builtin_elementwise_fma((f32x2){v1[j].z, v1[j].w}, wh, a1); }
            lg0[e] = a0.x + a0.y; lg1[e] = a1.x + a1.y; if (e & 1) __builtin_amdgcn_sched_barrier(0); }
#pragma unroll
        for (int st = 0; st < 4; ++st) { const int o = 32 >> st, n = 8 >> st; const bool up = (lane & o) != 0;
#pragma unroll
            for (int i = 0; i < 8; ++i) if (i < n) { const float s0 = up ? lg0[i] : lg0[i + n], k0 = up ? lg0[i + n] : lg0[i]; const float s1 = up ? lg1[i] : lg1[i + n], k1 = up ? lg1[i + n] : lg1[i];
                lg0[i] = k0 + shx(s0, o, lane); lg1[i] = k1 + shx(s1, o, lane); } }
        float l0 = lg0[0], l1 = lg1[0]; l0 += shx(l0, 2, lane); l1 += shx(l1, 2, lane); l0 += shx(l0, 1, lane); l1 += shx(l1, 1, lane);
        float mx0 = l0, mx1 = l1;
#pragma unroll
        for (int o = 4; o < 64; o <<= 1) { mx0 = fmaxf(mx0, shx(mx0, o, lane)); mx1 = fmaxf(mx1, shx(mx1, o, lane)); }
        const float e0 = expf(l0 - mx0), e1 = expf(l1 - mx1); float sm0 = e0, sm1 = e1;
#pragma unroll
        for (int o = 4; o < 64; o <<= 1) { sm0 += shx(sm0, o, lane); sm1 += shx(sm1, o, lane); }
        const int e = ((lane >> 5) & 1) * 8 + ((lane >> 4) & 1) * 4 + ((lane >> 3) & 1) * 2 + ((lane >> 2) & 1);
        if ((lane & 3) == 0) { AFF[(size_t)e * S + m] = e0 / sm0; if (two) AFF[(size_t)e * S + m1] = e1 / sm1; }
    }
    __syncthreads();
}

__device__ __forceinline__ void select_phase(const Args& a, const Ctx& c, int e) {
    const float* AFF = (const float*)(a.ws + WS_AFF) + (size_t)e * S; int* INV = (int*)(a.ws + WS_INV) + (size_t)e * S; int* IDX = (int*)(a.ws + WS_IDX); float* GATE = (float*)(a.ws + WS_GATE);
    LAS int* red = (LAS int*)c.lds;
    unsigned v[16];
#pragma unroll
    for (int q = 0; q < 4; ++q) { const u32x4 t4 = *(const GAS u32x4*)(AFF + c.tid * 16 + 4 * q); v[4 * q] = t4.x; v[4 * q + 1] = t4.y; v[4 * q + 2] = t4.z; v[4 * q + 3] = t4.w; }
    __syncthreads();
    unsigned prefix = 0; int it = 0;
    for (int sh = 30; sh >= 0; sh -= 2, ++it) {
        const int nb = (sh == 30) ? 1 : 2; const int shift = (sh == 30) ? 30 : sh - 1;
        int cnt[3];
#pragma unroll
        for (int j = 1; j <= 3; ++j) { const unsigned cand = prefix | ((unsigned)j << shift); int cj = 0;
#pragma unroll
            for (int i = 0; i < 16; ++i) cj += (v[i] >= cand) ? 1 : 0;
            cnt[j - 1] = wave_sum_dpp(cj); }
        LAS int* rb = red + (it & 1) * 32;
        if (c.lane == 0) { rb[c.wave * 4 + 0] = cnt[0]; rb[c.wave * 4 + 1] = cnt[1]; rb[c.wave * 4 + 2] = cnt[2]; }
        __syncthreads();
        int t1 = 0, t2 = 0, t3 = 0;
#pragma unroll
        for (int w = 0; w < NWAVES; ++w) { t1 += rb[w * 4 + 0]; t2 += rb[w * 4 + 1]; t3 += rb[w * 4 + 2]; }
        int jsel = 0;
        if (nb == 1) { jsel = (t1 >= CAP) ? 1 : 0; } else { jsel = (t3 >= CAP) ? 3 : ((t2 >= CAP) ? 2 : ((t1 >= CAP) ? 1 : 0)); }
        prefix |= (unsigned)jsel << shift;
        if (sh == 30) sh = 31;
    }
    const unsigned T = prefix;
    int cg = 0, ce = 0;
#pragma unroll
    for (int i = 0; i < 16; ++i) { cg += (v[i] > T) ? 1 : 0; ce += (v[i] == T) ? 1 : 0; }
    int pg = cg, pe = ce;
#pragma unroll
    for (int o = 1; o < 64; o <<= 1) { const int src = (c.lane >= o ? c.lane - o : c.lane) << 2; const int tg = __builtin_amdgcn_ds_bpermute(src, pg), te = __builtin_amdgcn_ds_bpermute(src, pe); if (c.lane >= o) { pg += tg; pe += te; } }
    __syncthreads();
    if (c.lane == 63) { red[64 + c.wave] = pg; red[80 + c.wave] = pe; }
    __syncthreads();
    int bg = 0, be = 0, ng = 0;
#pragma unroll
    for (int w = 0; w < NWAVES; ++w) { const int xg = red[64 + w], xe = red[80 + w]; if (w < c.wave) { bg += xg; be += xe; } ng += xg; }
    pg = pg - cg + bg; pe = pe - ce + be;
    const int need = CAP - ng;
    int slots[16];
#pragma unroll
    for (int i = 0; i < 16; ++i) {
        const int t = c.tid * 16 + i; int slot = -1;
        if (v[i] > T) { slot = pg++; } else if (v[i] == T) { if (pe < need) slot = ng + pe; pe++; }
        slots[i] = slot;
        if (slot >= 0) { IDX[e * CAP + slot] = t; GATE[e * CAP + slot] = __builtin_bit_cast(float, v[i]); }
    }
#pragma unroll
    for (int q = 0; q < 4; ++q) { u32x4 o; o.x = (unsigned)slots[4 * q]; o.y = (unsigned)slots[4 * q + 1]; o.z = (unsigned)slots[4 * q + 2]; o.w = (unsigned)slots[4 * q + 3]; *(GAS u32x4*)(INV + c.tid * 16 + 4 * q) = o; }
}

__device__ __forceinline__ void combine_stage(const Args& a, const Ctx& c, int layer) {
    LAS f32x4* gl = (LAS f32x4*)c.lds; const bool lastl = (layer == NL - 1);
    __syncthreads();
    if (c.tid < D / 4) gl[c.tid] = ((const GAS f32x4*)((const float*)(a.ws + WS_PAR) + (lastl ? PAR_GFIN : PAR_GMIX + (layer + 1) * D)))[c.tid];
    __syncthreads();
}
__device__ __forceinline__ void combine_phase(const Args& a, const Ctx& c, int layer, bool staged = false) {
    int gw = c.vcu * NWAVES + c.wave; asm volatile("" : "+s"(gw));
    const int NGW = c.G * NWAVES, lane = c.lane;
    const bf16_t* Y = (const bf16_t*)(a.ws + WS_Y); const int* INV = (const int*)(a.ws + WS_INV); bf16_t* H = (bf16_t*)(a.ws + WS_H);
    const bool lastl = (layer == NL - 1);
    LAS f32x4* gl = (LAS f32x4*)c.lds;
    f32x4 nv[8]; int ninv = -1;
    { ninv = INV[(size_t)(lane & 15) * S + gw];
#pragma unroll
        for (int j = 0; j < 8; ++j) nv[j] = ((const GAS f32x4*)(a.X + (size_t)gw * D))[lane + 64 * j]; }
    if (!staged) {
    __syncthreads();
    if (c.tid < D / 4) gl[c.tid] = ((const GAS f32x4*)((const float*)(a.ws + WS_PAR) + (lastl ? PAR_GFIN : PAR_GMIX + (layer + 1) * D)))[c.tid];
    __syncthreads();
    }
    for (int m = gw; m < S; m += NGW) {
        GAS f32x4* xr = (GAS f32x4*)(a.X + (size_t)m * D) + lane; f32x4 v[8];
#pragma unroll
        for (int j = 0; j < 8; ++j) v[j] = nv[j];
        const int myinv = ninv;
        if (m + NGW < S) { ninv = INV[(size_t)(lane & 15) * S + m + NGW];
#pragma unroll
            for (int j = 0; j < 8; ++j) nv[j] = ((const GAS f32x4*)(a.X + (size_t)(m + NGW) * D))[lane + 64 * j]; }
        unsigned mask = (unsigned)(__builtin_amdgcn_ballot_w64(myinv >= 0) & 0xFFFFull);
        while (mask) {
            const int e1 = __builtin_ctz(mask); mask &= mask - 1u; const bool two = mask != 0u; const int e2 = two ? __builtin_ctz(mask) : e1; if (two) mask &= mask - 1u;
            const int s1 = __builtin_amdgcn_readlane(myinv, e1), s2 = __builtin_amdgcn_readlane(myinv, e2);
            const GAS u32x2* y1 = (const GAS u32x2*)(Y + ((size_t)e1 * CAP + s1) * D) + lane; const GAS u32x2* y2 = (const GAS u32x2*)(Y + ((size_t)e2 * CAP + s2) * D) + lane;
            u32x2 a1[8], a2[8];
#pragma unroll
            for (int j = 0; j < 8; ++j) { a1[j] = y1[64 * j]; a2[j] = y2[64 * j]; }
#pragma unroll
            for (int j = 0; j < 8; ++j) { v[j].x += bf_lo(a1[j].x); v[j].y += bf_hi(a1[j].x); v[j].z += bf_lo(a1[j].y); v[j].w += bf_hi(a1[j].y); }
            if (two) {
#pragma unroll
                for (int j = 0; j < 8; ++j) { v[j].x += bf_lo(a2[j].x); v[j].y += bf_hi(a2[j].x); v[j].z += bf_lo(a2[j].y); v[j].w += bf_hi(a2[j].y); } }
        }
        float ss = 0.f;
#pragma unroll
        for (int j = 0; j < 8; ++j) ss += (v[j].x * v[j].x + v[j].y * v[j].y) + (v[j].z * v[j].z + v[j].w * v[j].w);
        const float r = rsqrtf(wave_sum(ss, lane) * (1.0f / D) + EPS);
        if (!lastl) {
            GAS u32x2* o8 = (GAS u32x2*)(H + (size_t)m * D) + lane;
#pragma unroll
            for (int j = 0; j < 8; ++j) { xr[64 * j] = v[j]; const f32x4 w = gl[lane + 64 * j]; u32x2 o; o.x = cvt_pk_bf16(v[j].x * r * w.x, v[j].y * r * w.y); o.y = cvt_pk_bf16(v[j].z * r * w.z, v[j].w * r * w.w); o8[64 * j] = o; }
        } else {
#pragma unroll
            for (int j = 0; j < 8; ++j) { const f32x4 w = gl[lane + 64 * j]; f32x4 o; o.x = v[j].x * r * w.x; o.y = v[j].y * r * w.y; o.z = v[j].z * r * w.z; o.w = v[j].w * r * w.w; xr[64 * j] = o; }
        }
    }
    __syncthreads();
}
constexpr int NPH = 1 + 9 * NL;
__global__ void __launch_bounds__(NTHREADS, 2) mk_fwd(Args a) {
    extern __shared__ __attribute__((aligned(16))) unsigned char lds_raw[];
    Ctx c; c.lds = (LAS unsigned char*)lds_raw;
    c.wave = __builtin_amdgcn_readfirstlane((int)threadIdx.x >> 6);
    c.lane = lane_id(); c.tid = c.wave * 64 + c.lane;
    c.G = gridDim.x; { const int bx = blockIdx.x; c.vcu = (c.G % 8 == 0) ? (bx % 8) * (c.G / 8) + bx / 8 : bx; }
    volatile LAS unsigned* MISC = (volatile LAS unsigned*)(c.lds + MISC_OFF);
    for (int u = c.tid; u < (LDS_BYTES - LDSCTL_OFF) / 4; u += NTHREADS) ((LAS unsigned*)(c.lds + LDSCTL_OFF))[u] = 0u;
    const bool leader0 = false; (void)leader0;
    __syncthreads();
    const int lo = a.ph_lo, hi = a.ph_hi;
    unsigned* ctl = (unsigned*)(a.ws + WS_CTL);
    XcdBarrier bar; bar.bar = ctl + CW_BAR; bar.x = 0; bar.st = nullptr;
    if (hi - lo > 1) bar = xcd_barrier_post(ctl + CW_BAR, MISC + 8, c.tid == 0);
    unsigned char* ws = a.ws;
#define IN(k) (lo <= (k) && (k) < hi)
#ifndef MK_PHMASK
#define MK_PHMASK 0x3ff
#endif
#define EN(b) ((MK_PHMASK >> (b)) & 1)
#ifndef MK_REPMASK
#define MK_REPMASK 0
#endif
#ifndef MK_NRSTAGE
#define MK_NRSTAGE 1
#endif
#define REPS_ON(b) (((MK_REPMASK >> (b)) & 1) != 0)
#ifndef MK_REPN
#define MK_REPN 3
#endif
#define REPS(b) (((MK_REPMASK >> (b)) & 1) ? MK_REPN : 1)
#define SEAM(k) do { if (IN((k) + 1)) { const int _ln = lane_id(); xcd_barrier(bar, c.wave == 0 && _ln == 0); } } while (0)
#ifndef MK_SELCVT
#define MK_SELCVT 4400
#endif
#define par0b_() ({ int _b = (int)blockIdx.x; asm volatile("" : "+s"(_b)); _b; })
#define FRESH(cc) Ctx cc = c; cc.lane = lane_id(); cc.tid = cc.wave * 64 + cc.lane

    if (EN(0) && IN(0)) {
        { FRESH(cc); p0_prologue(a, cc); }
        SEAM(0); }

    for (int l = 0; l < NL; ++l) {
        const int pb = 1 + 9 * l, li = l >> 1; const bool odd = (l & 1) != 0;
        if (EN(1) && IN(pb + 0)) {
            pg8::Sched Sc{}; Sc.G = c.G; Sc.c = (int)blockIdx.x; Sc.A = (long)WS_H; Sc.tA = 256 * D * 2; Sc.sA = 0; Sc.sB = 0; Sc.tB = 256 * D * 2; Sc.nM = S / 256; Sc.nG = 1; Sc.gidx = nullptr;
            pg8::EpiBf16 E{}; E.O = (bf16_t*)(ws + WS_Z); E.gcol = 0; E.O2 = (bf16_t*)(ws + WS_VT); E.ldc2 = S;
            if (!odd) { Sc.B = (long)(WS_EVIN + li * SZ_EVIN); Sc.nN = QKF_LD / 256; E.ldc = QKF_LD;
                Sc.nExtra = 64; Sc.nFull = 384; }
            else { Sc.B = (long)(WS_ODIN + li * SZ_ODIN); Sc.nN = OD_IN / 256; E.ldc = OD_IN; Sc.nExtra = 0; Sc.nFull = (S / 256) * (OD_IN / 256); }
#if MK_JITCVT
            int par0 = (int)blockIdx.x; asm volatile("" : "+s"(par0)); par0 &= 1;
            const bool solo = !odd && c.G == 256;
            if (solo) { if (par0b_() >= 128) { FRESH(cc); moe_cvt(a, cc, l, 0, par0b_() - 128, 128); __syncthreads(); } }
            else if (par0 == 0) { FRESH(cc); moe_cvt(a, cc, l, 0); __syncthreads(); }
#endif
            pg8::gemm_phase<pg8::EpiBf16, false>(c.lds, c.wave, (const char*)ws, D, D, D, Sc, E);
#if MK_JITCVT
            int par0b = (int)blockIdx.x; asm volatile("" : "+s"(par0b));
            if (!(!odd && c.G == 256) && (par0b & 1) != 0) { FRESH(cc); moe_cvt(a, cc, l, 0); __syncthreads(); }
#endif
            SEAM(pb + 0);
        }
        if (EN(2) && IN(pb + 1)) {
#if MK_JITCVT && MK_UPHOST
            { int parm = (int)blockIdx.x; asm volatile("" : "+s"(parm)); if ((parm & 1) == 0) { FRESH(cc); moe_cvt(a, cc, l, 1); __syncthreads(); } }
#endif
            if (!odd) {
#ifndef MK_SUB
#define MK_SUB 7
#endif
                _Pragma("unroll 1") for (int rep = 0; rep < REPS(10); ++rep) if (MK_SUB & 1) for (int u = c.vcu; u < 256; u += c.G) { FRESH(cc); attn_unit(a, cc, li, u >> 2, u & 3); }
                _Pragma("unroll 1") for (int rep = 0; rep < REPS(11); ++rep) if (MK_SUB & 2) for (int u = c.vcu; u < 256; u += c.G) { FRESH(cc); ffta_unit(a, cc, u >> 6, u & 63); }
            } else {
                _Pragma("unroll 1") for (int rep = 0; rep < REPS(13); ++rep) if (MK_SUB & 4) for (int u = c.vcu; u < 256; u += c.G) { FRESH(cc); if (MK_ODDMIX2) oddmix_unit2(a, cc, li, u); else oddmix_unit(a, cc, li, u); }
            }
#if MK_JITCVT && MK_UPHOST
            { int parm = (int)blockIdx.x; asm volatile("" : "+s"(parm)); if ((parm & 1) != 0) { __syncthreads(); FRESH(cc); moe_cvt(a, cc, l, 1); __syncthreads(); } }
#endif
            SEAM(pb + 1);
        }
        if (EN(3) && IN(pb + 2)) {
            if (!odd) {
                _Pragma("unroll 1") for (int rep = 0; rep < REPS(12); ++rep) if (MK_SUB & 1) for (int u = c.vcu; u < 256; u += c.G) { FRESH(cc); fftc_unit(a, cc, u >> 2, u & 3); }
                __syncthreads();
            }
            if (!odd)             SEAM(pb + 2);
        }
        if (EN(4) && IN(pb + 3)) {
            const int Kk = odd ? D : MIX_LD_EV;
            pg8::Sched Sc{}; Sc.G = c.G; Sc.c = (int)blockIdx.x; Sc.A = (long)WS_MIX; Sc.sA = 0; Sc.tA = 256 * Kk * 2;
            Sc.B = (long)(odd ? WS_ODOUT + li * SZ_ODOUT : WS_EVOUT + li * SZ_EVOUT); Sc.sB = 0; Sc.tB = 256 * Kk * 2;
            Sc.nM = S / 256; Sc.nN = D / 256; Sc.nG = 1; Sc.gidx = nullptr; Sc.nExtra = 0; Sc.nFull = 256;
            pg8::EpiResF32 E{}; E.R = (l == 0) ? a.x_in : a.X; E.X = a.X; E.ldc = D;
#if MK_JITCVT && !MK_UPHOST
            int par1 = (int)blockIdx.x; asm volatile("" : "+s"(par1)); par1 &= 1;
            if (par1 == 0) { FRESH(cc); moe_cvt(a, cc, l, 1); __syncthreads(); }
#endif
            pg8::gemm_phase<pg8::EpiResF32, false>(c.lds, c.wave, (const char*)ws, Kk, Kk, Kk, Sc, E);
#if MK_JITCVT && !MK_UPHOST
            int par1b = (int)blockIdx.x; asm volatile("" : "+s"(par1b));
            if ((par1b & 1) != 0) { FRESH(cc); moe_cvt(a, cc, l, 1); __syncthreads(); }
#endif
#if MK_NRSTAGE
            if (IN(pb + 4) && EN(5) && !REPS_ON(14)) { FRESH(cc); norm_router_stage(a, cc, l); }
#endif
            SEAM(pb + 3);
        }
        if (EN(5) && IN(pb + 4)) { _Pragma("unroll 1") for (int rep = 0; rep < REPS(14); ++rep) { FRESH(cc); norm_router_phase(a, cc, l, MK_NRSTAGE && EN(4) && IN(pb + 3) && !REPS_ON(14)); } SEAM(pb + 4); }
        if (EN(6) && IN(pb + 5)) { _Pragma("unroll 1") for (int rep = 0; rep < REPS(6); ++rep) { FRESH(cc); int bx = (int)blockIdx.x; asm volatile("" : "+s"(bx));
              if (bx < NE) select_phase(a, cc, bx);
#if MK_JITCVT
              else if (c.G == 256) moe_cvt(a, cc, l, 2, bx - NE, 256 - NE, 0, MK_SELCVT);
#endif
#ifdef MK_SELSLEEP
              else { for (int q = 0; q < MK_SELSLEEP; ++q) __builtin_amdgcn_s_sleep(127); }
#endif
            } SEAM(pb + 5); }
        if (EN(7) && IN(pb + 6)) {
            pg8::Sched Sc{}; Sc.G = c.G; Sc.c = (int)blockIdx.x; Sc.A = (long)WS_H; Sc.sA = 0; Sc.tA = 0; Sc.B = (long)(WS_GU + l * SZ_GU); Sc.sB = (long)2048 * D * 2; Sc.tB = 256 * D * 2;
            Sc.nM = CAP / 256; Sc.nN = 2048 / 256; Sc.nG = NE; Sc.gidx = (const int*)(ws + WS_IDX); Sc.nExtra = 0; Sc.nFull = 512;
            pg8::EpiGU E{}; E.HID = (bf16_t*)(ws + WS_HID);
#if MK_JITCVT
            int par2 = (int)blockIdx.x; asm volatile("" : "+s"(par2)); par2 &= 1;
            if (par2 == 0) { FRESH(cc); moe_cvt(a, cc, l, 2, -1, 0, (c.G == 256) ? MK_SELCVT : 0); __syncthreads(); }
#endif
            pg8::gemm_phase<pg8::EpiGU, true>(c.lds, c.wave, (const char*)ws, D, D, D, Sc, E);
#if MK_JITCVT
            int par2b = (int)blockIdx.x; asm volatile("" : "+s"(par2b));
            if ((par2b & 1) != 0) { FRESH(cc); moe_cvt(a, cc, l, 2, -1, 0, (c.G == 256) ? MK_SELCVT : 0); __syncthreads(); }
#endif
            SEAM(pb + 6);
        }
        if (EN(8) && IN(pb + 7)) {
            pg8::Sched Sc{}; Sc.G = c.G; Sc.c = (int)blockIdx.x; Sc.A = (long)WS_HID; Sc.sA = (long)CAP * EH * 2; Sc.tA = 256 * EH * 2; Sc.B = (long)(WS_DN + l * SZ_DN); Sc.sB = (long)D * EH * 2; Sc.tB = 256 * EH * 2;
            Sc.nM = CAP / 256; Sc.nN = D / 256; Sc.nG = NE; Sc.gidx = nullptr; Sc.nExtra = 0; Sc.nFull = 512;
            pg8::EpiDown E{}; E.Y = (bf16_t*)(ws + WS_Y); E.gate = (const float*)(ws + WS_GATE);
            pg8::gemm_phase<pg8::EpiDown, false>(c.lds, c.wave, (const char*)ws, EH, EH, EH, Sc, E);
#if MK_NRSTAGE
            if (IN(pb + 8) && EN(9)) { FRESH(cc); combine_stage(a, cc, l); }
#endif
            SEAM(pb + 7);
        }
        if (EN(9) && IN(pb + 8)) { FRESH(cc); combine_phase(a, cc, l, MK_NRSTAGE && EN(8) && IN(pb + 7)); SEAM(pb + 8); }
    }
#undef IN
#undef SEAM
}
}


extern "C" void kernel_launch(void* const* d_in, const int* in_sizes, int n_in, void* d_out, int out_size, void* d_ws, size_t ws_size, hipStream_t stream) {
    using namespace mk;
    static int grid = 0;
    if (grid == 0) {
        int dev = 0, cus = 0, per_cu = 0;
        if (hipGetDevice(&dev) != hipSuccess || hipDeviceGetAttribute(&cus, hipDeviceAttributeMultiprocessorCount, dev) != hipSuccess) { fprintf(stderr, "kernel_launch: device query failed\n"); grid = -1; return; }
        if (hipFuncSetAttribute((const void*)mk_fwd, hipFuncAttributeMaxDynamicSharedMemorySize, LDS_BYTES) != hipSuccess) { fprintf(stderr, "kernel_launch: hipFuncSetAttribute failed\n"); grid = -1; return; }
        if (hipOccupancyMaxActiveBlocksPerMultiprocessor(&per_cu, (const void*)mk_fwd, NTHREADS, LDS_BYTES) != hipSuccess || per_cu < 1) fprintf(stderr, "kernel_launch: occupancy query reports %d blocks per CU\n", per_cu);
        (void)hipGetLastError();
        grid = cus;
        if (ws_size < WS_END) { fprintf(stderr, "kernel_launch: workspace too small: %zu < %zu\n", ws_size, (size_t)WS_END); grid = -1; return; }
    }
    if (grid < 0) return;
    (void)hipMemsetAsync((char*)d_ws + WS_CTL, 0, CTL_ZERO_BYTES, stream);
    Args a{};
    a.x_in = (const float*)d_in[0]; a.rel_bias = (const float*)d_in[1]; a.norm_mix_g = (const float*)d_in[2]; a.norm_ffn_g = (const float*)d_in[3]; a.final_g = (const float*)d_in[4];
    a.ev_w_in = (const float*)d_in[5]; a.ev_sink = (const float*)d_in[6]; a.ev_w_out = (const float*)d_in[7];
    a.od_w_in = (const float*)d_in[8]; a.od_conv_w = (const float*)d_in[9]; a.od_pool_w = (const float*)d_in[10]; a.od_pool_scale = (const float*)d_in[11]; a.od_w_out = (const float*)d_in[12];
    a.moe_w_router = (const float*)d_in[13]; a.moe_w_gate = (const float*)d_in[14]; a.moe_w_up = (const float*)d_in[15]; a.moe_w_down = (const float*)d_in[16];
    a.X = (float*)d_out; a.ws = (unsigned char*)d_ws;
#if MK_DEBUG
    mkref::debug_run(a, grid, d_in, d_out, d_ws, ws_size, stream);
#else
#if MK_NLAUNCH == 1
    a.ph_lo = 0; a.ph_hi = NPH;
    hipLaunchKernelGGL(mk_fwd, dim3(grid), dim3(NTHREADS), LDS_BYTES, stream, a);
#else
    for (int p = 0; p < NPH; ++p) { const int type = p == 0 ? 0 : ((p - 1) % 9) + 1; const int layer = p == 0 ? 0 : (p - 1) / 9; (void)layer;
        int reps = 1;
#if defined(MK_HREPMASK)
        if (((MK_HREPMASK >> type) & 1) && ((MK_HREPLAYERS >> layer) & 1)) reps = MK_HREPN;
#endif
        for (int r = 0; r < reps; ++r) { a.ph_lo = p; a.ph_hi = p + 1; hipLaunchKernelGGL(mk_fwd, dim3(grid), dim3(NTHREADS), LDS_BYTES, stream, a); } }
#if defined(MK_HREP_EMPTY)
    for (int r = 0; r < MK_HREP_EMPTY; ++r) { a.ph_lo = NPH; a.ph_hi = NPH; hipLaunchKernelGGL(mk_fwd, dim3(grid), dim3(NTHREADS), LDS_BYTES, stream, a); }
#endif
#endif
    if (hipPeekAtLastError() != hipSuccess) fprintf(stderr, "kernel_launch: launch failed\n");
#endif
}
```
